# Optimizing an MI355X kernel written in HIP

```python
import math
import jax, jax.numpy as jnp
from jax import lax
import numpy as np

D_MODEL = 1024
BATCH = 16
SEQ = 2048
DEPTH = 4

N_MIXERS = 3
MLA_HEADS = 8
MLA_Q_LORA = 384
MLA_KV_LORA = 256
MLA_NOPE = 128
MLA_ROPE = 64
MLA_V = 128
MLA_QK = MLA_NOPE + MLA_ROPE
ROPE_THETA = 10000.0
Q_BLOCK = 128
HG_HEADS = 8
HG_DK = D_MODEL // HG_HEADS
HG_DV = D_MODEL // HG_HEADS
HG_CHUNK = 64
CONV_WIDTH = 31
D_FF = 4 * D_MODEL
EPS = 1e-6

N_MLA_LAYERS = (DEPTH + 2) // 3
N_HGRN_LAYERS = (DEPTH + 1) // 3
N_CONV_LAYERS = DEPTH // 3

kernel_name = "hybrid_mla_hgrn2_conformer_trunk"


def rms_norm(x, g):
    xf = x.astype(jnp.float32)
    y = xf * lax.rsqrt(jnp.mean(xf * xf, axis=-1, keepdims=True) + EPS)
    return (y * g.astype(jnp.float32)).astype(x.dtype)


def layer_norm(x, g, b):
    xf = x.astype(jnp.float32)
    mu = jnp.mean(xf, axis=-1, keepdims=True)
    xc = xf - mu
    y = xc * lax.rsqrt(jnp.mean(xc * xc, axis=-1, keepdims=True) + EPS)
    return (y * g.astype(jnp.float32) + b.astype(jnp.float32)).astype(x.dtype)


def apply_rope(t, cos, sin):
    t1, t2 = jnp.split(t.astype(jnp.float32), 2, axis=-1)
    out = jnp.concatenate([t1 * cos - t2 * sin, t2 * cos + t1 * sin], axis=-1)
    return out.astype(t.dtype)


def causal_block_attention(q, k, v):
    B, S, H, Dq = q.shape
    nb = S // Q_BLOCK
    scale = Dq ** -0.5
    qb = q.reshape(B, nb, Q_BLOCK, H, Dq).transpose(1, 0, 2, 3, 4)
    key_pos = jnp.arange(S)

    def one_block(args):
        q_blk, blk = args
        q_pos = blk * Q_BLOCK + jnp.arange(Q_BLOCK)
        s = jnp.einsum('bqhd,bkhd->bhqk', q_blk, k, preferred_element_type=jnp.float32) * scale
        s = jnp.where(key_pos[None, :] <= q_pos[:, None], s, -jnp.inf)
        p = jax.nn.softmax(s, axis=-1)
        return jnp.einsum('bhqk,bkhd->bqhd', p.astype(v.dtype), v)

    ob = lax.map(one_block, (qb, jnp.arange(nb)))
    return ob.transpose(1, 0, 2, 3, 4).reshape(B, S, H, v.shape[-1])


def mla_mixer(h, cos, sin, w_down, q_lat_norm, kv_lat_norm, w_uq, w_ukv, q_head_norm, k_head_norm, w_o):
    B, S, _ = h.shape
    lat = h @ w_down
    c_q, c_kv, k_rope = jnp.split(lat, [MLA_Q_LORA, MLA_Q_LORA + MLA_KV_LORA], axis=-1)
    c_q = rms_norm(c_q, q_lat_norm)
    c_kv = rms_norm(c_kv, kv_lat_norm)
    q = (c_q @ w_uq).reshape(B, S, MLA_HEADS, MLA_QK)
    kv = (c_kv @ w_ukv).reshape(B, S, MLA_HEADS, MLA_NOPE + MLA_V)
    q_nope, q_rope = jnp.split(q, [MLA_NOPE], axis=-1)
    k_nope, v = jnp.split(kv, [MLA_NOPE], axis=-1)
    q_nope = rms_norm(q_nope, q_head_norm[:MLA_NOPE])
    q_rope = rms_norm(q_rope, q_head_norm[MLA_NOPE:])
    k_nope = rms_norm(k_nope, k_head_norm[:MLA_NOPE])
    k_rope = rms_norm(k_rope, k_head_norm[MLA_NOPE:])
    q_rope = apply_rope(q_rope, cos[:, :, None, :], sin[:, :, None, :])
    k_rope = apply_rope(k_rope, cos, sin)
    q = jnp.concatenate([q_nope, q_rope], axis=-1)
    k = jnp.concatenate([k_nope, jnp.broadcast_to(k_rope[:, :, None, :], (B, S, MLA_HEADS, MLA_ROPE))], axis=-1)
    o = causal_block_attention(q, k, v)
    return o.reshape(B, S, MLA_HEADS * MLA_V) @ w_o


def hgrn2_chunk_scan(q, k, v, log_f):
    _, B, H, C, dk = q.shape
    dv = v.shape[-1]
    causal = jnp.tril(jnp.ones((C, C), dtype=bool))

    def step(state, inp):
        qc, kc, vc, lfc = inp
        b = jnp.cumsum(lfc, axis=2)
        b_last = b[:, :, -1:, :]
        o_inter = jnp.einsum('bhtk,bhkv->bhtv', qc * jnp.exp(b), state)
        diff = b[:, :, :, None, :] - b[:, :, None, :, :]
        decay = jnp.exp(jnp.where(causal[:, :, None], diff, -jnp.inf))
        attn = jnp.einsum('bhtk,bhsk,bhtsk->bhts', qc, kc, decay)
        o_intra = jnp.einsum('bhts,bhsv->bhtv', attn, vc)
        new_state = jnp.exp(b_last[:, :, 0, :])[..., None] * state + jnp.einsum(
            'bhsk,bhsv->bhkv', kc * jnp.exp(b_last - b), vc)
        return new_state, o_inter + o_intra

    init = jnp.zeros((B, H, dk, dv), jnp.float32)
    _, o = lax.scan(step, init, (q, k, v, log_f))
    return o


def hgrn2_mixer(h, lb, w_in, out_norm, w_o):
    B, S, _ = h.shape
    nC = S // HG_CHUNK
    proj = h @ w_in
    q, fz, i, g = jnp.split(proj, 4, axis=-1)
    fz = fz.astype(jnp.float32)
    f = lb + (1.0 - lb) * jax.nn.sigmoid(fz)
    log_f = jnp.log(f)
    k = (1.0 - lb) * jax.nn.sigmoid(-fz)

    def to_chunks(t, d):
        return t.astype(jnp.float32).reshape(B, nC, HG_CHUNK, HG_HEADS, d).transpose(1, 0, 3, 2, 4)

    o = hgrn2_chunk_scan(to_chunks(q, HG_DK), to_chunks(k, HG_DK), to_chunks(i, HG_DV), to_chunks(log_f, HG_DK))
    o = o.transpose(1, 0, 3, 2, 4).reshape(B, S, HG_HEADS, HG_DV)
    gate = jax.nn.silu(g.astype(jnp.float32)).reshape(B, S, HG_HEADS, HG_DV)
    o = rms_norm(o, out_norm) * gate
    return o.reshape(B, S, HG_HEADS * HG_DV).astype(h.dtype) @ w_o


def conformer_conv_mixer(h, w_pw1, b_pw1, w_dw, b_dw, ln_g, ln_b, w_pw2, b_pw2):
    a, gate = jnp.split(h @ w_pw1 + b_pw1, 2, axis=-1)
    u = a * jax.nn.sigmoid(gate)
    u = lax.conv_general_dilated(
        u, w_dw[:, None, :].astype(u.dtype), window_strides=(1,), padding=[(CONV_WIDTH - 1, 0)],
        dimension_numbers=('NWC', 'WIO', 'NWC'), feature_group_count=D_MODEL) + b_dw
    u = jax.nn.silu(layer_norm(u, ln_g, ln_b))
    return u @ w_pw2 + b_pw2


def squared_relu_mlp(h, w_in, w_out):
    a = jax.nn.relu(h @ w_in)
    return (a * a) @ w_out


def setup_inputs(seed: int = 0) -> dict:
    key = jax.random.key(seed)
    ks = iter(jax.random.split(key, 32))
    f32 = jnp.float32

    def nrm(shape, scale):
        return jax.random.normal(next(ks), shape, f32) * scale

    def gain(shape):
        return 1.0 + 0.1 * jax.random.normal(next(ks), shape, f32)

    def bias(shape):
        return 0.02 * jax.random.normal(next(ks), shape, f32)

    x = nrm((BATCH, SEQ, D_MODEL), 1.0)
    offsets = jax.random.randint(next(ks), (BATCH, 1), 0, 4096, dtype=jnp.int32)
    positions = offsets + jnp.arange(SEQ, dtype=jnp.int32)[None, :]
    nA, nB, nC = N_MLA_LAYERS, N_HGRN_LAYERS, N_CONV_LAYERS
    return {
        "x": x,
        "positions": positions,
        "norm_mix": gain((DEPTH, D_MODEL)),
        "norm_mlp": gain((DEPTH, D_MODEL)),
        "mlp_w_in": nrm((DEPTH, D_MODEL, D_FF), D_MODEL ** -0.5),
        "mlp_w_out": nrm((DEPTH, D_FF, D_MODEL), D_FF ** -0.5),
        "mla_w_down": nrm((nA, D_MODEL, MLA_Q_LORA + MLA_KV_LORA + MLA_ROPE), D_MODEL ** -0.5),
        "mla_q_lat_norm": gain((nA, MLA_Q_LORA)),
        "mla_kv_lat_norm": gain((nA, MLA_KV_LORA)),
        "mla_w_uq": nrm((nA, MLA_Q_LORA, MLA_HEADS * MLA_QK), MLA_Q_LORA ** -0.5),
        "mla_w_ukv": nrm((nA, MLA_KV_LORA, MLA_HEADS * (MLA_NOPE + MLA_V)), MLA_KV_LORA ** -0.5),
        "mla_q_head_norm": gain((nA, MLA_QK)),
        "mla_k_head_norm": gain((nA, MLA_QK)),
        "mla_w_o": nrm((nA, MLA_HEADS * MLA_V, D_MODEL), (MLA_HEADS * MLA_V) ** -0.5),
        "hg_w_in": nrm((nB, D_MODEL, 2 * HG_HEADS * HG_DK + 2 * HG_HEADS * HG_DV), D_MODEL ** -0.5),
        "hg_lb_logits": nrm((DEPTH, HG_HEADS * HG_DK), 0.5),
        "hg_out_norm": gain((nB, HG_DV)),
        "hg_w_o": nrm((nB, HG_HEADS * HG_DV, D_MODEL), (HG_HEADS * HG_DV) ** -0.5),
        "cv_w_pw1": nrm((nC, D_MODEL, 2 * D_MODEL), D_MODEL ** -0.5),
        "cv_b_pw1": bias((nC, 2 * D_MODEL)),
        "cv_w_dw": nrm((nC, CONV_WIDTH, D_MODEL), CONV_WIDTH ** -0.5),
        "cv_b_dw": bias((nC, D_MODEL)),
        "cv_ln_g": gain((nC, D_MODEL)),
        "cv_ln_b": bias((nC, D_MODEL)),
        "cv_w_pw2": nrm((nC, D_MODEL, D_MODEL), D_MODEL ** -0.5),
        "cv_b_pw2": bias((nC, D_MODEL)),
    }


def reference(x, positions, norm_mix, norm_mlp, mlp_w_in, mlp_w_out,
              mla_w_down, mla_q_lat_norm, mla_kv_lat_norm, mla_w_uq, mla_w_ukv,
              mla_q_head_norm, mla_k_head_norm, mla_w_o,
              hg_w_in, hg_lb_logits, hg_out_norm, hg_w_o,
              cv_w_pw1, cv_b_pw1, cv_w_dw, cv_b_dw, cv_ln_g, cv_ln_b, cv_w_pw2, cv_b_pw2):
    f32 = jnp.float32
    inv_freq = jnp.power(ROPE_THETA, -jnp.arange(0, MLA_ROPE, 2, dtype=f32) / MLA_ROPE)
    ang = positions.astype(f32)[..., None] * inv_freq
    cos, sin = jnp.cos(ang), jnp.sin(ang)
    lb_table = jnp.cumsum(jax.nn.softmax(hg_lb_logits.astype(f32), axis=0), axis=0)
    lb_table = lb_table - lb_table[0]

    for layer in range(DEPTH):
        kind, j = layer % N_MIXERS, layer // N_MIXERS
        h = rms_norm(x, norm_mix[layer])
        if kind == 0:
            mix = mla_mixer(h, cos, sin, mla_w_down[j], mla_q_lat_norm[j], mla_kv_lat_norm[j],
                            mla_w_uq[j], mla_w_ukv[j], mla_q_head_norm[j], mla_k_head_norm[j], mla_w_o[j])
        elif kind == 1:
            mix = hgrn2_mixer(h, lb_table[layer], hg_w_in[j], hg_out_norm[j], hg_w_o[j])
        else:
            mix = conformer_conv_mixer(h, cv_w_pw1[j], cv_b_pw1[j], cv_w_dw[j], cv_b_dw[j],
                                       cv_ln_g[j], cv_ln_b[j], cv_w_pw2[j], cv_b_pw2[j])
        x = x + mix.astype(x.dtype)
        h = rms_norm(x, norm_mlp[layer])
        x = x + squared_relu_mlp(h, mlp_w_in[layer], mlp_w_out[layer]).astype(x.dtype)
    return x
```

```cpp
#include <hip/hip_runtime.h>
#include <cstdio>
#include <cstdint>
#include <cmath>
__device__ __forceinline__ int mk_lane() { int l; asm volatile("v_mbcnt_lo_u32_b32 %0, -1, 0\n\tv_mbcnt_hi_u32_b32 %0, -1, %0" : "=v"(l)); return l; }
namespace pg8 {
#define PG8_LAS __attribute__((address_space(3)))
typedef unsigned short bf16_t;
typedef short bf16x8 __attribute__((ext_vector_type(8)));
typedef float f32x4 __attribute__((ext_vector_type(4)));
typedef unsigned u32x4 __attribute__((ext_vector_type(4)));
constexpr int BM = 256, BK = 64, HALF = 128, HTB = HALF * BK * 2  , STAGE_BYTES = 8 * HTB, NXCD = 8, WGM = 8;

__host__ __device__ __forceinline__ int lds_byte(int r, int c) { const int st = (r >> 4) * 2 + (c >> 5), rr = r & 15, cc = c & 31, ob = rr * 64 + cc * 2; return st * 1024 + (ob ^ (((ob >> 9) & 1) << 5)); }
__host__ __device__ __forceinline__ void stage_rc(int b, int& R, int& C) { const int st = b / 1024, sb = b % 1024, swz = sb ^ (((sb >> 9) & 1) << 5); R = (st >> 1) * 16 + swz / 64; C = (st & 1) * 32 + (swz % 64) / 2; }
__host__ __device__ __forceinline__ int perm32(int rho) { const int n = rho >> 4, i = rho & 15; return 8 * (i >> 2) + 4 * n + (i & 3); }

struct Unit { int pm, pn; };
struct Gemm { const bf16_t* A; const bf16_t* Bt; int M, N, K; };

struct StaticOrder {
    int nM, nN, nwg, G, c;
    __host__ __device__ void init(int M, int N, int G_, int c_) { nM = M / BM; nN = N / BM; nwg = nM * nN; G = G_; c = c_; }
    __host__ __device__ bool next(int i, Unit& u) const {
        const long L = (long)i * G + c; if (L >= nwg) return false;
        int wgid = (int)L; { const int q = nwg / NXCD, r = nwg % NXCD, xcd = wgid % NXCD, off = wgid / NXCD; wgid = (xcd < r ? xcd * (q + 1) : r * (q + 1) + (xcd - r) * q) + off; }
        const int nig = WGM * nN, gid = wgid / nig, fm = gid * WGM, gsz = (nM - fm) < WGM ? (nM - fm) : WGM;
        u.pm = fm + ((wgid % nig) % gsz); u.pn = (wgid % nig) / gsz; return true;
    }
    __device__ __forceinline__ void a_ready(const Unit&) const {}
    __device__ __forceinline__ void done(const Unit&) const {}
};
__device__ __forceinline__ unsigned cvt_pk_bf16(float lo, float hi) { unsigned r; asm volatile("v_cvt_pk_bf16_f32 %0, %1, %2" : "=v"(r) : "v"(lo), "v"(hi)); return r; }
constexpr float RMS_EPS = 1e-6f;
typedef unsigned long long ssq_t;
constexpr float SS_SCALE = 1048576.0f, SS_INV = 1.0f / 1048576.0f;
__device__ __forceinline__ float row_rstd(const ssq_t* ss, int row, float inv_n) { return rsqrtf((float)ss[row] * (inv_n * SS_INV) + RMS_EPS); }
__device__ __forceinline__ void ss_add(ssq_t* p, float v) { (void)__hip_atomic_fetch_add(p, (ssq_t)(v * SS_SCALE + 0.5f), __ATOMIC_RELAXED, __HIP_MEMORY_SCOPE_AGENT); }
__device__ __forceinline__ float sigm(float x) { return __builtin_amdgcn_rcpf(1.0f + __expf(-x)); }
__device__ __forceinline__ u32x4 pack8v(f32x4 a, f32x4 b) { u32x4 w; w.x = cvt_pk_bf16(a[0], a[1]); w.y = cvt_pk_bf16(a[2], a[3]); w.z = cvt_pk_bf16(b[0], b[1]); w.w = cvt_pk_bf16(b[2], b[3]); return w; }
__device__ __forceinline__ float dot4(f32x4 a) { return (a[0] * a[0] + a[1] * a[1]) + (a[2] * a[2] + a[3] * a[3]); }
__device__ __forceinline__ float quad_sum(float s) { s += __shfl_xor(s, 16); s += __shfl_xor(s, 32); return s; }

template <int ACT> struct EpiRow {
    static constexpr bool PERM = true, AFTER_DRAIN = false;
    bf16_t* O; int ldc; const ssq_t* ss; float inv_n;
    __device__ __forceinline__ void operator()(const f32x4 (&acc)[2][2][4][2], const Unit& u, int wr, int wc, int fr, int fq) const {
        const int row0 = u.pm * BM + wr * 64 + fr, col0 = u.pn * BM + wc * 32 + 8 * fq;
#pragma unroll
        for (int ai = 0; ai < 2; ++ai)
#pragma unroll
            for (int m = 0; m < 4; ++m) {
                const int row = row0 + ai * HALF + m * 16;
                const float rs = row_rstd(ss, row, inv_n);
                bf16_t* rowp = O + (size_t)row * ldc + col0;
#pragma unroll
                for (int bj = 0; bj < 2; ++bj) {
                    f32x4 v0 = acc[ai][bj][m][0] * rs, v1 = acc[ai][bj][m][1] * rs;
                    if (ACT == 1) {
#pragma unroll
                        for (int e = 0; e < 4; ++e) { const float a = fmaxf(v0[e], 0.f), b = fmaxf(v1[e], 0.f); v0[e] = a * a; v1[e] = b * b; }
                    }
                    *(u32x4*)(rowp + bj * HALF) = pack8v(v0, v1);
                }
            }
    }
};

template <bool LAST> struct EpiResid {
    static constexpr bool PERM = true, AFTER_DRAIN = false;
    const float* xin; float* xout; bf16_t* xb; const float* bias; ssq_t* ssn;
    __device__ __forceinline__ void operator()(const f32x4 (&acc)[2][2][4][2], const Unit& u, int wr, int wc, int fr, int fq) const {
        const int row0 = u.pm * BM + wr * 64 + fr, col0 = u.pn * BM + wc * 32 + 8 * fq;
        f32x4 bv[2][2];
#pragma unroll
        for (int bj = 0; bj < 2; ++bj)
#pragma unroll
            for (int n = 0; n < 2; ++n) bv[bj][n] = bias ? *(const f32x4*)(bias + col0 + bj * HALF + 4 * n) : (f32x4){0.f, 0.f, 0.f, 0.f};
#pragma unroll
        for (int ai = 0; ai < 2; ++ai)
#pragma unroll
            for (int m = 0; m < 4; ++m) {
                const int row = row0 + ai * HALF + m * 16;
                const size_t off = (size_t)row * 1024 + col0;
                float sq = 0.f;
#pragma unroll
                for (int bj = 0; bj < 2; ++bj) {
                    const f32x4 x0 = *(const f32x4*)(xin + off + bj * HALF), x1 = *(const f32x4*)(xin + off + bj * HALF + 4);
                    const f32x4 v0 = acc[ai][bj][m][0] + x0 + bv[bj][0], v1 = acc[ai][bj][m][1] + x1 + bv[bj][1];
                    *(f32x4*)(xout + off + bj * HALF) = v0; *(f32x4*)(xout + off + bj * HALF + 4) = v1;
                    if (!LAST) { *(u32x4*)(xb + off + bj * HALF) = pack8v(v0, v1); sq += dot4(v0) + dot4(v1); }
                }
                if (!LAST) { sq = quad_sum(sq); if (fq == 0) ss_add(ssn + row, sq); }
                if (m & 1) asm volatile("" ::: "memory");
            }
    }
};

struct EpiDown {
    static constexpr bool PERM = true, AFTER_DRAIN = false;
    const ssq_t* ss; bf16_t* cq; bf16_t* ckv; bf16_t* kr; ssq_t* sscq; ssq_t* ssckv;
    __device__ __forceinline__ void operator()(const f32x4 (&acc)[2][2][4][2], const Unit& u, int wr, int wc, int fr, int fq) const {
        const int row0 = u.pm * BM + wr * 64 + fr, cw = wc * 32 + 8 * fq;
#pragma unroll
        for (int ai = 0; ai < 2; ++ai)
#pragma unroll
            for (int m = 0; m < 4; ++m) {
                const int row = row0 + ai * HALF + m * 16;
                const float rs = row_rstd(ss, row, 1.0f / 1024.0f);
                float sq_q = 0.f, sq_kv = 0.f;
#pragma unroll
                for (int bj = 0; bj < 2; ++bj) {
                    const int seg = u.pn * 2 + bj;
                    const f32x4 v0 = acc[ai][bj][m][0] * rs, v1 = acc[ai][bj][m][1] * rs;
                    const u32x4 w = pack8v(v0, v1);
                    if (seg < 3) { *(u32x4*)(cq + (size_t)row * 384 + seg * 128 + cw) = w; sq_q += dot4(v0) + dot4(v1); }
                    else if (seg < 5) { *(u32x4*)(ckv + (size_t)row * 256 + (seg - 3) * 128 + cw) = w; sq_kv += dot4(v0) + dot4(v1); }
                    else if (wc < 2) { *(u32x4*)(kr + (size_t)row * 64 + cw) = w; }
                }
                sq_q = quad_sum(sq_q); sq_kv = quad_sum(sq_kv);
                if (fq == 0) { if (u.pn <= 1) ss_add(sscq + row, sq_q); if (u.pn >= 1) ss_add(ssckv + row, sq_kv); }
            }
    }
};

struct EpiUQ {
    static constexpr bool PERM = true, AFTER_DRAIN = false;
    const ssq_t* ss; bf16_t* Q;
    __device__ __forceinline__ void operator()(const f32x4 (&acc)[2][2][4][2], const Unit& u, int wr, int wc, int fr, int fq) const {
        const int row0 = u.pm * BM + wr * 64 + fr, col0 = u.pn * BM + wc * 32 + 8 * fq;
#pragma unroll
        for (int ai = 0; ai < 2; ++ai)
#pragma unroll
            for (int m = 0; m < 4; ++m) {
                const int row = row0 + ai * HALF + m * 16, b = row >> 11, s = row & 2047;
                const float rs = row_rstd(ss, row, 1.0f / 384.0f);
#pragma unroll
                for (int bj = 0; bj < 2; ++bj) {
                    const int col = col0 + bj * HALF, h = col / 192, d = col - h * 192;
                    const f32x4 v0 = acc[ai][bj][m][0] * rs, v1 = acc[ai][bj][m][1] * rs;
                    *(u32x4*)(Q + ((size_t)((b * 8 + h) * 2048 + s)) * 192 + d) = pack8v(v0, v1);
                }
            }
    }
};

struct EpiUKV {
    static constexpr bool PERM = true, AFTER_DRAIN = false;
    const ssq_t* ss; bf16_t* Kn; bf16_t* V;
    __device__ __forceinline__ void operator()(const f32x4 (&acc)[2][2][4][2], const Unit& u, int wr, int wc, int fr, int fq) const {
        const int row0 = u.pm * BM + wr * 64 + fr, cw = wc * 32 + 8 * fq, h = u.pn;
#pragma unroll
        for (int ai = 0; ai < 2; ++ai)
#pragma unroll
            for (int m = 0; m < 4; ++m) {
                const int row = row0 + ai * HALF + m * 16, b = row >> 11, s = row & 2047;
                const float rs = row_rstd(ss, row, 1.0f / 256.0f);
                const size_t off = ((size_t)((b * 8 + h) * 2048 + s)) * 128 + cw;
                { const f32x4 v0 = acc[ai][0][m][0] * rs, v1 = acc[ai][0][m][1] * rs; *(u32x4*)(Kn + off) = pack8v(v0, v1); }
                { const f32x4 v0 = acc[ai][1][m][0] * rs, v1 = acc[ai][1][m][1] * rs; *(u32x4*)(V + off) = pack8v(v0, v1); }
            }
    }
};

struct EpiHG {
    static constexpr bool PERM = true, AFTER_DRAIN = false;
    const ssq_t* ss; const float* lb; bf16_t* hq; float* hlf; size_t sec_stride;
    __device__ __forceinline__ void operator()(const f32x4 (&acc)[2][2][4][2], const Unit& u, int wr, int wc, int fr, int fq) const {
        const int row0 = u.pm * BM + wr * 64 + fr, sec = u.pn >> 2, cc0 = (u.pn & 3) * BM + wc * 32 + 8 * fq;
        if (sec == 1) {
            f32x4 lbv[2][2];
#pragma unroll
            for (int bj = 0; bj < 2; ++bj)
#pragma unroll
                for (int n = 0; n < 2; ++n) lbv[bj][n] = *(const f32x4*)(lb + cc0 + bj * HALF + 4 * n);
#pragma unroll
            for (int ai = 0; ai < 2; ++ai)
#pragma unroll
                for (int m = 0; m < 4; ++m) {
                    const int row = row0 + ai * HALF + m * 16;
                    const float rs = row_rstd(ss, row, 1.0f / 1024.0f);
#pragma unroll
                    for (int bj = 0; bj < 2; ++bj)
#pragma unroll
                        for (int n = 0; n < 2; ++n) {
                            const f32x4 v = acc[ai][bj][m][n] * rs; f32x4 o;
#pragma unroll
                            for (int e = 0; e < 4; ++e) { const float l = lbv[bj][n][e]; o[e] = __logf(l + (1.0f - l) * sigm(v[e])); }
                            *(f32x4*)(hlf + (size_t)row * 1024 + cc0 + bj * HALF + 4 * n) = o;
                        }
                }
        } else {
            bf16_t* dst = hq + (size_t)((sec + 1) >> 1) * sec_stride;
#pragma unroll
            for (int ai = 0; ai < 2; ++ai)
#pragma unroll
                for (int m = 0; m < 4; ++m) {
                    const int row = row0 + ai * HALF + m * 16;
                    const float rs = row_rstd(ss, row, 1.0f / 1024.0f);
#pragma unroll
                    for (int bj = 0; bj < 2; ++bj) {
                        f32x4 v0 = acc[ai][bj][m][0] * rs, v1 = acc[ai][bj][m][1] * rs;
                        if (sec == 3) {
#pragma unroll
                            for (int e = 0; e < 4; ++e) { v0[e] = v0[e] * sigm(v0[e]); v1[e] = v1[e] * sigm(v1[e]); }
                        }
                        *(u32x4*)(dst + (size_t)row * 1024 + cc0 + bj * HALF) = pack8v(v0, v1);
                    }
                }
        }
    }
};

struct EpiGLU {
    static constexpr bool PERM = true, AFTER_DRAIN = false;
    const ssq_t* ss; const float* bias; bf16_t* cu;
    __device__ __forceinline__ void operator()(const f32x4 (&acc)[2][2][4][2], const Unit& u, int wr, int wc, int fr, int fq) const {
        const int row0 = u.pm * BM + wr * 64 + fr, j0 = u.pn * HALF + wc * 32 + 8 * fq;
        const f32x4 ba0 = *(const f32x4*)(bias + j0), ba1 = *(const f32x4*)(bias + j0 + 4), bg0 = *(const f32x4*)(bias + 1024 + j0), bg1 = *(const f32x4*)(bias + 1024 + j0 + 4);
#pragma unroll
        for (int ai = 0; ai < 2; ++ai)
#pragma unroll
            for (int m = 0; m < 4; ++m) {
                const int row = row0 + ai * HALF + m * 16;
                const float rs = row_rstd(ss, row, 1.0f / 1024.0f);
                f32x4 a0 = acc[ai][0][m][0] * rs + ba0, a1 = acc[ai][0][m][1] * rs + ba1;
                const f32x4 g0 = acc[ai][1][m][0] * rs + bg0, g1 = acc[ai][1][m][1] * rs + bg1;
#pragma unroll
                for (int e = 0; e < 4; ++e) { a0[e] *= sigm(g0[e]); a1[e] *= sigm(g1[e]); }
                *(u32x4*)(cu + (size_t)row * 1024 + j0) = pack8v(a0, a1);
            }
    }
};
template <class Epi, class Sched, bool ALIGN_EPI = false, bool SP2 = false>
__device__ __forceinline__ void gemm_phase(PG8_LAS unsigned char* lds, const Gemm g, const Sched& S, const Epi& E, int wave_s) {
    int tid_ = wave_s * 64 + mk_lane(); asm volatile("" : "+v"(tid_));
    const int tid = tid_, wid = __builtin_amdgcn_readfirstlane(tid >> 6), lane = tid & 63, wr = wid >> 2, wc = wid & 3, fr = lane & 15, fq = lane >> 4;
    const int K = g.K, nt = K / BK;
    unsigned voffA[2], voffB[2];
#pragma unroll
    for (int i = 0; i < 2; ++i) { int R, C; stage_rc(tid * 16 + i * 8192, R, C); const int Rb = Epi::PERM ? ((R & ~31) + perm32(R & 31)) : R;
        voffA[i] = (unsigned)(R * K + C) * 2u; voffB[i] = (unsigned)(Rb * K + C) * 2u; }
    const size_t kstep = (size_t)(BK * 2);
    const size_t hstep = (size_t)HALF * K * 2;
    const size_t tstep = 2 * hstep;
    const unsigned ldsw = (unsigned)wid * 1024u;
    const int aoff = lds_byte(wr * 64 + fr, fq * 8), boff = lds_byte(wc * 32 + fr, fq * 8);
#define PG8_SA(b, h) (((b) * 2 + (h)) * HTB)
#define PG8_SB(b, h) ((4 + (b) * 2 + (h)) * HTB)
#define PG8_STAGE(bufoff, gbase, voff) do { _Pragma("unroll") for (int _i = 0; _i < 2; ++_i) \
        __builtin_amdgcn_global_load_lds((const unsigned*)((const char*)(gbase) + (voff)[_i]), (PG8_LAS unsigned*)(lds + (bufoff) + ldsw + _i * 8192), 16, 0, 0); } while (0)
#define PG8_LDA(dst, b, h) do { _Pragma("unroll") for (int m = 0; m < 4; ++m) _Pragma("unroll") for (int k = 0; k < 2; ++k) dst[m][k] = *(const PG8_LAS bf16x8*)(lds + PG8_SA(b, h) + aoff + m * 2048 + k * 1024); } while (0)
#define PG8_LDB(dst, b, h) do { _Pragma("unroll") for (int n = 0; n < 2; ++n) _Pragma("unroll") for (int k = 0; k < 2; ++k) dst[n][k] = *(const PG8_LAS bf16x8*)(lds + PG8_SB(b, h) + boff + n * 2048 + k * 1024); } while (0)
#define PG8_MMA(ai, bj, At, Bt) do { __builtin_amdgcn_s_setprio(1); _Pragma("unroll") for (int m = 0; m < 4; ++m) _Pragma("unroll") for (int n = 0; n < 2; ++n) _Pragma("unroll") for (int k = 0; k < 2; ++k) \
        acc[ai][bj][m][n] = __builtin_amdgcn_mfma_f32_16x16x32_bf16(Bt[n][k], At[m][k], acc[ai][bj][m][n], 0, 0, 0); __builtin_amdgcn_s_setprio(0); } while (0)
#define PG8_WAIT_V(n) asm volatile("s_waitcnt vmcnt(" #n ")" ::: "memory")
#define PG8_WAIT_L(n) asm volatile("s_waitcnt lgkmcnt(" #n ")" ::: "memory")
#define PG8_BAR __builtin_amdgcn_s_barrier()
#define PG8_SCHED __builtin_amdgcn_sched_barrier(0)
    Unit cur, nxt; int ui = 0;
    if (!S.next(0, cur)) return;
    f32x4 acc[2][2][4][2];
#pragma unroll
    for (int a = 0; a < 2; ++a)
#pragma unroll
        for (int b = 0; b < 2; ++b)
#pragma unroll
            for (int m = 0; m < 4; ++m)
#pragma unroll
                for (int n = 0; n < 2; ++n) acc[a][b][m][n] = (f32x4){0.f, 0.f, 0.f, 0.f};
    bf16x8 At[4][2], B0[2][2], B1[2][2];
    const char* cA = (const char*)g.A + (size_t)cur.pm * tstep; const char* cB = (const char*)g.Bt + (size_t)cur.pn * tstep;
    S.a_ready(cur);
    if constexpr (SP2) {
        PG8_STAGE(PG8_SB(0, 0), cB, voffB); PG8_STAGE(PG8_SB(0, 1), cB + hstep, voffB); PG8_STAGE(PG8_SA(0, 0), cA, voffA); PG8_STAGE(PG8_SA(0, 1), cA + hstep, voffA);
        if (wr == 1) PG8_BAR;
        PG8_WAIT_V(2); PG8_BAR;
        PG8_STAGE(PG8_SB(1, 0), cB + kstep, voffB); PG8_STAGE(PG8_SA(1, 0), cA + kstep, voffA); PG8_STAGE(PG8_SB(1, 1), cB + hstep + kstep, voffB);
        PG8_WAIT_V(6); PG8_BAR;
    } else {
        PG8_STAGE(PG8_SB(0, 0), cB, voffB); PG8_STAGE(PG8_SA(0, 0), cA, voffA); PG8_STAGE(PG8_SB(0, 1), cB + hstep, voffB); PG8_STAGE(PG8_SA(0, 1), cA + hstep, voffA);
        if (wr == 1) PG8_BAR;
        PG8_WAIT_V(4); PG8_BAR;
        PG8_STAGE(PG8_SB(1, 0), cB + kstep, voffB); PG8_STAGE(PG8_SA(1, 0), cA + kstep, voffA); PG8_STAGE(PG8_SB(1, 1), cB + hstep + kstep, voffB);
        PG8_WAIT_V(6); PG8_BAR;
    }
    for (;;) {
        const bool has_next = S.next(ui + 1, nxt);
        const char* nA = has_next ? (const char*)g.A + (size_t)nxt.pm * tstep : cA; const char* nB = has_next ? (const char*)g.Bt + (size_t)nxt.pn * tstep : cB;
        for (int t = 0; t < nt; t += 2) {
            const bool last = (t == nt - 2);
            const char* a1 = cA + (size_t)(t + 1) * kstep;
            const char* a2 = last ? nA : cA + (size_t)(t + 2) * kstep; const char* b2 = last ? nB : cB + (size_t)(t + 2) * kstep;
            const char* a3 = a2 + kstep; const char* b3 = b2 + kstep;
            if (last && has_next) S.a_ready(nxt);
            if constexpr (SP2) {
            PG8_LDB(B0, 0, 0); PG8_LDB(B1, 0, 1); PG8_SCHED; PG8_LDA(At, 0, 0); PG8_STAGE(PG8_SA(1, 1), a1 + hstep, voffA);
            PG8_WAIT_V(8); PG8_WAIT_L(0); PG8_BAR; PG8_MMA(0, 0, At, B0); PG8_MMA(0, 1, At, B1); PG8_BAR; PG8_SCHED;
            PG8_LDA(At, 0, 1); PG8_STAGE(PG8_SB(0, 0), b2, voffB); PG8_STAGE(PG8_SB(0, 1), b2 + hstep, voffB); PG8_STAGE(PG8_SA(0, 0), a2, voffA);
            PG8_WAIT_V(8); PG8_WAIT_L(0); PG8_BAR; PG8_MMA(1, 0, At, B0); PG8_MMA(1, 1, At, B1); PG8_BAR; PG8_SCHED;
            PG8_LDB(B0, 1, 0); PG8_LDB(B1, 1, 1); PG8_SCHED; PG8_LDA(At, 1, 0); PG8_STAGE(PG8_SA(0, 1), a2 + hstep, voffA);
            PG8_WAIT_V(8); PG8_WAIT_L(0); PG8_BAR; PG8_MMA(0, 0, At, B0); PG8_MMA(0, 1, At, B1); PG8_BAR; PG8_SCHED;
            PG8_LDA(At, 1, 1); PG8_STAGE(PG8_SB(1, 0), b3, voffB); PG8_STAGE(PG8_SB(1, 1), b3 + hstep, voffB); PG8_STAGE(PG8_SA(1, 0), a3, voffA);
            PG8_WAIT_V(8); PG8_WAIT_L(0); PG8_BAR; PG8_MMA(1, 0, At, B0); PG8_MMA(1, 1, At, B1); PG8_BAR; PG8_SCHED;
            } else {
            PG8_LDB(B0, 0, 0); PG8_SCHED; PG8_LDA(At, 0, 0); PG8_STAGE(PG8_SA(1, 1), a1 + hstep, voffA);
            PG8_WAIT_L(8); PG8_BAR; PG8_WAIT_L(0); PG8_MMA(0, 0, At, B0); PG8_BAR; PG8_SCHED;
            PG8_LDB(B1, 0, 1); PG8_STAGE(PG8_SB(0, 0), b2, voffB);
            PG8_BAR; PG8_WAIT_L(0); PG8_MMA(0, 1, At, B1); PG8_BAR;
            PG8_LDA(At, 0, 1); PG8_STAGE(PG8_SA(0, 0), a2, voffA);
            PG8_BAR; PG8_WAIT_L(0); PG8_MMA(1, 0, At, B0); PG8_BAR; PG8_SCHED;
            PG8_STAGE(PG8_SB(0, 1), b2 + hstep, voffB);
            PG8_WAIT_V(6); PG8_BAR; PG8_MMA(1, 1, At, B1); PG8_BAR;
            PG8_LDB(B0, 1, 0); PG8_SCHED; PG8_LDA(At, 1, 0); PG8_STAGE(PG8_SA(0, 1), a2 + hstep, voffA);
            PG8_WAIT_L(8); PG8_BAR; PG8_WAIT_L(0); PG8_MMA(0, 0, At, B0); PG8_BAR; PG8_SCHED;
            PG8_LDB(B1, 1, 1); PG8_STAGE(PG8_SB(1, 0), b3, voffB);
            PG8_BAR; PG8_WAIT_L(0); PG8_MMA(0, 1, At, B1); PG8_BAR;
            PG8_LDA(At, 1, 1); PG8_STAGE(PG8_SA(1, 0), a3, voffA);
            PG8_BAR; PG8_WAIT_L(0); PG8_MMA(1, 0, At, B0); PG8_BAR; PG8_SCHED;
            PG8_STAGE(PG8_SB(1, 1), b3 + hstep, voffB);
            PG8_WAIT_V(6); PG8_BAR; PG8_MMA(1, 1, At, B1); PG8_BAR;
            }
        }
        if constexpr (ALIGN_EPI) { if (wr == 0) PG8_BAR; }
        if constexpr (!Epi::AFTER_DRAIN) { E(acc, cur, wr, wc, fr, fq); S.done(cur); }
        if (!has_next) break;
#pragma unroll
        for (int a = 0; a < 2; ++a)
#pragma unroll
            for (int b = 0; b < 2; ++b)
#pragma unroll
                for (int m = 0; m < 4; ++m)
#pragma unroll
                    for (int n = 0; n < 2; ++n) acc[a][b][m][n] = (f32x4){0.f, 0.f, 0.f, 0.f};
        cur = nxt; cA = nA; cB = nB; ++ui;
        if constexpr (ALIGN_EPI) { if (wr == 1) PG8_BAR; }
    }
    PG8_WAIT_V(0);
    if constexpr (!ALIGN_EPI) { if (wr == 0) PG8_BAR; }
    PG8_BAR;
    if constexpr (Epi::AFTER_DRAIN) { E.fused(acc, cur, wr, wc, fr, fq, lds, wid, lane); S.done(cur); }
#undef PG8_SA
#undef PG8_SB
#undef PG8_STAGE
#undef PG8_LDA
#undef PG8_LDB
#undef PG8_MMA
#undef PG8_WAIT_V
#undef PG8_WAIT_L
#undef PG8_BAR
#undef PG8_SCHED
}
}
namespace att {
typedef unsigned short bf16;
typedef short bf16x8 __attribute__((ext_vector_type(8)));
typedef short s16x4 __attribute__((ext_vector_type(4)));
typedef float f32x16 __attribute__((ext_vector_type(16)));
typedef float f32x4 __attribute__((ext_vector_type(4)));
typedef unsigned u32x4 __attribute__((ext_vector_type(4)));
constexpr int NW = 8, QBLK = 32, KVBLK = 64, QB = NW * QBLK;
constexpr int DN = 128, DR = 64, DQ = 192, DV = 128, SEQ = 2048, NH = 8, NB = 16, OSTR = 1024;
constexpr int SHM_V = KVBLK * DV * 2, SHM_K = KVBLK * DN * 2, RPAD = 144, SHM_R = KVBLK * RPAD;
constexpr int OFF_V = 0, OFF_K = 2 * SHM_V, OFF_R = OFF_K + 2 * SHM_K, OFF_WS = OFF_R + 2 * SHM_R, OFF_QS = OFF_WS + NW * 64 * 4, LDS_BYTES = OFF_QS + NW * 4096;
constexpr float SCALE = 0.07216878364870323f;
constexpr float THR = 8.f;
constexpr int WIN = 1 << 30;

#define KSWZ(row, colB) ((row) * 256 + ((colB) ^ (((row) & 7) << 4)))
#define SBAR() __builtin_amdgcn_sched_barrier(0)
__device__ __forceinline__ int v_st(int k, int c) { const int kk = (k & ~0xC) | ((k & 4) << 1) | ((k & 8) >> 1); return ((kk >> 3) * 4 + (c >> 5)) * 512 + ((kk & 7) * 32 + (c & 31)) * 2; }
__device__ __forceinline__ int v_rd_base(int lane) { return ((lane & 3) << 3) | (((lane >> 2) & 3) << 6) | (((lane >> 4) & 1) << 5) | (((lane >> 5) & 1) << 8); }
constexpr int v_rd_off(int d0, int ks, int half) { return d0 * 512 + ks * 4096 + half * 2048; }
__device__ __forceinline__ int crow(int r, int hi) { return (r & 3) + 8 * (r >> 2) + 4 * hi; }
__device__ __forceinline__ unsigned cvtpk(float lo, float hi) { unsigned r; asm volatile("v_cvt_pk_bf16_f32 %0, %1, %2" : "=v"(r) : "v"(lo), "v"(hi)); return r; }
__device__ __forceinline__ bf16x8 load8(const bf16* p) { return *reinterpret_cast<const bf16x8*>(p); }
__device__ __forceinline__ void mask_tile(f32x16& p0, f32x16& p1, int dq, unsigned W) {
    const float NEG = -__builtin_inff();
#pragma unroll
    for (int r = 0; r < 16; ++r) {
        const int c = (r & 3) + 8 * (r >> 2);
        if ((unsigned)(dq - c) >= W) p0[r] = NEG;
        if ((unsigned)(dq - c - 32) >= W) p1[r] = NEG;
    }
}
__device__ __forceinline__ void partialSM(f32x16& p0, f32x16& p1, float& m_reg, float& mn, float& alpha) {
    float pmax = p0[0]; for (int r = 1; r < 16; ++r) pmax = fmaxf(pmax, p0[r]); for (int r = 0; r < 16; ++r) pmax = fmaxf(pmax, p1[r]);
    { auto rr = __builtin_amdgcn_permlane32_swap(__float_as_uint(pmax), __float_as_uint(pmax), false, false);
      pmax = fmaxf(__uint_as_float(rr[0]), __uint_as_float(rr[1])); }
    constexpr float C2 = 1.4426950408889634f * SCALE;
    if (__builtin_expect(__all((pmax - m_reg) * SCALE <= THR), 1)) { mn = m_reg; alpha = 1.f; }
    else { mn = fmaxf(m_reg, pmax); alpha = __builtin_amdgcn_exp2f((m_reg - mn) * C2); m_reg = mn; }
    const float mnL = -mn * C2;
    for (int r = 0; r < 16; ++r) p0[r] = fmaf(p0[r], C2, mnL); for (int r = 0; r < 16; ++r) p1[r] = fmaf(p1[r], C2, mnL);
    for (int r = 0; r < 16; ++r) p0[r] = __builtin_amdgcn_exp2f(p0[r]);
}
__device__ __forceinline__ void finishSM(f32x16& p0, f32x16& p1, float alpha, float& l_reg, bf16x8& pa0, bf16x8& pa1, bf16x8& pa2, bf16x8& pa3) {
    for (int r = 0; r < 16; ++r) p1[r] = __builtin_amdgcn_exp2f(p1[r]);
    float ps = 0; for (int r = 0; r < 16; ++r) ps += p0[r]; for (int r = 0; r < 16; ++r) ps += p1[r];
    { auto rr = __builtin_amdgcn_permlane32_swap(__float_as_uint(ps), __float_as_uint(ps), false, false);
      ps = __uint_as_float(rr[0]) + __uint_as_float(rr[1]); }
    l_reg = l_reg * alpha + ps;
#define PK4(P, B_, OUT) do { unsigned a0 = cvtpk(P[B_+0], P[B_+1]), a1 = cvtpk(P[B_+2], P[B_+3]);                          \
        unsigned b0 = cvtpk(P[B_+4], P[B_+5]), b1 = cvtpk(P[B_+6], P[B_+7]);                                             \
        auto r0 = __builtin_amdgcn_permlane32_swap(a0, b0, false, false); auto r1 = __builtin_amdgcn_permlane32_swap(a1, b1, false, false); \
        u32x4 w = {r0[0], r1[0], r0[1], r1[1]}; OUT = *reinterpret_cast<bf16x8*>(&w); } while (0)
    PK4(p0, 0, pa0); PK4(p0, 8, pa1); PK4(p1, 0, pa2); PK4(p1, 8, pa3);
#undef PK4
}
template <int KB>
__device__ __forceinline__ void qkt(f32x16& p0, f32x16& p1, const char* K_lds, const char* R_lds, int r32, int hi, const bf16x8* qr, const char* qsp) {
    p0 = f32x16{}; p1 = f32x16{};
    const char* kb[4];
#pragma unroll
    for (int dd = 0; dd < 4; ++dd) kb[dd] = K_lds + KB * SHM_K + KSWZ(r32, (dd * 16 + hi * 8) * 2);
#pragma unroll
    for (int d0 = 0; d0 < 8; ++d0) { const char* a = kb[d0 & 3] + (d0 >> 2) * 128;
        bf16x8 b0 = *reinterpret_cast<const bf16x8*>(a);
        bf16x8 b1 = *reinterpret_cast<const bf16x8*>(a + 32 * 256);
        p0 = __builtin_amdgcn_mfma_f32_32x32x16_bf16(b0, qr[d0], p0, 0, 0, 0);
        p1 = __builtin_amdgcn_mfma_f32_32x32x16_bf16(b1, qr[d0], p1, 0, 0, 0); }
    const char* rb = R_lds + KB * SHM_R + r32 * RPAD + hi * 16;
#pragma unroll
    for (int d0 = 0; d0 < 4; ++d0) {
        bf16x8 b0 = *reinterpret_cast<const bf16x8*>(rb + d0 * 32);
        bf16x8 b1 = *reinterpret_cast<const bf16x8*>(rb + d0 * 32 + 32 * RPAD);
        const bf16x8 qf = *reinterpret_cast<const bf16x8*>(qsp + d0 * 1024);
        p0 = __builtin_amdgcn_mfma_f32_32x32x16_bf16(b0, qf, p0, 0, 0, 0);
        p1 = __builtin_amdgcn_mfma_f32_32x32x16_bf16(b1, qf, p1, 0, 0, 0); }
}
template <int VB>
__device__ __forceinline__ void pv_tile(f32x16* o, int vb0, bf16x8 pa0, bf16x8 pa1, bf16x8 pa2, bf16x8 pa3) {
#define TRRD(dst, off) asm volatile("ds_read_b64_tr_b16 %0, %1 offset:%2" : "=&v"(dst) : "v"(vb0), "i"(off) : "memory")
#define PV_D0(d0) do { s16x4 l0, l1, l2, l3, h0, h1, h2, h3; constexpr int b_ = VB * SHM_V + v_rd_off(d0, 0, 0);   \
        TRRD(l0, b_); TRRD(h0, b_ + 2048); TRRD(l1, b_ + 4096); TRRD(h1, b_ + 6144); TRRD(l2, b_ + 8192); TRRD(h2, b_ + 10240); TRRD(l3, b_ + 12288); TRRD(h3, b_ + 14336); \
        asm volatile("s_waitcnt lgkmcnt(0)" ::: "memory"); SBAR();   \
        o[d0] = __builtin_amdgcn_mfma_f32_32x32x16_bf16(pa0, (bf16x8){l0[0], l0[1], l0[2], l0[3], h0[0], h0[1], h0[2], h0[3]}, o[d0], 0, 0, 0);   \
        o[d0] = __builtin_amdgcn_mfma_f32_32x32x16_bf16(pa1, (bf16x8){l1[0], l1[1], l1[2], l1[3], h1[0], h1[1], h1[2], h1[3]}, o[d0], 0, 0, 0);   \
        o[d0] = __builtin_amdgcn_mfma_f32_32x32x16_bf16(pa2, (bf16x8){l2[0], l2[1], l2[2], l2[3], h2[0], h2[1], h2[2], h2[3]}, o[d0], 0, 0, 0);   \
        o[d0] = __builtin_amdgcn_mfma_f32_32x32x16_bf16(pa3, (bf16x8){l3[0], l3[1], l3[2], l3[3], h3[0], h3[1], h3[2], h3[3]}, o[d0], 0, 0, 0); } while (0)
    PV_D0(0); PV_D0(1); PV_D0(2); PV_D0(3);
#undef PV_D0
#undef TRRD
}

struct BlockRef { const bf16* Q; const bf16* K; const bf16* R; const bf16* V; bf16* O; int P0; };
__device__ __forceinline__ BlockRef make_ref(int L, int pass, const bf16* Q, const bf16* K, const bf16* R, const bf16* V, bf16* O) {
    const int xcd = L & 7, k = L >> 3, bh = (k >> 2) * 8 + xcd, x = k & 3, qb = pass ? 7 - x : x, b = bh >> 3, h = bh & 7;
    BlockRef r;
    r.Q = Q + ((size_t)bh * SEQ + (size_t)qb * QB) * DQ; r.K = K + (size_t)bh * SEQ * DN; r.V = V + (size_t)bh * SEQ * DV; r.R = R + (size_t)b * SEQ * DR;
    r.O = O + ((size_t)b * SEQ + (size_t)qb * QB) * OSTR + h * DV; r.P0 = qb * QB;
    return r;
}
#define ROW(p, k0, rr) ((p) + (size_t)((k0) + (rr)) * 128 + sc)
#define RROW(p, k0) ((p) + (size_t)((k0) + rsr) * 64 + rsc)
#define VMW() asm volatile("s_waitcnt vmcnt(0)" ::: "memory")
#define SLOAD_H(Kp, Rp, Vp, k0) do { st_v0 = load8(ROW(Vp, k0, sr)); st_v1 = load8(ROW(Vp, k0, 32 + sr));              \
                         st_k0 = load8(ROW(Kp, k0, sr)); st_k1 = load8(ROW(Kp, k0, 32 + sr)); st_r = load8(RROW(Rp, k0)); } while (0)
#define SWRITE_H(bf) do { *(bf16x8*)(V_lds + (bf) * SHM_V + vst0) = st_v0; *(bf16x8*)(V_lds + (bf) * SHM_V + vst1) = st_v1; \
                          *(bf16x8*)(K_lds + (bf) * SHM_K + kws) = st_k0; *(bf16x8*)(K_lds + (bf) * SHM_K + kws + 32 * 256) = st_k1; *(bf16x8*)(R_lds + (bf) * SHM_R + rws) = st_r; } while (0)
__device__ __forceinline__ void attn_phase(char* lds, const bf16* Q, const bf16* K, const bf16* R, const bf16* V, bf16* O, int G, int c, int wave_s) {
    constexpr int total = 4 * NB * NH;
    int tid_ = wave_s * 64 + mk_lane(); asm volatile("" : "+v"(tid_));
    const int tid = tid_, wid = __builtin_amdgcn_readfirstlane(tid >> 6), lane = tid & 63, r32 = lane & 31, hi = lane >> 5;
    int L = c; if (L >= total) return;
    int pass = 0;
    BlockRef cur = make_ref(L, 0, Q, K, R, V, O);
    char* V_lds = lds + OFF_V; char* K_lds = lds + OFF_K; char* R_lds = lds + OFF_R;
    float* ws = (float*)(lds + OFF_WS) + wid * 64; float* li_l = ws, * al_l = ws + 32;
    char* qsp = lds + OFF_QS + wid * 4096 + lane * 16;
    const int sr = tid >> 4, sc = (tid & 15) * 8, vst0 = v_st(sr, sc), vst1 = v_st(32 + sr, sc), kws = KSWZ(sr, sc * 2);
    const int rsr = tid >> 3, rsc = (tid & 7) * 8, rws = rsr * RPAD + rsc * 2;
    const int vb0 = (int)(uintptr_t)V_lds + v_rd_base(lane);
    bf16x8 st_v0, st_v1, st_k0, st_k1, st_r;
    SLOAD_H(cur.K, cur.R, cur.V, 0); VMW(); SWRITE_H(0);
    __syncthreads();
    for (;;) {
        const bool more_pass = pass == 0, more_item = L + G < total, last = !more_pass && !more_item;
        int passn = pass + 1, Ln = L;
        if (!more_pass) { passn = 0; Ln = more_item ? L + G : L; }
        const BlockRef nxt = last ? cur : make_ref(Ln, passn, Q, K, R, V, O);
        const int NT = cur.P0 / KVBLK + 4;
        const int qlo = cur.P0 + wid * QBLK, qm = qlo + r32 - 4 * hi;
        bf16x8 qr[8];
        { const bf16* qp = cur.Q + (size_t)(wid * QBLK + r32) * DQ + hi * 8;
#pragma unroll
          for (int d0 = 0; d0 < 8; ++d0) qr[d0] = load8(qp + d0 * 16);
#pragma unroll
          for (int d0 = 0; d0 < 4; ++d0) *reinterpret_cast<bf16x8*>(qsp + d0 * 1024) = load8(qp + 128 + d0 * 16); }
        float m_reg = -1e30f, l_reg = 0; f32x16 o[4] = {};
        const bf16* Kh = cur.K; const bf16* Vh = cur.V; const bf16* Rh = cur.R;
#define RESC(a) do { if (__any((a) < 1.f)) { if (hi == 0) al_l[r32] = (a); asm volatile("s_waitcnt lgkmcnt(0)" ::: "memory");              \
                     for (int d_ = 0; d_ < 4; ++d_) for (int r = 0; r < 16; ++r) o[d_][r] *= al_l[crow(r, hi)]; } } while (0)
#define TILE(t, RB) do { const int kb_ = (t) * KVBLK;                                                                        \
        if (kb_ <= qlo + QBLK - 1) {                                           \
            f32x16 p0, p1; float mn, al; bf16x8 pa0, pa1, pa2, pa3;                                                          \
            SBAR(); qkt<RB>(p0, p1, K_lds, R_lds, r32, hi, qr, qsp);                                                         \
            if (kb_ + KVBLK - 1 > qlo) mask_tile(p0, p1, qm - kb_, (unsigned)WIN);                                            \
            partialSM(p0, p1, m_reg, mn, al); RESC(al);                                                                      \
            finishSM(p0, p1, al, l_reg, pa0, pa1, pa2, pa3); SBAR();                                                         \
            pv_tile<RB>(o, vb0, pa0, pa1, pa2, pa3); } } while (0)
        for (int t = 0; t < NT; t += 2) {
            SLOAD_H(Kh, Rh, Vh, (t + 1) * KVBLK); SBAR();
            TILE(t, 0);
            VMW(); SWRITE_H(1); __syncthreads();
            const bool lt = t + 2 >= NT;
            if (!lt) { SLOAD_H(Kh, Rh, Vh, (t + 2) * KVBLK); } else { SLOAD_H(nxt.K, nxt.R, nxt.V, 0); }
            SBAR();
            TILE(t + 1, 1);
            VMW(); SWRITE_H(0); __syncthreads();
        }
        if (hi == 0) li_l[r32] = l_reg; asm volatile("s_waitcnt lgkmcnt(0)" ::: "memory");
        float rli[16];
#pragma unroll
        for (int r = 0; r < 16; ++r) rli[r] = __builtin_amdgcn_rcpf(li_l[crow(r, hi)]);
        bf16* Ow = cur.O + (size_t)(wid * QBLK) * OSTR;
        bf16* stg = (bf16*)(lds + OFF_QS + wid * 4096);
#pragma unroll
        for (int hf = 0; hf < 2; ++hf) {
#pragma unroll
            for (int r = 0; r < 16; ++r) { const int orow = crow(r, hi);
#pragma unroll
                for (int d = 0; d < 2; ++d) stg[orow * 64 + d * 32 + r32] = (bf16)(cvtpk(o[2 * hf + d][r] * rli[r], 0.f) & 0xffffu); }
            asm volatile("s_waitcnt lgkmcnt(0)" ::: "memory");
#pragma unroll
            for (int i = 0; i < 4; ++i) { const int row = i * 8 + (lane >> 3), ch = lane & 7; const u32x4 v = *(const u32x4*)(stg + row * 64 + ch * 8); *(u32x4*)(Ow + (size_t)row * OSTR + hf * 64 + ch * 8) = v; }
            asm volatile("s_waitcnt lgkmcnt(0)" ::: "memory");
        }
#undef RESC
#undef TILE
        if (last) break;
        cur = nxt; pass = passn; L = Ln;
    }
    __syncthreads();
}
#undef ROW
#undef RROW
#undef VMW
#undef SLOAD_H
#undef SWRITE_H
#undef KSWZ
#undef SBAR
}
#define GAS __attribute__((address_space(1)))
#define LAS __attribute__((address_space(3)))
typedef unsigned short bf16;
typedef unsigned v4u __attribute__((ext_vector_type(4)));
typedef float f32x4 __attribute__((ext_vector_type(4)));
typedef short bf16x8 __attribute__((ext_vector_type(8)));
typedef GAS unsigned gu32;
typedef GAS unsigned long long gu64;
#define RLX_AGENT __ATOMIC_RELAXED, __HIP_MEMORY_SCOPE_AGENT
#define LDS_WAIT() asm volatile("s_waitcnt lgkmcnt(0)" ::: "memory")
#define VM_WAIT() asm volatile("s_waitcnt vmcnt(0)" ::: "memory")
__device__ __forceinline__ unsigned long long rt() { return __builtin_amdgcn_s_memrealtime(); }
__device__ __forceinline__ unsigned f2bf(float f) { unsigned u = __builtin_bit_cast(unsigned, f); return (u + 0x7fffu + ((u >> 16) & 1u)) >> 16; }
__device__ __forceinline__ unsigned pk2(float lo, float hi) { return f2bf(lo) | (f2bf(hi) << 16); }
#define XB_TMO      128
#define XB_XCNT(j)  (256  + 64 * (j))
#define XB_XSUB(j)  (1280 + 64 * (j))
#define XB_XGEN(j)  (2304 + 64 * (j))
#define XB_TOP      3328
#define XB_TOPGEN   3392
#define XCD_BAR_WORDS 3456
#define XB_SPIN_CAP (1u << 18)

__device__ __forceinline__ unsigned xb_ld(unsigned* p)              { return __hip_atomic_load(p, __ATOMIC_RELAXED, __HIP_MEMORY_SCOPE_AGENT); }
__device__ __forceinline__ unsigned xb_add(unsigned* p, unsigned v) { return __hip_atomic_fetch_add(p, v, __ATOMIC_RELAXED, __HIP_MEMORY_SCOPE_AGENT); }
__device__ __forceinline__ unsigned xb_xcc_id() { return (unsigned)__builtin_amdgcn_s_getreg((3 << 11) | 20) & 0xFu; }
#define XB_SPIN(cond, bar) do { unsigned _sp = 0; while (cond) { __builtin_amdgcn_s_sleep(1); \
    if ((++_sp & 255u) == 0u) { if (xb_ld(&(bar)[XB_TMO])) break; if (_sp > XB_SPIN_CAP) { atomicAdd(&(bar)[XB_TMO], 1u); break; } } } } while (0)

struct XcdBarrier {
    unsigned* bar; unsigned x;
    volatile LAS unsigned* st;
};

__device__ __forceinline__ XcdBarrier xcd_barrier_post(unsigned* bar, volatile LAS unsigned* st, bool t0  ) {
    XcdBarrier b; b.bar = bar; b.x = xb_xcc_id(); b.st = st;
    if (t0) (void)xb_add(&bar[XB_XCNT(b.x)], 1u);
    return b;
}
__device__ __forceinline__ void xcd_barrier_complete(unsigned* bar, unsigned x, unsigned& nloc, unsigned& nx) {
    const unsigned G = gridDim.x * gridDim.y * gridDim.z;
    unsigned sum, cnt, mine, sp = 0u;
    for (;;) {
        sum = 0u; cnt = 0u; mine = 0u;
#pragma unroll
        for (unsigned j = 0; j < 16; ++j) { const unsigned c = xb_ld(&bar[XB_XCNT(j)]); sum += c; cnt += (c > 0u) ? 1u : 0u; mine = (j == x) ? c : mine; }
        if (sum == G) break;
        __builtin_amdgcn_s_sleep(1);
        if ((++sp & 255u) == 0u) { if (xb_ld(&bar[XB_TMO])) break; if (sp > XB_SPIN_CAP) { atomicAdd(&bar[XB_TMO], 1u); break; } }
    }
    nloc = mine > 0u ? mine : 1u; nx = cnt > 0u ? cnt : 1u;
}

__device__ __forceinline__ void xcd_barrier(const XcdBarrier& b, bool t0) {
    asm volatile("s_waitcnt vmcnt(0)" ::: "memory");
    __syncthreads();
    if (t0) {
        unsigned* bar = b.bar;
        __builtin_amdgcn_s_waitcnt(0);
        unsigned nloc = b.st[0], nx = b.st[1];
        if (nloc == 0u) { xcd_barrier_complete(bar, b.x, nloc, nx); b.st[0] = nloc; b.st[1] = nx; }
        const unsigned old = xb_add(&bar[XB_XSUB(b.x)], 1u);
        const unsigned gen = old / nloc;
        if (old + 1u == (gen + 1u) * nloc) {
            __builtin_amdgcn_fence(__ATOMIC_RELEASE, "agent");
            asm volatile("s_waitcnt vmcnt(0)" ::: "memory");
            const unsigned og = xb_add(&bar[XB_TOP], 1u);
            const unsigned tg = og / nx;
            if (og + 1u == (tg + 1u) * nx) xb_add(&bar[XB_TOPGEN], 1u);
            else XB_SPIN(xb_ld(&bar[XB_TOPGEN]) == tg, bar);
            __builtin_amdgcn_fence(__ATOMIC_ACQUIRE, "agent");
            xb_add(&bar[XB_XGEN(b.x)], 1u);
            asm volatile("s_waitcnt vmcnt(0)" ::: "memory");
        } else {
            XB_SPIN(xb_ld(&bar[XB_XGEN(b.x)]) == gen, bar);
            __builtin_amdgcn_fence(__ATOMIC_ACQUIRE, "agent");
            asm volatile("s_waitcnt vmcnt(0)" ::: "memory");
        }
    }
    __syncthreads();
}
constexpr int NWAVES = 8;
constexpr int BATCH = 16, SEQ = 2048, T = BATCH * SEQ, D = 1024, FF = 4096;
constexpr int NPHASE = 25;
#ifndef MK_PER_PHASE
#define MK_PER_PHASE 1
#endif

constexpr size_t MiB = 1u << 20;
constexpr size_t WS_CTL = 0, CTL_ZERO_BYTES = 4 * MiB;
constexpr size_t CTL_SS = 256 * 1024;
constexpr size_t CTL_SSCQ = CTL_SS + 8 * (size_t)T * 8;
constexpr size_t CTL_SSCKV = CTL_SSCQ + 2 * (size_t)T * 8;
static_assert(CTL_SSCKV + 2 * (size_t)T * 8 <= CTL_ZERO_BYTES, "ctl");
constexpr size_t WS_W = 4 * MiB;
constexpr size_t W_MI = 0, W_MO = W_MI + 4 * (size_t)FF * D, W_DN = W_MO + 4 * (size_t)FF * D, W_UQ = W_DN + 2 * (size_t)768 * 1024, W_UKV = W_UQ + 2 * (size_t)1536 * 384,
                 W_AO = W_UKV + 2 * (size_t)2048 * 256, W_HI = W_AO + 2 * (size_t)1024 * 1024, W_HO = W_HI + (size_t)4096 * 1024, W_P1 = W_HO + (size_t)1024 * 1024,
                 W_P2 = W_P1 + (size_t)2048 * 1024, W_END = W_P2 + (size_t)1024 * 1024;
constexpr size_t WS_LB = WS_W + W_END * 2;
constexpr size_t WS_PV = WS_LB + 4096;
constexpr int PV_GQ = 0, PV_GK = 384, PV_ON = 768, PV_BP1 = 896, PV_WDW = 2944, PV_BDW = 34688, PV_LNG = 35712, PV_LNB = 36736, PV_BP2 = 37760, PV_POS = 38784, PV_END = PV_POS + T;
static_assert(WS_PV + (size_t)PV_END * 4 <= 96 * MiB, "weights + params");
constexpr size_t WS_XB = 96 * MiB;
constexpr size_t WS_OV = 160 * MiB;
constexpr size_t WS_HH = WS_OV;
constexpr size_t WS_Q = WS_OV, WS_K = WS_OV + 96 * MiB, WS_V = WS_OV + 160 * MiB, WS_O = WS_OV + 224 * MiB, WS_CQ = WS_OV + 288 * MiB, WS_CKV = WS_OV + 312 * MiB, WS_KR = WS_OV + 328 * MiB;
constexpr size_t WS_HQ = WS_OV, WS_HV = WS_OV + 64 * MiB, WS_HG = WS_OV + 128 * MiB, WS_HLF = WS_OV + 192 * MiB;
constexpr size_t WS_CU = WS_OV, WS_CY = WS_OV + 64 * MiB;
constexpr size_t WS_END = 512 * MiB;
static_assert(WS_KR + (size_t)T * 64 * 2 <= WS_END && WS_HLF + (size_t)T * 1024 * 4 <= WS_END && WS_HH + (size_t)T * FF * 2 <= WS_O + 0 * MiB + 64 * MiB, "ws map");

constexpr int CW_BAR = 4096;

constexpr int RING_OFF = 0, RING_BYTES = 131072;
constexpr int LDSCTL_OFF = RING_BYTES, MISC_OFF = LDSCTL_OFF + 320, EXTRA_OFF = RING_BYTES + 1024;
constexpr int LDS_BYTES = 147456;

__device__ __forceinline__ float wave_sum(float v) {
#pragma unroll
    for (int o = 1; o < 64; o <<= 1) v += __shfl_xor(v, o);
    return v;
}
__device__ __forceinline__ float bf2f(unsigned h) { return __builtin_bit_cast(float, h << 16); }
__device__ __forceinline__ void p0_transpose_item(const float* W, int K, int N, const float* gain, bf16* WT, int dst_row0, LAS float* scr, int k0, int n0, int lane) {
#pragma unroll 8
    for (int i = 0; i < 32; ++i) { const int kk = 2 * i + (lane >> 5); const float gk = gain ? gain[k0 + kk] : 1.0f; scr[kk * 33 + (lane & 31)] = W[(size_t)(k0 + kk) * N + n0 + (lane & 31)] * gk; }
    LDS_WAIT(); asm volatile("" ::: "memory");
    const int c = lane & 7;
#pragma unroll
    for (int j = 0; j < 4; ++j) { const int n = (lane >> 3) + 8 * j; const LAS float* s = scr + (8 * c) * 33 + n;
        v4u o; o.x = pk2(s[0 * 33], s[1 * 33]); o.y = pk2(s[2 * 33], s[3 * 33]); o.z = pk2(s[4 * 33], s[5 * 33]); o.w = pk2(s[6 * 33], s[7 * 33]);
        *(GAS v4u*)(WT + (size_t)(dst_row0 + n) * K + k0 + 8 * c) = o; }
    LDS_WAIT(); asm volatile("" ::: "memory");
}

struct Args {
    const float* in[26]; float* out; unsigned char* ws; int ph_lo, ph_hi, li, pad;
};

#define P0_MAT(cnt_per, nmats, Wbase, Wstride, Kd, Nd, gainexpr, WTbase, WTstride) \
    if (r < (cnt_per) * (nmats)) { const int mi = r / (cnt_per), it = r % (cnt_per); const int nnb = (Nd) / 32, kb = it / nnb, nb = it % nnb; \
        p0_transpose_item((Wbase) + (size_t)mi * (Wstride), (Kd), (Nd), (gainexpr), (WTbase) + (size_t)mi * (WTstride), 32 * nb, scr, 64 * kb, 32 * nb, lane); continue; } r -= (cnt_per) * (nmats);

__device__ __forceinline__ void p0_prologue(const Args& a, LAS unsigned char* lds, int vcu, int G, int tid, int lane, int wave) {
    unsigned char* ws = a.ws;
    bf16* Wb = (bf16*)(ws + WS_W);
    LAS float* scr = (LAS float*)(lds + RING_OFF + wave * 16384);
    const int gw = vcu * NWAVES + wave, NGW = G * NWAVES;
    const float* norm_mix = a.in[2]; const float* norm_mlp = a.in[3];
    constexpr int I_MI = 16 * 128, I_MO = 64 * 32, I_DN = 16 * 22, I_UQ = 6 * 48, I_UKV = 4 * 64, I_SQ = 16 * 32, I_HI = 16 * 128, I_P1 = 16 * 64;
    constexpr int NITEMS = 4 * I_MI + 4 * I_MO + 2 * I_DN + 2 * I_UQ + 2 * I_UKV + 2 * I_SQ + I_HI + I_SQ + I_P1 + I_SQ;
    for (int item = gw; item < NITEMS; item += NGW) {
        int r = item;
        P0_MAT(I_MI, 4, a.in[4], (size_t)D * FF, D, FF, norm_mlp + mi * D, Wb + W_MI, (size_t)FF * D)
        P0_MAT(I_MO, 4, a.in[5], (size_t)FF * D, FF, D, (const float*)nullptr, Wb + W_MO, (size_t)FF * D)
        P0_MAT(I_DN, 2, a.in[6], (size_t)D * 704, D, 704, norm_mix + mi * 3 * D, Wb + W_DN, (size_t)768 * D)
        P0_MAT(I_UQ, 2, a.in[9], (size_t)384 * 1536, 384, 1536, a.in[7] + mi * 384, Wb + W_UQ, (size_t)1536 * 384)
        P0_MAT(I_UKV, 2, a.in[10], (size_t)256 * 2048, 256, 2048, a.in[8] + mi * 256, Wb + W_UKV, (size_t)2048 * 256)
        P0_MAT(I_SQ, 2, a.in[13], (size_t)D * D, D, D, (const float*)nullptr, Wb + W_AO, (size_t)D * D)
        P0_MAT(I_HI, 1, a.in[14], 0, D, FF, norm_mix + 1 * D, Wb + W_HI, 0)
        P0_MAT(I_SQ, 1, a.in[17], 0, D, D, (const float*)nullptr, Wb + W_HO, 0)
        if (r < I_P1) {
            const int nnb = 2048 / 32, kb = r / nnb, nb = r % nnb, n0 = 32 * nb, bj = n0 >> 10, j0 = n0 & 1023;
            p0_transpose_item(a.in[18], D, 2048, norm_mix + 2 * D, Wb + W_P1, 256 * (j0 >> 7) + 128 * bj + (j0 & 127), scr, 64 * kb, n0, lane); continue; }
        r -= I_P1;
        { const int nnb = D / 32, kb = r / nnb, nb = r % nnb; p0_transpose_item(a.in[24], D, D, nullptr, Wb + W_P2, 32 * nb, scr, 64 * kb, 32 * nb, lane); }
    }
    for (int i = vcu * 512 + tid; i < 2 * 8192; i += G * 512) { const int j = i >> 13, ch = i & 8191; *(GAS v4u*)(Wb + W_DN + (size_t)j * 768 * D + (size_t)704 * D + ch * 8) = (v4u){0u, 0u, 0u, 0u}; }
    for (int c = vcu * 512 + tid; c < 1024; c += G * 512) {
        const float* lg = a.in[15]; const float l0 = lg[c], l1 = lg[1024 + c], l2 = lg[2048 + c], l3 = lg[3072 + c];
        const float mx = fmaxf(fmaxf(l0, l1), fmaxf(l2, l3)); const float e0 = expf(l0 - mx), e1 = expf(l1 - mx), e2 = expf(l2 - mx), e3 = expf(l3 - mx);
        ((float*)(ws + WS_LB))[c] = e1 / (e0 + e1 + e2 + e3);
    }
    { float* pv = (float*)(ws + WS_PV); const int gt = vcu * 512 + tid, NT_ = G * 512;
#define P0_COPY(dst, src, n) for (int i = gt; i < (n); i += NT_) pv[(dst) + i] = (src)[i];
      P0_COPY(PV_GQ, a.in[11], 384) P0_COPY(PV_GK, a.in[12], 384) P0_COPY(PV_ON, a.in[16], 128) P0_COPY(PV_BP1, a.in[19], 2048) P0_COPY(PV_WDW, a.in[20], 31 * 1024)
      P0_COPY(PV_BDW, a.in[21], 1024) P0_COPY(PV_LNG, a.in[22], 1024) P0_COPY(PV_LNB, a.in[23], 1024) P0_COPY(PV_BP2, a.in[25], 1024) P0_COPY(PV_POS, a.in[1], T)
#undef P0_COPY
    }
    const float* x = a.in[0]; bf16* xb = (bf16*)(ws + WS_XB); unsigned long long* ss0 = (unsigned long long*)(ws + CTL_SS);
    for (int m = gw; m < T; m += NGW) {
        const GAS f32x4* xr = (const GAS f32x4*)(x + (size_t)m * D) + lane;
        f32x4 v[4]; float s = 0.f;
#pragma unroll
        for (int j = 0; j < 4; ++j) { v[j] = xr[64 * j]; s += (v[j].x * v[j].x + v[j].y * v[j].y) + (v[j].z * v[j].z + v[j].w * v[j].w); }
        s = wave_sum(s);
        GAS unsigned long long* o8 = (GAS unsigned long long*)(xb + (size_t)m * D) + lane;
#pragma unroll
        for (int j = 0; j < 4; ++j) o8[64 * j] = (unsigned long long)pk2(v[j].x, v[j].y) | ((unsigned long long)pk2(v[j].z, v[j].w) << 32);
        if (lane == 0) ss0[m] = (unsigned long long)(s * 1048576.0f + 0.5f);
    }
}

__device__ __forceinline__ void mla_finalize(const int* pos, const float* gq, const float* gk, bf16* Q, bf16* Kn, bf16* Kr, int vcu, int G, int lane, int wave) {
    const int gw = vcu * NWAVES + wave, NGW = G * NWAVES;
    const float gq0 = gq[2 * lane], gq1 = gq[2 * lane + 1], gqr = gq[128 + lane], gk0 = gk[2 * lane], gk1 = gk[2 * lane + 1], gkr = gk[128 + lane];
    const float inv_freq = powf(10000.0f, -(float)(2 * (lane & 31)) / 64.0f);
    for (int row = gw; row < T; row += NGW) {
        const int b = row >> 11, s = row & 2047;
        const float ang = (float)pos[row] * inv_freq; float sn, cs; sincosf(ang, &sn, &cs);
        const float sgn = lane < 32 ? -sn : sn;
#pragma unroll 2
        for (int h = 0; h < 8; ++h) {
            bf16* qp = Q + ((size_t)((b * 8 + h) * 2048 + s)) * 192; bf16* kp = Kn + ((size_t)((b * 8 + h) * 2048 + s)) * 128;
            const unsigned wq = *(const unsigned*)(qp + 2 * lane), wk = *(const unsigned*)(kp + 2 * lane); const unsigned er = qp[128 + lane];
            float a0 = bf2f(wq & 0xffffu), a1 = bf2f(wq >> 16), k0 = bf2f(wk & 0xffffu), k1 = bf2f(wk >> 16), e = bf2f(er);
            const float sq = wave_sum(a0 * a0 + a1 * a1), sk = wave_sum(k0 * k0 + k1 * k1), se = wave_sum(e * e);
            const float rq = rsqrtf(sq * (1.0f / 128.0f) + 1e-6f), rk = rsqrtf(sk * (1.0f / 128.0f) + 1e-6f), re = rsqrtf(se * (1.0f / 64.0f) + 1e-6f);
            *(unsigned*)(qp + 2 * lane) = pk2(a0 * rq * gq0, a1 * rq * gq1);
            *(unsigned*)(kp + 2 * lane) = pk2(k0 * rk * gk0, k1 * rk * gk1);
            e = e * re * gqr; const float pe = __shfl_xor(e, 32);
            qp[128 + lane] = (bf16)f2bf(e * cs + pe * sgn);
        }
        { bf16* rp = Kr + (size_t)row * 64; float e = bf2f(rp[lane]); const float se = wave_sum(e * e); e = e * rsqrtf(se * (1.0f / 64.0f) + 1e-6f) * gkr;
          const float pe = __shfl_xor(e, 32); rp[lane] = (bf16)f2bf(e * cs + pe * sgn); }
    }
}

__device__ __forceinline__ void hgrn_scan_simple(LAS unsigned char* lds, bf16* hq, const bf16* hv, const bf16* hg, const float* hlf, const float* onorm, int unit, int tid) {
    LAS float* Lf = (LAS float*)(lds); LAS float* Lk = Lf + 4096; LAS float* Lq = Lk + 4096; LAS float* Lv = Lq + 4096; LAS float* Lp = Lv + 4096;
    const int b = unit >> 3, h = unit & 7, dv = tid & 127, kg = tid >> 7;
    float S[32];
#pragma unroll
    for (int j = 0; j < 32; ++j) S[j] = 0.f;
    for (int c0 = 0; c0 < SEQ; c0 += 32) {
#pragma unroll
        for (int i = 0; i < 8; ++i) { const int idx = tid + 512 * i, t = idx >> 7, c = idx & 127; const size_t g = (size_t)(b * SEQ + c0 + t) * 1024 + h * 128 + c;
            const float f = __expf(hlf[g]); Lf[idx] = f; Lk[idx] = 1.0f - f; Lq[idx] = bf2f(hq[g]); Lv[idx] = bf2f(hv[g]); }
        __syncthreads();
        for (int t = 0; t < 32; ++t) {
            const float vv = Lv[t * 128 + dv]; float acc = 0.f;
            const LAS f32x4* pf = (const LAS f32x4*)(Lf + t * 128 + kg * 32); const LAS f32x4* pk = (const LAS f32x4*)(Lk + t * 128 + kg * 32); const LAS f32x4* pq = (const LAS f32x4*)(Lq + t * 128 + kg * 32);
#pragma unroll
            for (int j4 = 0; j4 < 8; ++j4) { const f32x4 f4 = pf[j4], k4 = pk[j4], q4 = pq[j4];
#pragma unroll
                for (int e = 0; e < 4; ++e) { const int j = j4 * 4 + e; S[j] = f4[e] * S[j] + k4[e] * vv; acc += q4[e] * S[j]; } }
            Lp[(kg * 32 + t) * 128 + dv] = acc;
        }
        __syncthreads();
        { const int t = tid >> 4, d0 = (tid & 15) * 8; float o[8]; float sq = 0.f;
#pragma unroll
            for (int e = 0; e < 8; ++e) { o[e] = (Lp[(0 * 32 + t) * 128 + d0 + e] + Lp[(1 * 32 + t) * 128 + d0 + e]) + (Lp[(2 * 32 + t) * 128 + d0 + e] + Lp[(3 * 32 + t) * 128 + d0 + e]); sq += o[e] * o[e]; }
            sq += __shfl_xor(sq, 1); sq += __shfl_xor(sq, 2); sq += __shfl_xor(sq, 4); sq += __shfl_xor(sq, 8);
            const float rn = rsqrtf(sq * (1.0f / 128.0f) + 1e-6f);
            const size_t g = (size_t)(b * SEQ + c0 + t) * 1024 + h * 128 + d0;
            const v4u gv = *(const v4u*)(hg + g); unsigned w[4];
#pragma unroll
            for (int e = 0; e < 4; ++e) { const unsigned gg = e == 0 ? gv.x : e == 1 ? gv.y : e == 2 ? gv.z : gv.w;
                w[e] = pk2(o[2 * e] * rn * onorm[d0 + 2 * e] * bf2f(gg & 0xffffu), o[2 * e + 1] * rn * onorm[d0 + 2 * e + 1] * bf2f(gg >> 16)); }
            *(v4u*)(hq + g) = (v4u){w[0], w[1], w[2], w[3]}; }
        __syncthreads();
    }
}

#ifndef EXP_NO_LN
#define EXP_NO_LN 0
#endif
__device__ __forceinline__ void conv_phase(LAS unsigned char* lds, const bf16* cu, bf16* cy, const float* wdw, const float* bdw, const float* lng, const float* lnb, int vcu, int G, int tid, int lane, int wave) {
    typedef float f32x2 __attribute__((ext_vector_type(2)));
    constexpr int TT = 16, NU = TT + 30;
    LAS f32x2* red = (LAS f32x2*)(lds + RING_OFF);
    LAS f32x2* stat = (LAS f32x2*)(lds + RING_OFF + 65536);
    const int c0 = 2 * tid;
    float w0[31], w1[31];
#pragma unroll
    for (int k = 0; k < 31; ++k) { const f32x2 w = *(const f32x2*)(wdw + k * 1024 + c0); w0[k] = w.x; w1[k] = w.y; }
    const f32x2 bd = *(const f32x2*)(bdw + c0), g2 = *(const f32x2*)(lng + c0), b2 = *(const f32x2*)(lnb + c0);
    int par = 0;
    for (int tile = vcu; tile < T / TT; tile += G) {
        const int row0 = tile * TT, s0 = row0 & 2047;
        float u0[NU], u1[NU];
#pragma unroll
        for (int i = 0; i < NU; ++i) {
            unsigned u = 0u;
            if (s0 - 30 + i >= 0) u = *(const unsigned*)(cu + (size_t)(row0 - 30 + i) * 1024 + c0);
            u0[i] = bf2f(u & 0xffffu); u1[i] = bf2f(u >> 16);
        }
        float y0[TT], y1[TT];
#pragma unroll
        for (int t = 0; t < TT; ++t) { float a0 = bd.x, a1 = bd.y;
#pragma unroll
            for (int k = 0; k < 31; ++k) { a0 += w0[k] * u0[t + k]; a1 += w1[k] * u1[t + k]; }
            y0[t] = a0; y1[t] = a1; }
        LAS f32x2* wp = red + (size_t)(par * TT * 8); par ^= 1;
#pragma unroll
        for (int t = 0; t < TT; ++t) { const float s1 = wave_sum(y0[t] + y1[t]), s2 = wave_sum(y0[t] * y0[t] + y1[t] * y1[t]); if (lane == 0) wp[t * 8 + wave] = (f32x2){s1, s2}; }
        __syncthreads();
#pragma unroll
        for (int t = 0; t < TT; ++t) { float s1 = 0.f, s2 = 0.f;
#pragma unroll
            for (int q = 0; q < 8; ++q) { const f32x2 v = wp[t * 8 + q]; s1 += v.x; s2 += v.y; }
            const float mean = s1 * (1.0f / 1024.0f), var = fmaxf(s2 * (1.0f / 1024.0f) - mean * mean, 0.f);
            const f32x2 st = (f32x2){mean, rsqrtf(var + 1e-6f)};
            float a = (y0[t] - st.x) * st.y * g2.x + b2.x, b = (y1[t] - st.x) * st.y * g2.y + b2.y;
            a = a * __builtin_amdgcn_rcpf(1.0f + __expf(-a)); b = b * __builtin_amdgcn_rcpf(1.0f + __expf(-b));
            *(unsigned*)(cy + (size_t)(row0 + t) * 1024 + c0) = pk2(a, b); }
    }
}
__global__ void __launch_bounds__(NWAVES * 64, 2) mk_fwd(Args args) {
    extern __shared__ __attribute__((aligned(16))) unsigned char lds_raw[];
    LAS unsigned char* lds = (LAS unsigned char*)lds_raw;
    volatile LAS unsigned* MISC = (volatile LAS unsigned*)(lds + MISC_OFF);
    const int wave = __builtin_amdgcn_readfirstlane(threadIdx.x >> 6);
    const int tid = wave * 64 + mk_lane();
    const int G = gridDim.x; const int bx = blockIdx.x; const int vcu = (G % 8 == 0) ? (bx % 8) * (G / 8) + bx / 8 : bx;
    unsigned char* ws = args.ws;
    gu32* ctl = (gu32*)(ws + WS_CTL);
    for (int u = tid; u < (LDS_BYTES - LDSCTL_OFF) / 4; u += NWAVES * 64) ((LAS unsigned*)(lds + LDSCTL_OFF))[u] = 0u;
    __syncthreads();
#if MK_PER_PHASE
#define GRID_BAR() do { } while (0)
#else
    XcdBarrier bar = xcd_barrier_post((unsigned*)(ctl + CW_BAR), MISC + 8, wave == 0 && mk_lane() == 0);
#define GRID_BAR() xcd_barrier(bar, wave == 0 && mk_lane() == 0)
#endif
    const int lo = args.ph_lo, hi = args.ph_hi;
#ifndef EXP_SKIP_CONV
#define EXP_SKIP_CONV 0
#endif
#ifndef NO_UQ
#define NO_UQ 0
#endif
#ifndef NO_UKV
#define NO_UKV 0
#endif
#ifndef ONLY_LO
#define ONLY_LO 0
#define ONLY_HI 99
#endif
#define IN(k) ((ONLY_LO) <= (k) && (k) <= (ONLY_HI) && lo <= (k) && (k) < hi)
#define SEAM(k) do { if (IN(k) && IN((k) + 1)) GRID_BAR(); } while (0)
    const float* x_in = args.in[0]; float* out = args.out; const float* pv = (const float*)(ws + WS_PV); const int* pos = (const int*)(pv + PV_POS);
    pg8::ssq_t* ssb = (pg8::ssq_t*)(ws + CTL_SS); pg8::ssq_t* sscq = (pg8::ssq_t*)(ws + CTL_SSCQ); pg8::ssq_t* ssckv = (pg8::ssq_t*)(ws + CTL_SSCKV);
    pg8::bf16_t* Wb = (pg8::bf16_t*)(ws + WS_W);
    pg8::bf16_t* xb = (pg8::bf16_t*)(ws + WS_XB);
    pg8::bf16_t* hh = (pg8::bf16_t*)(ws + WS_HH);
    pg8::bf16_t* aQ = (pg8::bf16_t*)(ws + WS_Q); pg8::bf16_t* aK = (pg8::bf16_t*)(ws + WS_K); pg8::bf16_t* aV = (pg8::bf16_t*)(ws + WS_V); pg8::bf16_t* aO = (pg8::bf16_t*)(ws + WS_O);
    pg8::bf16_t* aCQ = (pg8::bf16_t*)(ws + WS_CQ); pg8::bf16_t* aCKV = (pg8::bf16_t*)(ws + WS_CKV); pg8::bf16_t* aKR = (pg8::bf16_t*)(ws + WS_KR);
    pg8::bf16_t* hq = (pg8::bf16_t*)(ws + WS_HQ); pg8::bf16_t* hv = (pg8::bf16_t*)(ws + WS_HV); pg8::bf16_t* hg = (pg8::bf16_t*)(ws + WS_HG); float* hlf = (float*)(ws + WS_HLF);
    pg8::bf16_t* cu = (pg8::bf16_t*)(ws + WS_CU); pg8::bf16_t* cy = (pg8::bf16_t*)(ws + WS_CY);
    const float* lbv = (const float*)(ws + WS_LB);

#define RUN_GEMM(EpiT, Aptr, Btptr, Nn, Kk, ...) do { pg8::Gemm g_{(Aptr), (Btptr), T, (Nn), (Kk)}; pg8::StaticOrder S_; S_.init(T, (Nn), G, (int)blockIdx.x); \
        EpiT E_{__VA_ARGS__}; pg8::gemm_phase<EpiT, pg8::StaticOrder, true, true>(lds + RING_OFF, g_, S_, E_, wave); } while (0)

#define MLP_LAYER(l, P) do { \
    if (IN(P)) { RUN_GEMM(pg8::EpiRow<1>, xb, Wb + W_MI + (size_t)(l) * FF * D, FF, D, hh, FF, ssb + (size_t)(2 * (l) + 1) * T, 1.0f / 1024.0f); } SEAM(P); \
    if (IN((P) + 1)) { if ((l) < 3) { RUN_GEMM(pg8::EpiResid<false>, hh, Wb + W_MO + (size_t)(l) * FF * D, D, FF, out, out, xb, (const float*)nullptr, ssb + (size_t)(2 * (l) + 2) * T); } \
                       else { RUN_GEMM(pg8::EpiResid<true>, hh, Wb + W_MO + (size_t)(l) * FF * D, D, FF, out, out, xb, (const float*)nullptr, (pg8::ssq_t*)nullptr); } } SEAM((P) + 1); } while (0)

#define MLA_LAYER(j, l, P) do { \
    if (IN(P)) { RUN_GEMM(pg8::EpiDown, xb, Wb + W_DN + (size_t)(j) * 768 * D, 768, D, ssb + (size_t)(2 * (l)) * T, aCQ, aCKV, aKR, sscq + (size_t)(j) * T, ssckv + (size_t)(j) * T); } SEAM(P); \
    if (IN((P) + 1)) { if (!NO_UQ) RUN_GEMM(pg8::EpiUQ, aCQ, Wb + W_UQ + (size_t)(j) * 1536 * 384, 1536, 384, sscq + (size_t)(j) * T, aQ); \
                       if (!NO_UKV) RUN_GEMM(pg8::EpiUKV, aCKV, Wb + W_UKV + (size_t)(j) * 2048 * 256, 2048, 256, ssckv + (size_t)(j) * T, aK, aV); } SEAM((P) + 1); \
    if (IN((P) + 2)) { OPQ; mla_finalize(pos, pv + PV_GQ + (j) * 192, pv + PV_GK + (j) * 192, aQ, aK, aKR, vcu, G, l_, w_); } SEAM((P) + 2); \
    if (IN((P) + 3)) { att::attn_phase((char*)lds_raw + RING_OFF, aQ, aK, aKR, aV, aO, G, (int)blockIdx.x, wave); } SEAM((P) + 3); \
    if (IN((P) + 4)) { RUN_GEMM(pg8::EpiResid<false>, aO, Wb + W_AO + (size_t)(j) * D * D, D, D, ((l) == 0 ? x_in : (const float*)out), out, xb, (const float*)nullptr, ssb + (size_t)(2 * (l) + 1) * T); } SEAM((P) + 4); } while (0)

#define OPQ int t_ = wave * 64 + mk_lane(); asm volatile("" : "+v"(t_)); const int l_ = t_ & 63, w_ = __builtin_amdgcn_readfirstlane(t_ >> 6)
    if (IN(0)) { OPQ; p0_prologue(args, lds, vcu, G, t_, l_, w_); } SEAM(0);
    MLA_LAYER(0, 0, 1);
    MLP_LAYER(0, 6);
    if (IN(8)) { RUN_GEMM(pg8::EpiHG, xb, Wb + W_HI, FF, D, ssb + (size_t)2 * T, lbv, hq, hlf, (size_t)(WS_HV - WS_HQ) / 2); } SEAM(8);
    if (IN(9)) { OPQ; if (bx < 128) hgrn_scan_simple(lds, hq, hv, hg, hlf, pv + PV_ON, bx, t_); } SEAM(9);
    if (IN(10)) { RUN_GEMM(pg8::EpiResid<false>, hq, Wb + W_HO, D, D, out, out, xb, (const float*)nullptr, ssb + (size_t)3 * T); } SEAM(10);
    MLP_LAYER(1, 11);
    if (IN(13)) { RUN_GEMM(pg8::EpiGLU, xb, Wb + W_P1, 2048, D, ssb + (size_t)4 * T, pv + PV_BP1, cu); } SEAM(13);
    if (IN(14)) { OPQ; conv_phase(lds, cu, cy, pv + PV_WDW, pv + PV_BDW, pv + PV_LNG, pv + PV_LNB, vcu, G, t_, l_, w_); } SEAM(14);
    if (IN(15)) { RUN_GEMM(pg8::EpiResid<false>, (EXP_SKIP_CONV ? cu : cy), Wb + W_P2, D, D, out, out, xb, pv + PV_BP2, ssb + (size_t)5 * T); } SEAM(15);
    MLP_LAYER(2, 16);
    MLA_LAYER(1, 3, 18);
    MLP_LAYER(3, 23);
#undef IN
#undef SEAM
}

extern "C" void kernel_launch(void* const* d_in, const int* in_sizes, int n_in, void* d_out, int out_size, void* d_ws, size_t ws_size, hipStream_t stream) {
    static int grid = 0;
    if (grid == 0) {
        if (n_in != 26 || in_sizes[0] != T * D || out_size != T * D || ws_size < WS_END) { fprintf(stderr, "kernel_launch: unexpected shapes (n_in %d, in0 %d, out %d, ws %zu)\n", n_in, n_in > 0 ? in_sizes[0] : -1, out_size, ws_size); grid = -1; return; }
        int dev = 0, cus = 0, per_cu = 0;
        if (hipGetDevice(&dev) != hipSuccess || hipDeviceGetAttribute(&cus, hipDeviceAttributeMultiprocessorCount, dev) != hipSuccess) { grid = -1; return; }
        if (hipFuncSetAttribute((const void*)mk_fwd, hipFuncAttributeMaxDynamicSharedMemorySize, LDS_BYTES) != hipSuccess) { fprintf(stderr, "kernel_launch: hipFuncSetAttribute failed\n"); grid = -1; return; }
        if (hipOccupancyMaxActiveBlocksPerMultiprocessor(&per_cu, (const void*)mk_fwd, NWAVES * 64, LDS_BYTES) != hipSuccess || per_cu < 1) { fprintf(stderr, "kernel_launch: occupancy query says %d\n", per_cu); }
        (void)hipGetLastError();
        grid = cus;
    }
    if (grid < 0) return;
    if (hipMemsetAsync((char*)d_ws + WS_CTL, 0, CTL_ZERO_BYTES, stream) != hipSuccess) return;
    Args a{};
    for (int i = 0; i < 26; ++i) a.in[i] = (const float*)d_in[i];
    a.out = (float*)d_out; a.ws = (unsigned char*)d_ws; a.pad = 0;
#if MK_PER_PHASE
    for (int p = 0; p < NPHASE; ++p) { a.ph_lo = p; a.ph_hi = p + 1; a.li = p; hipLaunchKernelGGL(mk_fwd, dim3(grid), dim3(NWAVES * 64), LDS_BYTES, stream, a); }
#else
    a.ph_lo = 0; a.ph_hi = NPHASE; a.li = 0;
    hipLaunchKernelGGL(mk_fwd, dim3(grid), dim3(NWAVES * 64), LDS_BYTES, stream, a);
#endif
}
```

```cpp
#include <hip/hip_runtime.h>
#include <cstdio>
#include <cstdint>
#include <cmath>
__device__ __forceinline__ int mk_lane() { int l; asm volatile("v_mbcnt_lo_u32_b32 %0, -1, 0\n\tv_mbcnt_hi_u32_b32 %0, -1, %0" : "=v"(l)); return l; }
namespace pg8 {
#define PG8_LAS __attribute__((address_space(3)))
typedef unsigned short bf16_t;
typedef short bf16x8 __attribute__((ext_vector_type(8)));
typedef float f32x4 __attribute__((ext_vector_type(4)));
typedef unsigned u32x4 __attribute__((ext_vector_type(4)));
constexpr int BM = 256, BK = 64, HALF = 128, HTB = HALF * BK * 2  , STAGE_BYTES = 8 * HTB, NXCD = 8, WGM = 8;

__host__ __device__ __forceinline__ int lds_byte(int r, int c) { const int st = (r >> 4) * 2 + (c >> 5), rr = r & 15, cc = c & 31, ob = rr * 64 + cc * 2; return st * 1024 + (ob ^ (((ob >> 9) & 1) << 5)); }
__host__ __device__ __forceinline__ void stage_rc(int b, int& R, int& C) { const int st = b / 1024, sb = b % 1024, swz = sb ^ (((sb >> 9) & 1) << 5); R = (st >> 1) * 16 + swz / 64; C = (st & 1) * 32 + (swz % 64) / 2; }
__host__ __device__ __forceinline__ int perm32(int rho) { const int n = rho >> 4, i = rho & 15; return 8 * (i >> 2) + 4 * n + (i & 3); }

struct Unit { int pm, pn; };
struct Gemm { const bf16_t* A; const bf16_t* Bt; int M, N, K; };

struct StaticOrder {
    int nM, nN, nwg, G, c, rev;
    __host__ __device__ void init(int M, int N, int G_, int c_, int rev_ = 0) { nM = M / BM; nN = N / BM; nwg = nM * nN; G = G_; c = c_; rev = rev_; }
    __host__ __device__ bool next(int i, Unit& u) const {
        const long L = (long)i * G + c; if (L >= nwg) return false;
        int wgid = (int)L; { const int q = nwg / NXCD, r = nwg % NXCD, xcd = wgid % NXCD, off = wgid / NXCD; wgid = (xcd < r ? xcd * (q + 1) : r * (q + 1) + (xcd - r) * q) + off; }
        const int nig = WGM * nN, gid = wgid / nig, fm = gid * WGM, gsz = (nM - fm) < WGM ? (nM - fm) : WGM;
        u.pm = fm + ((wgid % nig) % gsz); u.pn = (wgid % nig) / gsz; if (rev == 1) u.pm = nM - 1 - u.pm; if (rev == 2) u.pm = u.pm & 7; return true;
    }
    __device__ __forceinline__ void a_ready(const Unit&) const {}
    __device__ __forceinline__ void done(const Unit&) const {}
};
__device__ __forceinline__ unsigned cvt_pk_bf16(float lo, float hi) { unsigned r; asm volatile("v_cvt_pk_bf16_f32 %0, %1, %2" : "=v"(r) : "v"(lo), "v"(hi)); return r; }
constexpr float RMS_EPS = 1e-6f;
typedef unsigned long long ssq_t;
constexpr float SS_SCALE = 1048576.0f, SS_INV = 1.0f / 1048576.0f;
__device__ __forceinline__ float row_rstd(const ssq_t* ss, int row, float inv_n) { return rsqrtf((float)ss[row] * (inv_n * SS_INV) + RMS_EPS); }
__device__ __forceinline__ void row_rstd8(float (&rs)[2][4], const ssq_t* ss, int row0, float inv_n) {
    ssq_t v[2][4];
#pragma unroll
    for (int ai = 0; ai < 2; ++ai)
#pragma unroll
        for (int m = 0; m < 4; ++m) v[ai][m] = ss[row0 + ai * HALF + m * 16];
#pragma unroll
    for (int ai = 0; ai < 2; ++ai)
#pragma unroll
        for (int m = 0; m < 4; ++m) rs[ai][m] = rsqrtf((float)v[ai][m] * (inv_n * SS_INV) + RMS_EPS);
}
__device__ __forceinline__ void ss_add(ssq_t* p, float v) { (void)__hip_atomic_fetch_add(p, (ssq_t)(v * SS_SCALE + 0.5f), __ATOMIC_RELAXED, __HIP_MEMORY_SCOPE_AGENT); }
__device__ __forceinline__ float sigm(float x) { return __builtin_amdgcn_rcpf(1.0f + __expf(-x)); }
__device__ __forceinline__ u32x4 pack8v(f32x4 a, f32x4 b) { u32x4 w; w.x = cvt_pk_bf16(a[0], a[1]); w.y = cvt_pk_bf16(a[2], a[3]); w.z = cvt_pk_bf16(b[0], b[1]); w.w = cvt_pk_bf16(b[2], b[3]); return w; }
__device__ __forceinline__ float dot4(f32x4 a) { return (a[0] * a[0] + a[1] * a[1]) + (a[2] * a[2] + a[3] * a[3]); }
__device__ __forceinline__ float quad_sum(float s) { s += __shfl_xor(s, 16); s += __shfl_xor(s, 32); return s; }

template <int ACT, bool NOSTORE = false, bool TILEDOUT = false> struct EpiRow {
    static constexpr bool PERM = true, AFTER_DRAIN = false;
    bf16_t* O; int ldc; const ssq_t* ss; float inv_n;
    __device__ __forceinline__ void operator()(const f32x4 (&acc)[2][2][4][2], const Unit& u, int wr, int wc, int fr, int fq) const {
        { const int ln_ = mk_lane(); fr = ln_ & 15; fq = ln_ >> 4; }
        const int row0 = u.pm * BM + wr * 64 + fr, col0 = u.pn * BM + wc * 32 + 8 * fq;
        float rsv[2][4]; row_rstd8(rsv, ss, row0, inv_n);
        int never = 0; asm volatile("" : "+s"(never));
#pragma unroll
        for (int ai = 0; ai < 2; ++ai)
#pragma unroll
            for (int m = 0; m < 4; ++m) {
                const int row = row0 + ai * HALF + m * 16;
                const float rs = rsv[ai][m];
                bf16_t* rowp = TILEDOUT ? O + ((size_t)u.pm * (ldc / 64) + (size_t)(u.pn * 4 + (wc >> 1))) * (BM * 64) + (size_t)(row & 255) * 64 + (wc & 1) * 32 + 8 * fq - (TILEDOUT ? 0 : 0)
                                        : O + (size_t)row * ldc + col0;
#pragma unroll
                for (int bj = 0; bj < 2; ++bj) {
                    f32x4 v0 = acc[ai][bj][m][0] * rs, v1 = acc[ai][bj][m][1] * rs;
                    if (ACT == 1) {
#pragma unroll
                        for (int e = 0; e < 4; ++e) { const float a = fmaxf(v0[e], 0.f), b = fmaxf(v1[e], 0.f); v0[e] = a * a; v1[e] = b * b; }
                    }
                    if (!NOSTORE || never) *(u32x4*)(rowp + (TILEDOUT ? bj * 2 * (BM * 64) : bj * HALF)) = pack8v(v0, v1);
                }
            }
    }
};

__device__ __forceinline__ void unpack8(u32x4 w, f32x4& a, f32x4& b) {
    a = (f32x4){__builtin_bit_cast(float, w.x << 16), __builtin_bit_cast(float, w.x & 0xffff0000u), __builtin_bit_cast(float, w.y << 16), __builtin_bit_cast(float, w.y & 0xffff0000u)};
    b = (f32x4){__builtin_bit_cast(float, w.z << 16), __builtin_bit_cast(float, w.z & 0xffff0000u), __builtin_bit_cast(float, w.w << 16), __builtin_bit_cast(float, w.w & 0xffff0000u)};
}
template <bool LAST, bool HAS_BIAS = false> struct EpiResid {
    static constexpr bool PERM = true, AFTER_DRAIN = false;
    float* xout; bf16_t* xb; const float* bias; ssq_t* ssn; bf16_t* xbw;
    __device__ __forceinline__ void operator()(const f32x4 (&acc)[2][2][4][2], const Unit& u, int wr, int wc, int fr, int fq) const {
        { const int ln_ = mk_lane(); fr = ln_ & 15; fq = ln_ >> 4; }
        const int row0 = u.pm * BM + wr * 64 + fr, col0 = u.pn * BM + wc * 32 + 8 * fq;
        f32x4 (&accw)[2][2][4][2] = const_cast<f32x4 (&)[2][2][4][2]>(acc);
        if (HAS_BIAS) {
#pragma unroll
            for (int bj = 0; bj < 2; ++bj)
#pragma unroll
                for (int n = 0; n < 2; ++n) { const f32x4 bvv = *(const f32x4*)(bias + col0 + bj * HALF + 4 * n);
#pragma unroll
                    for (int ai = 0; ai < 2; ++ai)
#pragma unroll
                        for (int m = 0; m < 4; ++m) accw[ai][bj][m][n] += bvv; }
        }
        constexpr int NB_ = HAS_BIAS ? 2 : 1, AI_ = HAS_BIAS ? 1 : 2;
#pragma unroll
        for (int hb = 0; hb < NB_; ++hb) {
            u32x4 xr[AI_][4][2];
#pragma unroll
            for (int a2 = 0; a2 < AI_; ++a2)
#pragma unroll
                for (int m = 0; m < 4; ++m)
#pragma unroll
                    for (int bj = 0; bj < 2; ++bj) xr[a2][m][bj] = *(const u32x4*)(xb + (size_t)(row0 + (hb * AI_ + a2) * HALF + m * 16) * 1024 + col0 + bj * HALF);
#pragma unroll
            for (int a2 = 0; a2 < AI_; ++a2)
#pragma unroll
                for (int m = 0; m < 4; ++m) {
                    const int ai = hb * AI_ + a2;
                    const int row = row0 + ai * HALF + m * 16;
                    const size_t off = (size_t)row * 1024 + col0;
                    float sq = 0.f;
#pragma unroll
                    for (int bj = 0; bj < 2; ++bj) {
                        f32x4 x0, x1; unpack8(xr[a2][m][bj], x0, x1);
                        const f32x4 v0 = accw[ai][bj][m][0] + x0, v1 = accw[ai][bj][m][1] + x1;
                        if (LAST) { *(f32x4*)(xout + off + bj * HALF) = v0; *(f32x4*)(xout + off + bj * HALF + 4) = v1; }
                        else { const u32x4 w = pack8v(v0, v1); *(u32x4*)(xbw + off + bj * HALF) = w; f32x4 r0, r1; unpack8(w, r0, r1); sq += dot4(r0) + dot4(r1); }
                    }
                    if (!LAST) { sq = quad_sum(sq); if (fq == 0) ss_add(ssn + row, sq); }
                }
        }
    }
};

struct EpiDown {
    static constexpr bool PERM = true, AFTER_DRAIN = false;
    const ssq_t* ss; bf16_t* cq; bf16_t* ckv; bf16_t* kr; ssq_t* sscq; ssq_t* ssckv;
    __device__ __forceinline__ void operator()(const f32x4 (&acc)[2][2][4][2], const Unit& u, int wr, int wc, int fr, int fq) const {
        { const int ln_ = mk_lane(); fr = ln_ & 15; fq = ln_ >> 4; }
        const int row0 = u.pm * BM + wr * 64 + fr, cw = wc * 32 + 8 * fq;
        float rsv[2][4]; row_rstd8(rsv, ss, row0, 1.0f / 1024.0f);
#pragma unroll
        for (int ai = 0; ai < 2; ++ai)
#pragma unroll
            for (int m = 0; m < 4; ++m) {
                const int row = row0 + ai * HALF + m * 16;
                const float rs = rsv[ai][m];
                float sq_q = 0.f, sq_kv = 0.f;
#pragma unroll
                for (int bj = 0; bj < 2; ++bj) {
                    const int seg = u.pn * 2 + bj;
                    const f32x4 v0 = acc[ai][bj][m][0] * rs, v1 = acc[ai][bj][m][1] * rs;
                    const u32x4 w = pack8v(v0, v1);
                    if (seg < 3) { *(u32x4*)(cq + (size_t)row * 384 + seg * 128 + cw) = w; sq_q += dot4(v0) + dot4(v1); }
                    else if (seg < 5) { *(u32x4*)(ckv + (size_t)row * 256 + (seg - 3) * 128 + cw) = w; sq_kv += dot4(v0) + dot4(v1); }
                    else if (wc < 2) { *(u32x4*)(kr + (size_t)row * 64 + cw) = w; }
                }
                sq_q = quad_sum(sq_q); sq_kv = quad_sum(sq_kv);
                if (fq == 0) { if (u.pn <= 1) ss_add(sscq + row, sq_q); if (u.pn >= 1) ss_add(ssckv + row, sq_kv); }
            }
    }
};

struct EpiUQ {
    static constexpr bool PERM = true, AFTER_DRAIN = false;
    const ssq_t* ss; bf16_t* Q;
    __device__ __forceinline__ void operator()(const f32x4 (&acc)[2][2][4][2], const Unit& u, int wr, int wc, int fr, int fq) const {
        { const int ln_ = mk_lane(); fr = ln_ & 15; fq = ln_ >> 4; }
        const int row0 = u.pm * BM + wr * 64 + fr, col0 = u.pn * BM + wc * 32 + 8 * fq;
        float rsv[2][4]; row_rstd8(rsv, ss, row0, 1.0f / 384.0f);
        int hoff[2];
#pragma unroll
        for (int bj = 0; bj < 2; ++bj) { const int col = col0 + bj * HALF, h = col / 192; hoff[bj] = h * (2048 * 192) + (col - h * 192); }
        const int bq = row0 >> 11;
        bf16_t* base = Q + (size_t)bq * (8 * 2048 * 192) + (size_t)(row0 & 2047) * 192;
#pragma unroll
        for (int ai = 0; ai < 2; ++ai)
#pragma unroll
            for (int m = 0; m < 4; ++m) {
                const float rs = rsv[ai][m];
#pragma unroll
                for (int bj = 0; bj < 2; ++bj) {
                    const f32x4 v0 = acc[ai][bj][m][0] * rs, v1 = acc[ai][bj][m][1] * rs;
                    *(u32x4*)(base + (ai * HALF + m * 16) * 192 + hoff[bj]) = pack8v(v0, v1);
                }
            }
    }
};

struct EpiUKV {
    static constexpr bool PERM = true, AFTER_DRAIN = false;
    const ssq_t* ss; bf16_t* Kn; bf16_t* V; const float* gk; PG8_LAS float* X;
    __device__ __forceinline__ void operator()(const f32x4 (&acc)[2][2][4][2], const Unit& u, int wr, int wc, int fr, int fq) const {
        { const int ln_ = mk_lane(); fr = ln_ & 15; fq = ln_ >> 4; }
        const int row0 = u.pm * BM + wr * 64 + fr, cw = wc * 32 + 8 * fq, h = u.pn;
        float rsv[2][4]; row_rstd8(rsv, ss, row0, 1.0f / 256.0f);
        const f32x4 g0 = *(const f32x4*)(gk + cw), g1 = *(const f32x4*)(gk + cw + 4);
        const size_t off0 = ((size_t)(((row0 >> 11) * 8 + h) * 2048 + (row0 & 2047))) * 128 + cw;
#pragma unroll
        for (int ai = 0; ai < 2; ++ai)
#pragma unroll
            for (int m = 0; m < 4; ++m) {
                const float rs = rsv[ai][m];
                const f32x4 a0 = acc[ai][0][m][0] * rs, a1 = acc[ai][0][m][1] * rs;
                const float s = quad_sum(dot4(a0) + dot4(a1));
                if (fq == 0) X[(ai * HALF + wr * 64 + m * 16 + fr) * 4 + wc] = s;
                const size_t off = off0 + (size_t)(ai * HALF + m * 16) * 128;
                { const f32x4 v0 = acc[ai][1][m][0] * rs, v1 = acc[ai][1][m][1] * rs; *(u32x4*)(V + off) = pack8v(v0, v1); }
            }
        asm volatile("s_waitcnt lgkmcnt(0)" ::: "memory"); __builtin_amdgcn_s_barrier(); asm volatile("" ::: "memory");
#pragma unroll
        for (int ai = 0; ai < 2; ++ai)
#pragma unroll
            for (int m = 0; m < 4; ++m) {
                const f32x4 p = *(const PG8_LAS f32x4*)(X + (ai * HALF + wr * 64 + m * 16 + fr) * 4);
                const float rk = rsqrtf(((p[0] + p[1]) + (p[2] + p[3])) * (1.0f / 128.0f) + RMS_EPS) * rsv[ai][m];
                const size_t off = off0 + (size_t)(ai * HALF + m * 16) * 128;
                const f32x4 v0 = acc[ai][0][m][0] * rk * g0, v1 = acc[ai][0][m][1] * rk * g1;
                *(u32x4*)(Kn + off) = pack8v(v0, v1);
            }
    }
};

struct EpiHG {
    static constexpr bool PERM = true, AFTER_DRAIN = false;
    const ssq_t* ss; const float* lb; bf16_t* hq; float* hlf; size_t sec_stride;
    __device__ __forceinline__ void operator()(const f32x4 (&acc)[2][2][4][2], const Unit& u, int wr, int wc, int fr, int fq) const {
        { const int ln_ = mk_lane(); fr = ln_ & 15; fq = ln_ >> 4; }
        const int row0 = u.pm * BM + wr * 64 + fr, sec = u.pn >> 2, cc0 = (u.pn & 3) * BM + wc * 32 + 8 * fq;
        float rsv[2][4]; row_rstd8(rsv, ss, row0, 1.0f / 1024.0f);
        if (sec == 1) {
            f32x4 lbv[2][2];
#pragma unroll
            for (int bj = 0; bj < 2; ++bj)
#pragma unroll
                for (int n = 0; n < 2; ++n) lbv[bj][n] = *(const f32x4*)(lb + cc0 + bj * HALF + 4 * n);
#pragma unroll
            for (int ai = 0; ai < 2; ++ai)
#pragma unroll
                for (int m = 0; m < 4; ++m) {
                    const int row = row0 + ai * HALF + m * 16;
                    const float rs = rsv[ai][m];
#pragma unroll
                    for (int bj = 0; bj < 2; ++bj)
#pragma unroll
                        for (int n = 0; n < 2; ++n) {
                            const f32x4 v = acc[ai][bj][m][n] * rs; f32x4 o;
#pragma unroll
                            for (int e = 0; e < 4; ++e) { const float l = lbv[bj][n][e]; o[e] = __logf(l + (1.0f - l) * sigm(v[e])); }
                            *(f32x4*)(hlf + (size_t)row * 1024 + cc0 + bj * HALF + 4 * n) = o;
                        }
                }
        } else {
            bf16_t* dst = hq + (size_t)((sec + 1) >> 1) * sec_stride;
#pragma unroll
            for (int ai = 0; ai < 2; ++ai)
#pragma unroll
                for (int m = 0; m < 4; ++m) {
                    const int row = row0 + ai * HALF + m * 16;
                    const float rs = rsv[ai][m];
#pragma unroll
                    for (int bj = 0; bj < 2; ++bj) {
                        f32x4 v0 = acc[ai][bj][m][0] * rs, v1 = acc[ai][bj][m][1] * rs;
                        if (sec == 3) {
#pragma unroll
                            for (int e = 0; e < 4; ++e) { v0[e] = v0[e] * sigm(v0[e]); v1[e] = v1[e] * sigm(v1[e]); }
                        }
                        *(u32x4*)(dst + (size_t)row * 1024 + cc0 + bj * HALF) = pack8v(v0, v1);
                    }
                }
        }
    }
};

struct EpiGLU {
    static constexpr bool PERM = true, AFTER_DRAIN = false;
    const ssq_t* ss; const float* bias; bf16_t* cu;
    __device__ __forceinline__ void operator()(const f32x4 (&acc)[2][2][4][2], const Unit& u, int wr, int wc, int fr, int fq) const {
        { const int ln_ = mk_lane(); fr = ln_ & 15; fq = ln_ >> 4; }
        const int row0 = u.pm * BM + wr * 64 + fr, j0 = u.pn * HALF + wc * 32 + 8 * fq;
        const f32x4 ba0 = *(const f32x4*)(bias + j0), ba1 = *(const f32x4*)(bias + j0 + 4), bg0 = *(const f32x4*)(bias + 1024 + j0), bg1 = *(const f32x4*)(bias + 1024 + j0 + 4);
        float rsv[2][4]; row_rstd8(rsv, ss, row0, 1.0f / 1024.0f);
#pragma unroll
        for (int ai = 0; ai < 2; ++ai)
#pragma unroll
            for (int m = 0; m < 4; ++m) {
                const int row = row0 + ai * HALF + m * 16;
                const float rs = rsv[ai][m];
                f32x4 a0 = acc[ai][0][m][0] * rs + ba0, a1 = acc[ai][0][m][1] * rs + ba1;
                const f32x4 g0 = acc[ai][1][m][0] * rs + bg0, g1 = acc[ai][1][m][1] * rs + bg1;
#pragma unroll
                for (int e = 0; e < 4; ++e) { a0[e] *= sigm(g0[e]); a1[e] *= sigm(g1[e]); }
                *(u32x4*)(cu + (size_t)row * 1024 + j0) = pack8v(a0, a1);
            }
    }
};
template <class Epi, class Sched, bool ALIGN_EPI = false, bool SP2 = false, bool TILED = false, bool TILEDB = TILED>
__device__ __forceinline__ void gemm_phase(PG8_LAS unsigned char* lds, const Gemm g, const Sched& S, const Epi& E, int wave_s, int stagger_ticks = 0) {
    int tid_ = wave_s * 64 + mk_lane(); asm volatile("" : "+v"(tid_));
    const int tid = tid_, wid = __builtin_amdgcn_readfirstlane(tid >> 6), lane = tid & 63, wr = wid >> 2, wc = wid & 3, fr = lane & 15, fq = lane >> 4;
    const int K = g.K, nt = K / BK;
    unsigned voffA[2], voffB[2];
#pragma unroll
    for (int i = 0; i < 2; ++i) { int R, C; stage_rc(tid * 16 + i * 8192, R, C); const int Rb = Epi::PERM ? ((R & ~31) + perm32(R & 31)) : R;
        voffA[i] = (unsigned)(R * (TILED ? BK : K) + C) * 2u; voffB[i] = (unsigned)(Rb * (TILEDB ? BK : K) + C) * 2u; }
    const size_t kstep = TILED ? (size_t)(BM * BK * 2) : (size_t)(BK * 2), kstepB = TILEDB ? (size_t)(BM * BK * 2) : (size_t)(BK * 2);
    const size_t hstep = TILED ? (size_t)(HALF * BK * 2) : (size_t)HALF * K * 2, hstepB = TILEDB ? (size_t)(HALF * BK * 2) : (size_t)HALF * K * 2;
    const size_t tstep = (size_t)BM * K * 2;
    const unsigned ldsw = (unsigned)wid * 1024u;
    const int aoff = lds_byte(wr * 64 + fr, fq * 8), boff = lds_byte(wc * 32 + fr, fq * 8);
#define PG8_SA(b, h) (((b) * 2 + (h)) * HTB)
#define PG8_SB(b, h) ((4 + (b) * 2 + (h)) * HTB)
#define PG8_STAGE(bufoff, gbase, voff) do { _Pragma("unroll") for (int _i = 0; _i < 2; ++_i) \
        __builtin_amdgcn_global_load_lds((const unsigned*)((const char*)(gbase) + (voff)[_i]), (PG8_LAS unsigned*)(lds + (bufoff) + ldsw + _i * 8192), 16, 0, 0); } while (0)
#define PG8_LDA(dst, b, h) do { _Pragma("unroll") for (int m = 0; m < 4; ++m) _Pragma("unroll") for (int k = 0; k < 2; ++k) dst[m][k] = *(const PG8_LAS bf16x8*)(lds + PG8_SA(b, h) + aoff + m * 2048 + k * 1024); } while (0)
#define PG8_LDB(dst, b, h) do { _Pragma("unroll") for (int n = 0; n < 2; ++n) _Pragma("unroll") for (int k = 0; k < 2; ++k) dst[n][k] = *(const PG8_LAS bf16x8*)(lds + PG8_SB(b, h) + boff + n * 2048 + k * 1024); } while (0)
#define PG8_MMA(ai, bj, At, Bt) do { __builtin_amdgcn_s_setprio(1); _Pragma("unroll") for (int m = 0; m < 4; ++m) _Pragma("unroll") for (int n = 0; n < 2; ++n) _Pragma("unroll") for (int k = 0; k < 2; ++k) \
        acc[ai][bj][m][n] = __builtin_amdgcn_mfma_f32_16x16x32_bf16(Bt[n][k], At[m][k], acc[ai][bj][m][n], 0, 0, 0); __builtin_amdgcn_s_setprio(0); } while (0)
#define PG8_WAIT_V(n) asm volatile("s_waitcnt vmcnt(" #n ")" ::: "memory")
#define PG8_WAIT_L(n) asm volatile("s_waitcnt lgkmcnt(" #n ")" ::: "memory")
#define PG8_BAR __builtin_amdgcn_s_barrier()
#define PG8_SCHED __builtin_amdgcn_sched_barrier(0)
    Unit cur, nxt; int ui = 0;
    if (!S.next(0, cur)) return;
    if (stagger_ticks > 0) { const unsigned long long t0_ = __builtin_amdgcn_s_memrealtime(); while (__builtin_amdgcn_s_memrealtime() - t0_ < (unsigned long long)stagger_ticks) __builtin_amdgcn_s_sleep(8); }
    f32x4 acc[2][2][4][2];
#pragma unroll
    for (int a = 0; a < 2; ++a)
#pragma unroll
        for (int b = 0; b < 2; ++b)
#pragma unroll
            for (int m = 0; m < 4; ++m)
#pragma unroll
                for (int n = 0; n < 2; ++n) acc[a][b][m][n] = (f32x4){0.f, 0.f, 0.f, 0.f};
    bf16x8 At[4][2], B0[2][2], B1[2][2];
    const char* cA = (const char*)g.A + (size_t)cur.pm * tstep; const char* cB = (const char*)g.Bt + (size_t)cur.pn * tstep;
    S.a_ready(cur);
    if constexpr (SP2) {
        PG8_STAGE(PG8_SB(0, 0), cB, voffB); PG8_STAGE(PG8_SB(0, 1), cB + hstepB, voffB); PG8_STAGE(PG8_SA(0, 0), cA, voffA); PG8_STAGE(PG8_SA(0, 1), cA + hstep, voffA);
        if (wr == 1) PG8_BAR;
        PG8_WAIT_V(2); PG8_BAR;
        PG8_STAGE(PG8_SB(1, 0), cB + kstepB, voffB); PG8_STAGE(PG8_SA(1, 0), cA + kstep, voffA); PG8_STAGE(PG8_SB(1, 1), cB + hstepB + kstepB, voffB);
        PG8_WAIT_V(6); PG8_BAR;
    } else {
        PG8_STAGE(PG8_SB(0, 0), cB, voffB); PG8_STAGE(PG8_SA(0, 0), cA, voffA); PG8_STAGE(PG8_SB(0, 1), cB + hstepB, voffB); PG8_STAGE(PG8_SA(0, 1), cA + hstep, voffA);
        if (wr == 1) PG8_BAR;
        PG8_WAIT_V(4); PG8_BAR;
        PG8_STAGE(PG8_SB(1, 0), cB + kstepB, voffB); PG8_STAGE(PG8_SA(1, 0), cA + kstep, voffA); PG8_STAGE(PG8_SB(1, 1), cB + hstepB + kstepB, voffB);
        PG8_WAIT_V(6); PG8_BAR;
    }
    for (;;) {
        const bool has_next = S.next(ui + 1, nxt);
        const char* nA = has_next ? (const char*)g.A + (size_t)nxt.pm * tstep : cA; const char* nB = has_next ? (const char*)g.Bt + (size_t)nxt.pn * tstep : cB;
#pragma unroll 1
        for (int t = 0; t < nt; t += 2) {
            const bool last = (t == nt - 2);
            const char* a1 = cA + (size_t)(t + 1) * kstep;
            const char* a2 = last ? nA : cA + (size_t)(t + 2) * kstep; const char* b2 = last ? nB : cB + (size_t)(t + 2) * kstepB;
            const char* a3 = a2 + kstep; const char* b3 = b2 + kstepB;
            if (last && has_next) S.a_ready(nxt);
            if constexpr (SP2) {
            PG8_LDB(B0, 0, 0); PG8_LDB(B1, 0, 1); PG8_SCHED; PG8_LDA(At, 0, 0); PG8_STAGE(PG8_SA(1, 1), a1 + hstep, voffA);
            PG8_WAIT_V(8); PG8_WAIT_L(0); PG8_BAR; PG8_MMA(0, 0, At, B0); PG8_MMA(0, 1, At, B1); PG8_BAR; PG8_SCHED;
            PG8_LDA(At, 0, 1); PG8_STAGE(PG8_SB(0, 0), b2, voffB); PG8_STAGE(PG8_SB(0, 1), b2 + hstepB, voffB); PG8_STAGE(PG8_SA(0, 0), a2, voffA);
            PG8_WAIT_V(8); PG8_WAIT_L(0); PG8_BAR; PG8_MMA(1, 0, At, B0); PG8_MMA(1, 1, At, B1); PG8_BAR; PG8_SCHED;
            PG8_LDB(B0, 1, 0); PG8_LDB(B1, 1, 1); PG8_SCHED; PG8_LDA(At, 1, 0); PG8_STAGE(PG8_SA(0, 1), a2 + hstep, voffA);
            PG8_WAIT_V(8); PG8_WAIT_L(0); PG8_BAR; PG8_MMA(0, 0, At, B0); PG8_MMA(0, 1, At, B1); PG8_BAR; PG8_SCHED;
            PG8_LDA(At, 1, 1); PG8_STAGE(PG8_SB(1, 0), b3, voffB); PG8_STAGE(PG8_SB(1, 1), b3 + hstepB, voffB); PG8_STAGE(PG8_SA(1, 0), a3, voffA);
            PG8_WAIT_V(8); PG8_WAIT_L(0); PG8_BAR; PG8_MMA(1, 0, At, B0); PG8_MMA(1, 1, At, B1); PG8_BAR; PG8_SCHED;
            } else {
            PG8_LDB(B0, 0, 0); PG8_SCHED; PG8_LDA(At, 0, 0); PG8_STAGE(PG8_SA(1, 1), a1 + hstep, voffA);
            PG8_WAIT_L(8); PG8_BAR; PG8_WAIT_L(0); PG8_MMA(0, 0, At, B0); PG8_BAR; PG8_SCHED;
            PG8_LDB(B1, 0, 1); PG8_STAGE(PG8_SB(0, 0), b2, voffB);
            PG8_BAR; PG8_WAIT_L(0); PG8_MMA(0, 1, At, B1); PG8_BAR;
            PG8_LDA(At, 0, 1); PG8_STAGE(PG8_SA(0, 0), a2, voffA);
            PG8_BAR; PG8_WAIT_L(0); PG8_MMA(1, 0, At, B0); PG8_BAR; PG8_SCHED;
            PG8_STAGE(PG8_SB(0, 1), b2 + hstepB, voffB);
            PG8_WAIT_V(6); PG8_BAR; PG8_MMA(1, 1, At, B1); PG8_BAR;
            PG8_LDB(B0, 1, 0); PG8_SCHED; PG8_LDA(At, 1, 0); PG8_STAGE(PG8_SA(0, 1), a2 + hstep, voffA);
            PG8_WAIT_L(8); PG8_BAR; PG8_WAIT_L(0); PG8_MMA(0, 0, At, B0); PG8_BAR; PG8_SCHED;
            PG8_LDB(B1, 1, 1); PG8_STAGE(PG8_SB(1, 0), b3, voffB);
            PG8_BAR; PG8_WAIT_L(0); PG8_MMA(0, 1, At, B1); PG8_BAR;
            PG8_LDA(At, 1, 1); PG8_STAGE(PG8_SA(1, 0), a3, voffA);
            PG8_BAR; PG8_WAIT_L(0); PG8_MMA(1, 0, At, B0); PG8_BAR; PG8_SCHED;
            PG8_STAGE(PG8_SB(1, 1), b3 + hstepB, voffB);
            PG8_WAIT_V(6); PG8_BAR; PG8_MMA(1, 1, At, B1); PG8_BAR;
            }
        }
        if constexpr (ALIGN_EPI) { if (wr == 0) PG8_BAR; }
        if constexpr (!Epi::AFTER_DRAIN) { E(acc, cur, wr, wc, fr, fq); S.done(cur); }
        if (!has_next) break;
#pragma unroll
        for (int a = 0; a < 2; ++a)
#pragma unroll
            for (int b = 0; b < 2; ++b)
#pragma unroll
                for (int m = 0; m < 4; ++m)
#pragma unroll
                    for (int n = 0; n < 2; ++n) acc[a][b][m][n] = (f32x4){0.f, 0.f, 0.f, 0.f};
        cur = nxt; cA = nA; cB = nB; ++ui;
        if constexpr (ALIGN_EPI) { if (wr == 1) PG8_BAR; }
    }
    PG8_WAIT_V(0);
    if constexpr (!ALIGN_EPI) { if (wr == 0) PG8_BAR; }
    PG8_BAR;
    if constexpr (Epi::AFTER_DRAIN) { E.fused(acc, cur, wr, wc, fr, fq, lds, wid, lane); S.done(cur); }
#undef PG8_SA
#undef PG8_SB
#undef PG8_STAGE
#undef PG8_LDA
#undef PG8_LDB
#undef PG8_MMA
#undef PG8_WAIT_V
#undef PG8_WAIT_L
#undef PG8_BAR
#undef PG8_SCHED
}
}
namespace att {
typedef unsigned short bf16;
typedef short bf16x8 __attribute__((ext_vector_type(8)));
typedef short s16x4 __attribute__((ext_vector_type(4)));
typedef float f32x16 __attribute__((ext_vector_type(16)));
typedef float f32x4 __attribute__((ext_vector_type(4)));
typedef unsigned u32x4 __attribute__((ext_vector_type(4)));
constexpr int NW = 8, QBLK = 32, KVBLK = 64, QB = NW * QBLK;
constexpr int DN = 128, DR = 64, DQ = 192, DV = 128, SEQ = 2048, NH = 8, NB = 16, OSTR = 1024;
constexpr int SHM_V = KVBLK * DV * 2, SHM_K = KVBLK * DN * 2, RPAD = 144, SHM_R = KVBLK * RPAD;
constexpr int OFF_V = 0, OFF_K = 3 * SHM_V, OFF_R = OFF_K + 2 * SHM_K, OFF_WS = OFF_R + 2 * SHM_R, OFF_QS = OFF_WS + NW * 64 * 4, LDS_BYTES = OFF_QS + NW * 4096;
constexpr float SCALE = 0.07216878364870323f;
constexpr float THR = 8.f;
constexpr int WIN = 1 << 30;

#define KSWZ(row, colB) ((row) * 256 + ((colB) ^ (((row) & 7) << 4)))
#define SBAR() __builtin_amdgcn_sched_barrier(0)
__device__ __forceinline__ int v_st(int k, int c) { const int kk = (k & ~0xC) | ((k & 4) << 1) | ((k & 8) >> 1); return ((kk >> 3) * 4 + (c >> 5)) * 512 + ((kk & 7) * 32 + (c & 31)) * 2; }
__device__ __forceinline__ int v_rd_base(int lane) { return ((lane & 3) << 3) | (((lane >> 2) & 3) << 6) | (((lane >> 4) & 1) << 5) | (((lane >> 5) & 1) << 8); }
constexpr int v_rd_off(int d0, int ks, int half) { return d0 * 512 + ks * 4096 + half * 2048; }
__device__ __forceinline__ int crow(int r, int hi) { return (r & 3) + 8 * (r >> 2) + 4 * hi; }
__device__ __forceinline__ unsigned cvtpk(float lo, float hi) { unsigned r; asm volatile("v_cvt_pk_bf16_f32 %0, %1, %2" : "=v"(r) : "v"(lo), "v"(hi)); return r; }
__device__ __forceinline__ bf16x8 load8(const bf16* p) { return *reinterpret_cast<const bf16x8*>(p); }
__device__ __forceinline__ void mask_tile(f32x16& p0, f32x16& p1, int dq, unsigned W) {
    const float NEG = -__builtin_inff();
#pragma unroll
    for (int r = 0; r < 16; ++r) {
        const int c = (r & 3) + 8 * (r >> 2);
        if ((unsigned)(dq - c) >= W) p0[r] = NEG;
        if ((unsigned)(dq - c - 32) >= W) p1[r] = NEG;
    }
}
__device__ __forceinline__ void partialSM(f32x16& p0, f32x16& p1, float& m_reg, float& mn, float& alpha) {
    float pmax = p0[0]; for (int r = 1; r < 16; ++r) pmax = fmaxf(pmax, p0[r]); for (int r = 0; r < 16; ++r) pmax = fmaxf(pmax, p1[r]);
    { auto rr = __builtin_amdgcn_permlane32_swap(__float_as_uint(pmax), __float_as_uint(pmax), false, false);
      pmax = fmaxf(__uint_as_float(rr[0]), __uint_as_float(rr[1])); }
    constexpr float C2 = 1.4426950408889634f * SCALE;
    if (__builtin_expect(__all((pmax - m_reg) * SCALE <= THR), 1)) { mn = m_reg; alpha = 1.f; }
    else { mn = fmaxf(m_reg, pmax); alpha = __builtin_amdgcn_exp2f((m_reg - mn) * C2); m_reg = mn; }
    const float mnL = -mn * C2;
    for (int r = 0; r < 16; ++r) p0[r] = fmaf(p0[r], C2, mnL); for (int r = 0; r < 16; ++r) p1[r] = fmaf(p1[r], C2, mnL);
    for (int r = 0; r < 16; ++r) p0[r] = __builtin_amdgcn_exp2f(p0[r]);
}
__device__ __forceinline__ void finishSM(f32x16& p0, f32x16& p1, float alpha, float& l_reg, bf16x8& pa0, bf16x8& pa1, bf16x8& pa2, bf16x8& pa3) {
    for (int r = 0; r < 16; ++r) p1[r] = __builtin_amdgcn_exp2f(p1[r]);
    float ps = 0; for (int r = 0; r < 16; ++r) ps += p0[r]; for (int r = 0; r < 16; ++r) ps += p1[r];
    { auto rr = __builtin_amdgcn_permlane32_swap(__float_as_uint(ps), __float_as_uint(ps), false, false);
      ps = __uint_as_float(rr[0]) + __uint_as_float(rr[1]); }
    l_reg = l_reg * alpha + ps;
#define PK4(P, B_, OUT) do { unsigned a0 = cvtpk(P[B_+0], P[B_+1]), a1 = cvtpk(P[B_+2], P[B_+3]);                          \
        unsigned b0 = cvtpk(P[B_+4], P[B_+5]), b1 = cvtpk(P[B_+6], P[B_+7]);                                             \
        auto r0 = __builtin_amdgcn_permlane32_swap(a0, b0, false, false); auto r1 = __builtin_amdgcn_permlane32_swap(a1, b1, false, false); \
        u32x4 w = {r0[0], r1[0], r0[1], r1[1]}; OUT = *reinterpret_cast<bf16x8*>(&w); } while (0)
    PK4(p0, 0, pa0); PK4(p0, 8, pa1); PK4(p1, 0, pa2); PK4(p1, 8, pa3);
#undef PK4
}
template <int KB>
__device__ __forceinline__ void qkt(f32x16& p0, f32x16& p1, const char* K_lds, const char* R_lds, int r32, int hi, const bf16x8* qr, const char* qsp) {
    p0 = f32x16{}; p1 = f32x16{};
    const char* kb[4];
#pragma unroll
    for (int dd = 0; dd < 4; ++dd) kb[dd] = K_lds + KB * SHM_K + KSWZ(r32, (dd * 16 + hi * 8) * 2);
#pragma unroll
    for (int d0 = 0; d0 < 8; ++d0) { const char* a = kb[d0 & 3] + (d0 >> 2) * 128;
        bf16x8 b0 = *reinterpret_cast<const bf16x8*>(a);
        bf16x8 b1 = *reinterpret_cast<const bf16x8*>(a + 32 * 256);
        p0 = __builtin_amdgcn_mfma_f32_32x32x16_bf16(b0, qr[d0], p0, 0, 0, 0);
        p1 = __builtin_amdgcn_mfma_f32_32x32x16_bf16(b1, qr[d0], p1, 0, 0, 0); }
    const char* rb = R_lds + KB * SHM_R + r32 * RPAD + hi * 16;
#pragma unroll
    for (int d0 = 0; d0 < 4; ++d0) {
        bf16x8 b0 = *reinterpret_cast<const bf16x8*>(rb + d0 * 32);
        bf16x8 b1 = *reinterpret_cast<const bf16x8*>(rb + d0 * 32 + 32 * RPAD);
        const bf16x8 qf = *reinterpret_cast<const bf16x8*>(qsp + d0 * 1024);
        p0 = __builtin_amdgcn_mfma_f32_32x32x16_bf16(b0, qf, p0, 0, 0, 0);
        p1 = __builtin_amdgcn_mfma_f32_32x32x16_bf16(b1, qf, p1, 0, 0, 0); }
}
template <int VB>
__device__ __forceinline__ void pv_tile(f32x16* o, int vb0, bf16x8 pa0, bf16x8 pa1, bf16x8 pa2, bf16x8 pa3) {
#define TRRD(dst, off) asm volatile("ds_read_b64_tr_b16 %0, %1 offset:%2" : "=&v"(dst) : "v"(vb0), "i"(off) : "memory")
#define PV_KS(ks, PA) do { s16x4 l0, l1, l2, l3, h0, h1, h2, h3; constexpr int b_ = VB * SHM_V + v_rd_off(0, ks, 0);   \
        TRRD(l0, b_); TRRD(h0, b_ + 2048); TRRD(l1, b_ + 512); TRRD(h1, b_ + 512 + 2048); TRRD(l2, b_ + 1024); TRRD(h2, b_ + 1024 + 2048); TRRD(l3, b_ + 1536); TRRD(h3, b_ + 1536 + 2048); \
        asm volatile("s_waitcnt lgkmcnt(0)" ::: "memory"); SBAR();   \
        o[0] = __builtin_amdgcn_mfma_f32_32x32x16_bf16(PA, (bf16x8){l0[0], l0[1], l0[2], l0[3], h0[0], h0[1], h0[2], h0[3]}, o[0], 0, 0, 0);   \
        o[1] = __builtin_amdgcn_mfma_f32_32x32x16_bf16(PA, (bf16x8){l1[0], l1[1], l1[2], l1[3], h1[0], h1[1], h1[2], h1[3]}, o[1], 0, 0, 0);   \
        o[2] = __builtin_amdgcn_mfma_f32_32x32x16_bf16(PA, (bf16x8){l2[0], l2[1], l2[2], l2[3], h2[0], h2[1], h2[2], h2[3]}, o[2], 0, 0, 0);   \
        o[3] = __builtin_amdgcn_mfma_f32_32x32x16_bf16(PA, (bf16x8){l3[0], l3[1], l3[2], l3[3], h3[0], h3[1], h3[2], h3[3]}, o[3], 0, 0, 0); } while (0)
    PV_KS(0, pa0); PV_KS(1, pa1); PV_KS(2, pa2); PV_KS(3, pa3);
#undef PV_KS
#undef TRRD
}

struct BlockRef { const bf16* Q; const bf16* K; const bf16* R; const bf16* V; bf16* O; int P0; int row0; };
__device__ __forceinline__ BlockRef make_ref(int L, int pass, const bf16* Q, const bf16* K, const bf16* R, const bf16* V, bf16* O) {
    const int xcd = L & 7, k = L >> 3, bh = (k >> 2) * 8 + xcd, x = k & 3, qb = pass ? 7 - x : x, b = bh >> 3, h = bh & 7;
    BlockRef r;
    r.Q = Q + ((size_t)bh * SEQ + (size_t)qb * QB) * DQ; r.K = K + (size_t)bh * SEQ * DN; r.V = V + (size_t)bh * SEQ * DV; r.R = R + (size_t)b * SEQ * DR;
    r.O = O + ((size_t)b * SEQ + (size_t)qb * QB) * OSTR + h * DV; r.P0 = qb * QB; r.row0 = b * SEQ + qb * QB;
    return r;
}
#define ROW(p, k0, rr) ((p) + (size_t)((k0) + (rr)) * 128 + sc)
#define RROW(p, k0) ((p) + (size_t)((k0) + rsr) * 64 + rsc)
#define VMW() asm volatile("s_waitcnt vmcnt(0)" ::: "memory")
#define SLOAD_H(Kp, Rp, Vp, k0) do { st_v0 = load8(ROW(Vp, k0, sr)); st_v1 = load8(ROW(Vp, k0, 32 + sr));              \
                         st_k0 = load8(ROW(Kp, k0, sr)); st_k1 = load8(ROW(Kp, k0, 32 + sr)); st_r = load8(RROW(Rp, k0)); } while (0)
#define SWRITE_H(bf) do { *(bf16x8*)(V_lds + (bf) * SHM_V + vst0) = st_v0; *(bf16x8*)(V_lds + (bf) * SHM_V + vst1) = st_v1; \
                          *(bf16x8*)(K_lds + (bf) * SHM_K + kws) = st_k0; *(bf16x8*)(K_lds + (bf) * SHM_K + kws + 32 * 256) = st_k1; *(bf16x8*)(R_lds + (bf) * SHM_R + rws) = st_r; } while (0)
__device__ __forceinline__ void q_finalize(bf16x8 (&qr)[8], const BlockRef& cur, char* lds, int wid, const float* gq, const float* cs_tab) {
    {
            const int ln2_ = mk_lane(), r32 = ln2_ & 31, hi = ln2_ >> 5;
            const bf16* qp = cur.Q + (size_t)(wid * QBLK + r32) * DQ + hi * 8;
            char* qsp = lds + OFF_QS + wid * 4096 + ln2_ * 16;
            {
                bf16x8 raw[8];
#pragma unroll
                for (int d0 = 0; d0 < 8; ++d0) raw[d0] = load8(qp + d0 * 16);
                float sn = 0.f;
#pragma unroll
                for (int d0 = 0; d0 < 8; ++d0)
#pragma unroll
                    for (int j = 0; j < 8; ++j) { const float x = __builtin_bit_cast(float, (unsigned)(unsigned short)raw[d0][j] << 16); sn += x * x; }
                { auto rr = __builtin_amdgcn_permlane32_swap(__float_as_uint(sn), __float_as_uint(sn), false, false); sn = __uint_as_float(rr[0]) + __uint_as_float(rr[1]); }
                const float rn = rsqrtf(sn * (1.0f / 128.0f) + 1e-6f);
#pragma unroll
                for (int d0 = 0; d0 < 8; ++d0) { const f32x4 ga = *(const f32x4*)(gq + d0 * 16 + hi * 8), gb = *(const f32x4*)(gq + d0 * 16 + hi * 8 + 4); u32x4 w;
#define QX(j) (__builtin_bit_cast(float, (unsigned)(unsigned short)raw[d0][j] << 16) * rn)
                    w.x = cvtpk(QX(0) * ga[0], QX(1) * ga[1]); w.y = cvtpk(QX(2) * ga[2], QX(3) * ga[3]); w.z = cvtpk(QX(4) * gb[0], QX(5) * gb[1]); w.w = cvtpk(QX(6) * gb[2], QX(7) * gb[3]);
#undef QX
                    qr[d0] = *reinterpret_cast<bf16x8*>(&w); }
                asm volatile("" : "+v"(qr[0]), "+v"(qr[1]), "+v"(qr[2]), "+v"(qr[3]), "+v"(qr[4]), "+v"(qr[5]), "+v"(qr[6]), "+v"(qr[7]));
            }
            bf16x8 raw[12];
#pragma unroll
            for (int d0 = 8; d0 < 12; ++d0) raw[d0] = load8(qp + d0 * 16);
            float sr = 0.f;
#pragma unroll
            for (int d0 = 8; d0 < 12; ++d0)
#pragma unroll
                for (int j = 0; j < 8; ++j) { const float x = __builtin_bit_cast(float, (unsigned)(unsigned short)raw[d0][j] << 16); sr += x * x; }
            { auto rr = __builtin_amdgcn_permlane32_swap(__float_as_uint(sr), __float_as_uint(sr), false, false); sr = __uint_as_float(rr[0]) + __uint_as_float(rr[1]); }
            const float rrs = rsqrtf(sr * (1.0f / 64.0f) + 1e-6f);
            const float* csr = cs_tab + (size_t)(cur.row0 + wid * QBLK + r32) * 64;
#pragma unroll
            for (int dp = 0; dp < 2; ++dp) { u32x4 wlo, whi; unsigned lo[4], hi4[4];
#pragma unroll
                for (int jj = 0; jj < 4; ++jj) {
                    const f32x4 cs4 = *(const f32x4*)(csr + (16 * dp + 8 * hi + 2 * jj) * 2);
                    const int j = 2 * jj;
                    const float g1a = gq[128 + 16 * dp + 8 * hi + j], g1b = gq[128 + 16 * dp + 8 * hi + j + 1], g2a = gq[128 + 32 + 16 * dp + 8 * hi + j], g2b = gq[128 + 32 + 16 * dp + 8 * hi + j + 1];
                    const float t1a = __builtin_bit_cast(float, (unsigned)(unsigned short)raw[8 + dp][j] << 16) * rrs * g1a, t1b = __builtin_bit_cast(float, (unsigned)(unsigned short)raw[8 + dp][j + 1] << 16) * rrs * g1b;
                    const float t2a = __builtin_bit_cast(float, (unsigned)(unsigned short)raw[10 + dp][j] << 16) * rrs * g2a, t2b = __builtin_bit_cast(float, (unsigned)(unsigned short)raw[10 + dp][j + 1] << 16) * rrs * g2b;
                    lo[jj] = cvtpk(t1a * cs4[0] - t2a * cs4[1], t1b * cs4[2] - t2b * cs4[3]);
                    hi4[jj] = cvtpk(t2a * cs4[0] + t1a * cs4[1], t2b * cs4[2] + t1b * cs4[3]);
                }
                wlo = (u32x4){lo[0], lo[1], lo[2], lo[3]}; whi = (u32x4){hi4[0], hi4[1], hi4[2], hi4[3]};
                *reinterpret_cast<u32x4*>(qsp + dp * 1024) = wlo; *reinterpret_cast<u32x4*>(qsp + (dp + 2) * 1024) = whi; }
        }
}
__device__ __forceinline__ void o_epilogue(const f32x16 (&o)[4], float l_reg, bf16* Oblk, char* lds, float* li_l, int wid, int lane, int r32, int hi) {
        if (hi == 0) li_l[r32] = l_reg; asm volatile("s_waitcnt lgkmcnt(0)" ::: "memory");
        float rli[16];
#pragma unroll
        for (int r = 0; r < 16; ++r) rli[r] = __builtin_amdgcn_rcpf(li_l[crow(r, hi)]);
        bf16* Ow = Oblk + (size_t)(wid * QBLK) * OSTR;
        bf16* stg = (bf16*)(lds + OFF_QS + wid * 4096);
#pragma unroll
        for (int hf = 0; hf < 2; ++hf) {
#pragma unroll
            for (int r = 0; r < 16; ++r) { const int orow = crow(r, hi);
#pragma unroll
                for (int d = 0; d < 2; ++d) stg[orow * 64 + d * 32 + r32] = (bf16)(cvtpk(o[2 * hf + d][r] * rli[r], 0.f) & 0xffffu); }
            asm volatile("s_waitcnt lgkmcnt(0)" ::: "memory");
#pragma unroll
            for (int i = 0; i < 4; ++i) { const int row = i * 8 + (lane >> 3), ch = lane & 7; const u32x4 v = *(const u32x4*)(stg + row * 64 + ch * 8); *(u32x4*)(Ow + (size_t)row * OSTR + hf * 64 + ch * 8) = v; }
            asm volatile("s_waitcnt lgkmcnt(0)" ::: "memory");
        }
}
__device__ __forceinline__ void attn_phase(char* lds, const bf16* Q, const bf16* K, const bf16* R, const bf16* V, bf16* O, const float* gq, const float* cs_tab, int G, int c, int wave_s) {
    constexpr int total = 4 * NB * NH;
    int tid_ = wave_s * 64 + mk_lane(); asm volatile("" : "+v"(tid_));
    const int tid = tid_, wid = __builtin_amdgcn_readfirstlane(tid >> 6), lane = tid & 63, r32 = lane & 31, hi = lane >> 5;
    const int grp = wid >> 2;
    int L = c; if (L >= total) return;
    int pass = 0;
    BlockRef cur = make_ref(L, 0, Q, K, R, V, O);
    char* V_lds = lds + OFF_V; char* K_lds = lds + OFF_K; char* R_lds = lds + OFF_R;
    float* ws = (float*)(lds + OFF_WS) + wid * 64; float* li_l = ws, * al_l = ws + 32;
    char* qsp = lds + OFF_QS + wid * 4096 + lane * 16;
    const int sr = tid >> 4, sc = (tid & 15) * 8, vst0 = v_st(sr, sc), vst1 = v_st(32 + sr, sc), kws = KSWZ(sr, sc * 2);
    const int rsr = tid >> 3, rsc = (tid & 7) * 8, rws = rsr * RPAD + rsc * 2;
    const int vb0 = (int)(uintptr_t)V_lds + v_rd_base(lane);
    bf16x8 st_v0 = {}, st_v1 = {}, st_k0 = {}, st_k1 = {}, st_r = {};
#define SWRITE_KV(kb, vr) do { *(bf16x8*)(V_lds + (vr) * SHM_V + vst0) = st_v0; *(bf16x8*)(V_lds + (vr) * SHM_V + vst1) = st_v1; \
                               *(bf16x8*)(K_lds + (kb) * SHM_K + kws) = st_k0; *(bf16x8*)(K_lds + (kb) * SHM_K + kws + 32 * 256) = st_k1; *(bf16x8*)(R_lds + (kb) * SHM_R + rws) = st_r; } while (0)
    SLOAD_H(cur.K, cur.R, cur.V, 0); VMW(); SWRITE_KV(0, 0);
    __syncthreads();
    int vsel = 0;
    bool pend = false, have_old = false;
    bf16* oldO = cur.O;
    bf16x8 pa0 = {}, pa1 = {}, pa2 = {}, pa3 = {}; bf16x8 qr[8] = {};
    float m_reg = -1e30f, l_reg = 0; f32x16 o[4] = {};
#define RESC(a) do { if (__any((a) < 1.f)) { if (hi == 0) al_l[r32] = (a); asm volatile("s_waitcnt lgkmcnt(0)" ::: "memory");              \
                     for (int d_ = 0; d_ < 4; ++d_) for (int r = 0; r < 16; ++r) o[d_][r] *= al_l[crow(r, hi)]; } } while (0)
#define NEWBLOCK() do { q_finalize(qr, cur, lds, wid, gq, cs_tab); m_reg = -1e30f; l_reg = 0; _Pragma("unroll") for (int d_ = 0; d_ < 4; ++d_) o[d_] = f32x16{}; } while (0)
#define STEP(t, KB) do { const int kb_ = (t) * KVBLK; const int vprev = vsel == 0 ? 2 : vsel - 1, vnext = vsel == 2 ? 0 : vsel + 1;       \
        if (grp) {                                                              \
            if (pend) { pv_tile<0>(o, vb0 + vprev * SHM_V, pa0, pa1, pa2, pa3); pend = false; }                                          \
            if ((t) == 0) { if (have_old) o_epilogue(o, l_reg, oldO, lds, li_l, wid, lane, r32, hi); NEWBLOCK(); } }                     \
        if (kb_ <= qlo + QBLK - 1) {                                            \
            f32x16 p0 = {}, p1 = {}; float mn = 0.f, al = 1.f;                                                                                                 \
            SBAR(); qkt<KB>(p0, p1, K_lds, R_lds, r32, hi, qr, qsp);                                                                     \
            if (kb_ + KVBLK - 1 > qlo) mask_tile(p0, p1, qm - kb_, (unsigned)WIN);                                                        \
            partialSM(p0, p1, m_reg, mn, al); RESC(al);                                                                                  \
            finishSM(p0, p1, al, l_reg, pa0, pa1, pa2, pa3); SBAR();                                                                     \
            if (grp) pend = true; else pv_tile<0>(o, vb0 + vsel * SHM_V, pa0, pa1, pa2, pa3); }                                          \
        VMW(); SWRITE_KV((KB) ^ 1, vnext); __syncthreads(); vsel = vnext; } while (0)
    for (;;) {
        const bool more_pass = pass == 0, more_item = L + G < total, last = !more_pass && !more_item;
        int passn = pass + 1, Ln = L;
        if (!more_pass) { passn = 0; Ln = more_item ? L + G : L; }
        const BlockRef nxt = last ? cur : make_ref(Ln, passn, Q, K, R, V, O);
        const int NT = cur.P0 / KVBLK + 4;
        const int qlo = cur.P0 + wid * QBLK, qm = qlo + r32 - 4 * hi;
        const bf16* Kh = cur.K; const bf16* Vh = cur.V; const bf16* Rh = cur.R;
        if (!grp) NEWBLOCK();
        for (int t = 0; t < NT; t += 2) {
            SLOAD_H(Kh, Rh, Vh, (t + 1) * KVBLK); SBAR();
            STEP(t, 0);
            const bool lt = t + 2 >= NT;
            if (!lt) { SLOAD_H(Kh, Rh, Vh, (t + 2) * KVBLK); } else { SLOAD_H(nxt.K, nxt.R, nxt.V, 0); }
            SBAR();
            STEP(t + 1, 1);
        }
        if (grp) { oldO = cur.O; have_old = true; } else o_epilogue(o, l_reg, cur.O, lds, li_l, wid, lane, r32, hi);
        if (last) break;
        cur = nxt; pass = passn; L = Ln;
    }
    if (grp) { if (pend) pv_tile<0>(o, vb0 + (vsel == 0 ? 2 : vsel - 1) * SHM_V, pa0, pa1, pa2, pa3); o_epilogue(o, l_reg, oldO, lds, li_l, wid, lane, r32, hi); }
    __syncthreads();
#undef RESC
#undef NEWBLOCK
#undef STEP
#undef SWRITE_KV
}
#undef ROW
#undef RROW
#undef VMW
#undef SLOAD_H
#undef SWRITE_H
#undef KSWZ
#undef SBAR
}
#define GAS __attribute__((address_space(1)))
#define LAS __attribute__((address_space(3)))
typedef unsigned short bf16;
typedef unsigned v4u __attribute__((ext_vector_type(4)));
typedef float f32x4 __attribute__((ext_vector_type(4)));
typedef short bf16x8 __attribute__((ext_vector_type(8)));
typedef GAS unsigned gu32;
typedef GAS unsigned long long gu64;
#define RLX_AGENT __ATOMIC_RELAXED, __HIP_MEMORY_SCOPE_AGENT
#define LDS_WAIT() asm volatile("s_waitcnt lgkmcnt(0)" ::: "memory")
#define VM_WAIT() asm volatile("s_waitcnt vmcnt(0)" ::: "memory")
__device__ __forceinline__ unsigned long long rt() { return __builtin_amdgcn_s_memrealtime(); }
__device__ __forceinline__ unsigned f2bf(float f) { unsigned u = __builtin_bit_cast(unsigned, f); return (u + 0x7fffu + ((u >> 16) & 1u)) >> 16; }
__device__ __forceinline__ unsigned pk2(float lo, float hi) { return f2bf(lo) | (f2bf(hi) << 16); }
#define XB_TMO      128
#define XB_XCNT(j)  (256  + 64 * (j))
#define XB_XSUB(j)  (1280 + 64 * (j))
#define XB_XGEN(j)  (2304 + 64 * (j))
#define XB_TOP      3328
#define XB_TOPGEN   3392
#define XCD_BAR_WORDS 3456
#define XB_SPIN_CAP (1u << 18)

__device__ __forceinline__ unsigned xb_ld(unsigned* p)              { return __hip_atomic_load(p, __ATOMIC_RELAXED, __HIP_MEMORY_SCOPE_AGENT); }
__device__ __forceinline__ unsigned xb_add(unsigned* p, unsigned v) { return __hip_atomic_fetch_add(p, v, __ATOMIC_RELAXED, __HIP_MEMORY_SCOPE_AGENT); }
__device__ __forceinline__ unsigned xb_xcc_id() { return (unsigned)__builtin_amdgcn_s_getreg((3 << 11) | 20) & 0xFu; }
#define XB_SPIN(cond, bar) do { unsigned _sp = 0; while (cond) { __builtin_amdgcn_s_sleep(1); \
    if ((++_sp & 255u) == 0u) { if (xb_ld(&(bar)[XB_TMO])) break; if (_sp > XB_SPIN_CAP) { atomicAdd(&(bar)[XB_TMO], 1u); break; } } } } while (0)

struct XcdBarrier {
    unsigned* bar; unsigned x;
    volatile LAS unsigned* st;
};

__device__ __forceinline__ XcdBarrier xcd_barrier_post(unsigned* bar, volatile LAS unsigned* st, bool t0  ) {
    XcdBarrier b; b.bar = bar; b.x = xb_xcc_id(); b.st = st;
    if (t0) (void)xb_add(&bar[XB_XCNT(b.x)], 1u);
    return b;
}
__device__ __forceinline__ void xcd_barrier_complete(unsigned* bar, unsigned x, unsigned& nloc, unsigned& nx) {
    const unsigned G = gridDim.x * gridDim.y * gridDim.z;
    unsigned sum, cnt, mine, sp = 0u;
    for (;;) {
        sum = 0u; cnt = 0u; mine = 0u;
#pragma unroll
        for (unsigned j = 0; j < 16; ++j) { const unsigned c = xb_ld(&bar[XB_XCNT(j)]); sum += c; cnt += (c > 0u) ? 1u : 0u; mine = (j == x) ? c : mine; }
        if (sum == G) break;
        __builtin_amdgcn_s_sleep(1);
        if ((++sp & 255u) == 0u) { if (xb_ld(&bar[XB_TMO])) break; if (sp > XB_SPIN_CAP) { atomicAdd(&bar[XB_TMO], 1u); break; } }
    }
    nloc = mine > 0u ? mine : 1u; nx = cnt > 0u ? cnt : 1u;
}

__device__ __forceinline__ void xcd_barrier(const XcdBarrier& b, bool t0) {
    asm volatile("s_waitcnt vmcnt(0)" ::: "memory");
    __syncthreads();
    if (t0) {
        unsigned* bar = b.bar;
        __builtin_amdgcn_s_waitcnt(0);
        unsigned nloc = b.st[0], nx = b.st[1];
        if (nloc == 0u) { xcd_barrier_complete(bar, b.x, nloc, nx); b.st[0] = nloc; b.st[1] = nx; }
        const unsigned old = xb_add(&bar[XB_XSUB(b.x)], 1u);
        const unsigned gen = old / nloc;
        if (old + 1u == (gen + 1u) * nloc) {
            __builtin_amdgcn_fence(__ATOMIC_RELEASE, "agent");
            asm volatile("s_waitcnt vmcnt(0)" ::: "memory");
            const unsigned og = xb_add(&bar[XB_TOP], 1u);
            const unsigned tg = og / nx;
            if (og + 1u == (tg + 1u) * nx) xb_add(&bar[XB_TOPGEN], 1u);
            else XB_SPIN(xb_ld(&bar[XB_TOPGEN]) == tg, bar);
            __builtin_amdgcn_fence(__ATOMIC_ACQUIRE, "agent");
            xb_add(&bar[XB_XGEN(b.x)], 1u);
            asm volatile("s_waitcnt vmcnt(0)" ::: "memory");
        } else {
            XB_SPIN(xb_ld(&bar[XB_XGEN(b.x)]) == gen, bar);
            __builtin_amdgcn_fence(__ATOMIC_ACQUIRE, "agent");
            asm volatile("s_waitcnt vmcnt(0)" ::: "memory");
        }
    }
    __syncthreads();
}
constexpr int NWAVES = 8;
constexpr int BATCH = 16, SEQ = 2048, T = BATCH * SEQ, D = 1024, FF = 4096;
constexpr int NPHASE = 25;
#ifndef MK_PER_PHASE
#define MK_PER_PHASE 0
#endif

constexpr size_t MiB = 1u << 20;
constexpr size_t WS_CTL = 0, CTL_ZERO_BYTES = 4 * MiB;
constexpr size_t CTL_SS = 256 * 1024;
constexpr size_t CTL_SSCQ = CTL_SS + 8 * (size_t)T * 8;
constexpr size_t CTL_SSCKV = CTL_SSCQ + 2 * (size_t)T * 8;
constexpr size_t CTL_DUMMY = CTL_SSCKV + 2 * (size_t)T * 8;
static_assert(CTL_DUMMY + (size_t)T * 8 <= CTL_ZERO_BYTES, "ctl");
constexpr size_t WS_W = 4 * MiB;
constexpr size_t W_MI = 0, W_MO = W_MI + 4 * (size_t)FF * D, W_DN = W_MO + 4 * (size_t)FF * D, W_UQ = W_DN + 2 * (size_t)768 * 1024, W_UKV = W_UQ + 2 * (size_t)1536 * 384,
                 W_AO = W_UKV + 2 * (size_t)2048 * 256, W_HI = W_AO + 2 * (size_t)1024 * 1024, W_HO = W_HI + (size_t)4096 * 1024, W_P1 = W_HO + (size_t)1024 * 1024,
                 W_P2 = W_P1 + (size_t)2048 * 1024, W_END = W_P2 + (size_t)1024 * 1024;
constexpr size_t WS_LB = WS_W + W_END * 2;
constexpr size_t WS_PV = WS_LB + 4096;
constexpr int PV_GQ = 0, PV_GK = 384, PV_ON = 768, PV_BP1 = 896, PV_WDW = 2944, PV_BDW = 34688, PV_LNG = 35712, PV_LNB = 36736, PV_BP2 = 37760, PV_POS = 38784, PV_END = PV_POS + T;
static_assert(WS_PV + (size_t)PV_END * 4 <= 96 * MiB, "weights + params");
constexpr size_t WS_XB = 96 * MiB;
constexpr size_t WS_OV = 160 * MiB;
constexpr size_t WS_HH = WS_OV;
constexpr size_t WS_Q = WS_OV, WS_K = WS_OV + 96 * MiB, WS_V = WS_OV + 160 * MiB, WS_O = WS_OV + 224 * MiB, WS_CQ = WS_OV + 288 * MiB, WS_CKV = WS_OV + 312 * MiB, WS_KR = WS_OV + 328 * MiB;
constexpr size_t WS_HQ = WS_OV, WS_HV = WS_OV + 64 * MiB, WS_HG = WS_OV + 128 * MiB, WS_HLF = WS_OV + 192 * MiB;
constexpr size_t WS_CU = WS_OV, WS_CY = WS_OV + 64 * MiB;
constexpr size_t WS_CS = 496 * MiB;
constexpr size_t WS_END = 512 * MiB;
static_assert(WS_KR + (size_t)T * 64 * 2 <= WS_END && WS_HLF + (size_t)T * 1024 * 4 <= WS_END && WS_HH + (size_t)T * FF * 2 <= WS_O + 0 * MiB + 64 * MiB, "ws map");

constexpr int CW_BAR = 4096;

constexpr int RING_OFF = 0, RING_BYTES = 135168;
constexpr int LDSCTL_OFF = RING_BYTES, MISC_OFF = LDSCTL_OFF + 320, EXTRA_OFF = RING_BYTES + 1024;
constexpr int LDS_BYTES = 147456;

__device__ __forceinline__ float wave_sum(float v) {
#pragma unroll
    for (int o = 1; o < 64; o <<= 1) v += __shfl_xor(v, o);
    return v;
}
__device__ __forceinline__ float bf2f(unsigned h) { return __builtin_bit_cast(float, h << 16); }
template <bool TILED = false> __device__ __forceinline__ void p0_transpose_item(const float* W, int K, int N, const float* gain, bf16* WT, int dst_row0, LAS float* scr, int k0, int n0, int lane) {
    float wv_[32];
#pragma unroll
    for (int i = 0; i < 32; ++i) wv_[i] = W[(size_t)(k0 + 2 * i + (lane >> 5)) * N + n0 + (lane & 31)];
#pragma unroll
    for (int i = 0; i < 32; ++i) { const int kk = 2 * i + (lane >> 5); const float gk = gain ? gain[k0 + kk] : 1.0f; scr[kk * 33 + (lane & 31)] = wv_[i] * gk; }
    LDS_WAIT(); asm volatile("" ::: "memory");
    const int c = lane & 7;
#pragma unroll
    for (int j = 0; j < 4; ++j) { const int n = (lane >> 3) + 8 * j; const LAS float* s = scr + (8 * c) * 33 + n;
        v4u o; o.x = pk2(s[0 * 33], s[1 * 33]); o.y = pk2(s[2 * 33], s[3 * 33]); o.z = pk2(s[4 * 33], s[5 * 33]); o.w = pk2(s[6 * 33], s[7 * 33]);
        const int rr = dst_row0 + n;
        if (TILED) *(GAS v4u*)(WT + (((size_t)(rr >> 8) * (K / 64) + (k0 >> 6)) * 256 + (rr & 255)) * 64 + 8 * c) = o;
        else *(GAS v4u*)(WT + (size_t)rr * K + k0 + 8 * c) = o; }
    LDS_WAIT(); asm volatile("" ::: "memory");
}

struct Args {
    const float* in[26]; float* out; unsigned char* ws; int ph_lo, ph_hi, li, pad;
};

#define P0_MAT(cnt_per, nmats, Wbase, Wstride, Kd, Nd, gainexpr, WTbase, WTstride) P0_MATX(true, cnt_per, nmats, Wbase, Wstride, Kd, Nd, gainexpr, WTbase, WTstride)
#define P0_MATX(TL, cnt_per, nmats, Wbase, Wstride, Kd, Nd, gainexpr, WTbase, WTstride) \
    if (r < (cnt_per) * (nmats)) { const int mi = r / (cnt_per), it = r % (cnt_per); const int nnb = (Nd) / 32, kb = it / nnb, nb = it % nnb; \
        p0_transpose_item<TL>((Wbase) + (size_t)mi * (Wstride), (Kd), (Nd), (gainexpr), (WTbase) + (size_t)mi * (WTstride), 32 * nb, scr, 64 * kb, 32 * nb, lane); continue; } r -= (cnt_per) * (nmats);

template <int PART> __device__ __forceinline__ void p0_weights(const Args& a, LAS unsigned char* lds, int gw, int NGW, int lane, int wave) {
    bf16* Wb = (bf16*)(a.ws + WS_W);
    LAS float* scr = (LAS float*)(lds + RING_OFF + wave * 16384);
    const float* norm_mix = a.in[2]; const float* norm_mlp = a.in[3];
    constexpr int I_MI = 16 * 128, I_MO = 64 * 32, I_DN = 16 * 22, I_UQ = 6 * 48, I_UKV = 4 * 64, I_SQ = 16 * 32, I_HI = 16 * 128, I_P1 = 16 * 64;
    constexpr int NM = PART < 2 ? 2 : 1, L0 = PART == 0 ? 0 : PART == 1 ? 2 : PART == 2 ? 0 : 1, J0 = PART == 1 ? 1 : 0;
    constexpr bool HAS_MLA = PART != 3, TAIL_HG = PART == 0 || PART == 3, TAIL_CV = PART == 1;
    constexpr int NITEMS = NM * (I_MI + I_MO) + (HAS_MLA ? I_DN + I_UQ + I_UKV + I_SQ : 0) + (TAIL_HG ? I_HI + I_SQ : 0) + (TAIL_CV ? I_P1 + I_SQ : 0);
    for (int item = gw; item < NITEMS; item += NGW) {
        int r = item;
        P0_MAT(I_MI, NM, a.in[4] + (size_t)L0 * D * FF, (size_t)D * FF, D, FF, norm_mlp + (L0 + mi) * D, Wb + W_MI + (size_t)L0 * FF * D, (size_t)FF * D)
        P0_MATX(true, I_MO, NM, a.in[5] + (size_t)L0 * FF * D, (size_t)FF * D, FF, D, (const float*)nullptr, Wb + W_MO + (size_t)L0 * FF * D, (size_t)FF * D)
        if (HAS_MLA) {
            P0_MAT(I_DN, 1, a.in[6] + (size_t)J0 * D * 704, 0, D, 704, norm_mix + J0 * 3 * D, Wb + W_DN + (size_t)J0 * 768 * D, 0)
            P0_MAT(I_UQ, 1, a.in[9] + (size_t)J0 * 384 * 1536, 0, 384, 1536, a.in[7] + J0 * 384, Wb + W_UQ + (size_t)J0 * 1536 * 384, 0)
            P0_MAT(I_UKV, 1, a.in[10] + (size_t)J0 * 256 * 2048, 0, 256, 2048, a.in[8] + J0 * 256, Wb + W_UKV + (size_t)J0 * 2048 * 256, 0)
            P0_MAT(I_SQ, 1, a.in[13] + (size_t)J0 * D * D, 0, D, D, (const float*)nullptr, Wb + W_AO + (size_t)J0 * D * D, 0)
        }
        if (TAIL_HG) {
            P0_MAT(I_HI, 1, a.in[14], 0, D, FF, norm_mix + 1 * D, Wb + W_HI, 0)
            { const int nnb = D / 32, kb = r / nnb, nb = r % nnb; p0_transpose_item<true>(a.in[17], D, D, nullptr, Wb + W_HO, 32 * nb, scr, 64 * kb, 32 * nb, lane); }
        } else if (TAIL_CV) {
            if (r < I_P1) {
                const int nnb = 2048 / 32, kb = r / nnb, nb = r % nnb, n0 = 32 * nb, bj = n0 >> 10, j0 = n0 & 1023;
                p0_transpose_item<true>(a.in[18], D, 2048, norm_mix + 2 * D, Wb + W_P1, 256 * (j0 >> 7) + 128 * bj + (j0 & 127), scr, 64 * kb, n0, lane); continue; }
            r -= I_P1;
            { const int nnb = D / 32, kb = r / nnb, nb = r % nnb; p0_transpose_item<true>(a.in[24], D, D, nullptr, Wb + W_P2, 32 * nb, scr, 64 * kb, 32 * nb, lane); }
        }
    }
}
__device__ __forceinline__ void p0_prologue(const Args& a, LAS unsigned char* lds, int vcu, int G, int tid, int lane, int wave) {
    unsigned char* ws = a.ws;
    bf16* Wb = (bf16*)(ws + WS_W);
    const int gw = vcu * NWAVES + wave, NGW = G * NWAVES;
    p0_weights<2>(a, lds, gw, NGW, lane, wave);
    for (int i = vcu * 512 + tid; i < 2 * 8192; i += G * 512) { const int j = i >> 13, rem = i & 8191, kt = rem >> 9, ch = rem & 511;
        *(GAS v4u*)(Wb + W_DN + (size_t)j * 768 * D + ((size_t)(2 * 16 + kt) * 256 + 192) * 64 + ch * 8) = (v4u){0u, 0u, 0u, 0u}; }
    for (int c = vcu * 512 + tid; c < 1024; c += G * 512) {
        const float* lg = a.in[15]; const float l0 = lg[c], l1 = lg[1024 + c], l2 = lg[2048 + c], l3 = lg[3072 + c];
        const float mx = fmaxf(fmaxf(l0, l1), fmaxf(l2, l3)); const float e0 = expf(l0 - mx), e1 = expf(l1 - mx), e2 = expf(l2 - mx), e3 = expf(l3 - mx);
        ((float*)(ws + WS_LB))[c] = e1 / (e0 + e1 + e2 + e3);
    }
    { float* pv = (float*)(ws + WS_PV); const int gt = vcu * 512 + tid, NT_ = G * 512;
#define P0_COPY(dst, src, n) for (int i = gt; i < (n); i += NT_) pv[(dst) + i] = (src)[i];
      P0_COPY(PV_GQ, a.in[11], 384) P0_COPY(PV_GK, a.in[12], 384) P0_COPY(PV_ON, a.in[16], 128) P0_COPY(PV_BP1, a.in[19], 2048) P0_COPY(PV_WDW, a.in[20], 31 * 1024)
      P0_COPY(PV_BDW, a.in[21], 1024) P0_COPY(PV_LNG, a.in[22], 1024) P0_COPY(PV_LNB, a.in[23], 1024) P0_COPY(PV_BP2, a.in[25], 1024) P0_COPY(PV_POS, a.in[1], T)
#undef P0_COPY
    }
    const float* x = a.in[0]; bf16* xb = (bf16*)(ws + WS_XB); unsigned long long* ss0 = (unsigned long long*)(ws + CTL_SS);
    for (int m0 = gw; m0 < T; m0 += 2 * NGW) {
        f32x4 v[2][4];
#pragma unroll
        for (int u = 0; u < 2; ++u) { const int mr_ = (m0 + u * NGW < T) ? m0 + u * NGW : m0; const GAS f32x4* xr = (const GAS f32x4*)(x + (size_t)mr_ * D) + lane;
#pragma unroll
            for (int j = 0; j < 4; ++j) v[u][j] = xr[64 * j]; }
#pragma unroll
        for (int u = 0; u < 2; ++u) { const int m = (m0 + u * NGW < T) ? m0 + u * NGW : m0; float s = 0.f;
#pragma unroll
            for (int j = 0; j < 4; ++j) { const float r0 = bf2f(f2bf(v[u][j].x)), r1 = bf2f(f2bf(v[u][j].y)), r2 = bf2f(f2bf(v[u][j].z)), r3 = bf2f(f2bf(v[u][j].w)); s += (r0 * r0 + r1 * r1) + (r2 * r2 + r3 * r3); }
            s = wave_sum(s);
            GAS unsigned long long* o8 = (GAS unsigned long long*)(xb + (size_t)m * D) + lane;
#pragma unroll
            for (int j = 0; j < 4; ++j) o8[64 * j] = (unsigned long long)pk2(v[u][j].x, v[u][j].y) | ((unsigned long long)pk2(v[u][j].z, v[u][j].w) << 32);
            if (lane == 0) ss0[m] = (unsigned long long)(s * 1048576.0f + 0.5f); }
    }
}

__device__ __forceinline__ void mla_finalize(const int* pos, const float* gq, const float* gk, bf16* Q, bf16* Kn, bf16* Kr, int vcu, int G, int lane, int wave) {
    const int gw = vcu * NWAVES + wave, NGW = G * NWAVES;
    const float gq0 = gq[2 * lane], gq1 = gq[2 * lane + 1], gqr = gq[128 + lane], gk0 = gk[2 * lane], gk1 = gk[2 * lane + 1], gkr = gk[128 + lane];
    const float inv_freq = powf(10000.0f, -(float)(2 * (lane & 31)) / 64.0f);
    for (int row = gw; row < T; row += NGW) {
        const int b = row >> 11, s = row & 2047;
        const float ang = (float)pos[row] * inv_freq; float sn, cs; sincosf(ang, &sn, &cs);
        const float sgn = lane < 32 ? -sn : sn;
#pragma unroll 2
        for (int h = 0; h < 8; ++h) {
            bf16* qp = Q + ((size_t)((b * 8 + h) * 2048 + s)) * 192; bf16* kp = Kn + ((size_t)((b * 8 + h) * 2048 + s)) * 128;
            const unsigned wq = *(const unsigned*)(qp + 2 * lane), wk = *(const unsigned*)(kp + 2 * lane); const unsigned er = qp[128 + lane];
            float a0 = bf2f(wq & 0xffffu), a1 = bf2f(wq >> 16), k0 = bf2f(wk & 0xffffu), k1 = bf2f(wk >> 16), e = bf2f(er);
            const float sq = wave_sum(a0 * a0 + a1 * a1), sk = wave_sum(k0 * k0 + k1 * k1), se = wave_sum(e * e);
            const float rq = rsqrtf(sq * (1.0f / 128.0f) + 1e-6f), rk = rsqrtf(sk * (1.0f / 128.0f) + 1e-6f), re = rsqrtf(se * (1.0f / 64.0f) + 1e-6f);
            *(unsigned*)(qp + 2 * lane) = pk2(a0 * rq * gq0, a1 * rq * gq1);
            *(unsigned*)(kp + 2 * lane) = pk2(k0 * rk * gk0, k1 * rk * gk1);
            e = e * re * gqr; const float pe = __shfl_xor(e, 32);
            qp[128 + lane] = (bf16)f2bf(e * cs + pe * sgn);
        }
        { bf16* rp = Kr + (size_t)row * 64; float e = bf2f(rp[lane]); const float se = wave_sum(e * e); e = e * rsqrtf(se * (1.0f / 64.0f) + 1e-6f) * gkr;
          const float pe = __shfl_xor(e, 32); rp[lane] = (bf16)f2bf(e * cs + pe * sgn); }
    }
}

__device__ __forceinline__ void kr_finalize(const int* pos, const float* gk, bf16* Kr, float* cs_tab, int vcu, int G, int lane, int wave) {
    typedef float f32x2 __attribute__((ext_vector_type(2)));
    const int gw = vcu * NWAVES + wave, NGW = G * NWAVES;
    const float gkr = gk[128 + lane];
    const float inv_freq = powf(10000.0f, -(float)(2 * (lane & 31)) / 64.0f);
    for (int row = gw; row < T; row += NGW) {
        const float ang = (float)pos[row] * inv_freq; float sn, cs; sincosf(ang, &sn, &cs);
        const float sgn = lane < 32 ? -sn : sn;
        bf16* rp = Kr + (size_t)row * 64; float e = bf2f(rp[lane]); const float se = wave_sum(e * e); e = e * rsqrtf(se * (1.0f / 64.0f) + 1e-6f) * gkr;
        const float pe = __shfl_xor(e, 32); rp[lane] = (bf16)f2bf(e * cs + pe * sgn);
        if (lane < 32) *(f32x2*)(cs_tab + (size_t)row * 64 + 2 * lane) = (f32x2){cs, sn};
    }
}

__device__ __forceinline__ void hgrn_scan_simple(LAS unsigned char* lds, bf16* hq, const bf16* hv, const bf16* hg, const float* hlf, const float* onorm, int unit, int tid) {
    LAS float* Lf = (LAS float*)(lds); LAS float* Lk = Lf + 4096; LAS float* Lq = Lk + 4096; LAS float* Lv = Lq + 4096; LAS float* Lp = Lv + 4096;
    const int b = unit >> 3, h = unit & 7, dv = tid & 127, kg = tid >> 7;
    float S[32];
#pragma unroll
    for (int j = 0; j < 32; ++j) S[j] = 0.f;
    for (int c0 = 0; c0 < SEQ; c0 += 32) {
#pragma unroll
        for (int i = 0; i < 8; ++i) { const int idx = tid + 512 * i, t = idx >> 7, c = idx & 127; const size_t g = (size_t)(b * SEQ + c0 + t) * 1024 + h * 128 + c;
            const float f = __expf(hlf[g]); Lf[idx] = f; Lk[idx] = 1.0f - f; Lq[idx] = bf2f(hq[g]); Lv[idx] = bf2f(hv[g]); }
        __syncthreads();
        for (int t = 0; t < 32; ++t) {
            const float vv = Lv[t * 128 + dv]; float acc = 0.f;
            const LAS f32x4* pf = (const LAS f32x4*)(Lf + t * 128 + kg * 32); const LAS f32x4* pk = (const LAS f32x4*)(Lk + t * 128 + kg * 32); const LAS f32x4* pq = (const LAS f32x4*)(Lq + t * 128 + kg * 32);
#pragma unroll
            for (int j4 = 0; j4 < 8; ++j4) { const f32x4 f4 = pf[j4], k4 = pk[j4], q4 = pq[j4];
#pragma unroll
                for (int e = 0; e < 4; ++e) { const int j = j4 * 4 + e; S[j] = f4[e] * S[j] + k4[e] * vv; acc += q4[e] * S[j]; } }
            Lp[(kg * 32 + t) * 128 + dv] = acc;
        }
        __syncthreads();
        { const int t = tid >> 4, d0 = (tid & 15) * 8; float o[8]; float sq = 0.f;
#pragma unroll
            for (int e = 0; e < 8; ++e) { o[e] = (Lp[(0 * 32 + t) * 128 + d0 + e] + Lp[(1 * 32 + t) * 128 + d0 + e]) + (Lp[(2 * 32 + t) * 128 + d0 + e] + Lp[(3 * 32 + t) * 128 + d0 + e]); sq += o[e] * o[e]; }
            sq += __shfl_xor(sq, 1); sq += __shfl_xor(sq, 2); sq += __shfl_xor(sq, 4); sq += __shfl_xor(sq, 8);
            const float rn = rsqrtf(sq * (1.0f / 128.0f) + 1e-6f);
            const size_t g = (size_t)(b * SEQ + c0 + t) * 1024 + h * 128 + d0;
            const v4u gv = *(const v4u*)(hg + g); unsigned w[4];
#pragma unroll
            for (int e = 0; e < 4; ++e) { const unsigned gg = e == 0 ? gv.x : e == 1 ? gv.y : e == 2 ? gv.z : gv.w;
                w[e] = pk2(o[2 * e] * rn * onorm[d0 + 2 * e] * bf2f(gg & 0xffffu), o[2 * e + 1] * rn * onorm[d0 + 2 * e + 1] * bf2f(gg >> 16)); }
            *(v4u*)(hq + g) = (v4u){w[0], w[1], w[2], w[3]}; }
        __syncthreads();
    }
}

#ifndef EXP_NO_LN
#define EXP_NO_LN 0
#endif
__device__ __forceinline__ void conv_phase(LAS unsigned char* lds, const bf16* cu, bf16* cy, const float* wdw, const float* bdw, const float* lng, const float* lnb, int vcu, int G, int tid, int lane, int wave) {
    typedef float f32x2 __attribute__((ext_vector_type(2)));
    constexpr int TT = 16, NU = TT + 30;
    LAS f32x2* red = (LAS f32x2*)(lds + RING_OFF);
    const int c0 = 2 * tid;
    f32x2 wv[31];
#pragma unroll
    for (int k = 0; k < 31; ++k) wv[k] = *(const f32x2*)(wdw + k * 1024 + c0);
    const f32x2 bd = *(const f32x2*)(bdw + c0), g2 = *(const f32x2*)(lng + c0), b2 = *(const f32x2*)(lnb + c0);
    int par = 0;
    const int NT = T / TT, TPW = (NT + G - 1) / G, tb = vcu * TPW, te = (tb + TPW < NT) ? tb + TPW : NT;
    if (tb >= te) return;
    f32x2 uv[NU];
    unsigned nx[TT];
    {
        const int row0 = tb * TT, s0 = row0 & 2047;
#pragma unroll
        for (int i = 0; i < 30; ++i) {
            unsigned u = 0u;
            if (s0 - 30 + i >= 0) u = *(const unsigned*)(cu + (size_t)(row0 - 30 + i) * 1024 + c0);
            uv[i] = (f32x2){bf2f(u & 0xffffu), bf2f(u >> 16)};
        }
#pragma unroll
        for (int i = 0; i < TT; ++i) nx[i] = *(const unsigned*)(cu + (size_t)(row0 + i) * 1024 + c0);
    }
    for (int tile = tb; tile < te; ++tile) {
        const int row0 = tile * TT;
#pragma unroll
        for (int i = 0; i < TT; ++i) uv[30 + i] = (f32x2){bf2f(nx[i] & 0xffffu), bf2f(nx[i] >> 16)};
        if (tile + 1 < te) {
#pragma unroll
            for (int i = 0; i < TT; ++i) nx[i] = *(const unsigned*)(cu + (size_t)(row0 + TT + i) * 1024 + c0);
        }
        f32x2 yv[TT];
#pragma unroll
        for (int t = 0; t < TT; ++t) { f32x2 a = bd;
#pragma unroll
            for (int k = 0; k < 31; ++k) a = __builtin_elementwise_fma(wv[k], uv[t + k], a);
            yv[t] = a; }
        LAS f32x2* wp = red + (size_t)(par * TT * 8); par ^= 1;
#pragma unroll
        for (int t = 0; t < TT; ++t) { const float s1 = wave_sum(yv[t].x + yv[t].y), s2 = wave_sum(yv[t].x * yv[t].x + yv[t].y * yv[t].y); if (lane == 0) wp[t * 8 + wave] = (f32x2){s1, s2}; }
        __syncthreads();
#pragma unroll
        for (int t = 0; t < TT; ++t) { float s1 = 0.f, s2 = 0.f;
#pragma unroll
            for (int q = 0; q < 8; ++q) { const f32x2 v = wp[t * 8 + q]; s1 += v.x; s2 += v.y; }
            const float mean = s1 * (1.0f / 1024.0f), var = fmaxf(s2 * (1.0f / 1024.0f) - mean * mean, 0.f);
            const f32x2 st = (f32x2){mean, rsqrtf(var + 1e-6f)};
            float a = (yv[t].x - st.x) * st.y * g2.x + b2.x, b = (yv[t].y - st.x) * st.y * g2.y + b2.y;
            a = a * __builtin_amdgcn_rcpf(1.0f + __expf(-a)); b = b * __builtin_amdgcn_rcpf(1.0f + __expf(-b));
            *(unsigned*)(cy + (size_t)(row0 + t) * 1024 + c0) = pk2(a, b); }
        const bool newseq = ((row0 + TT) & 2047) == 0;
#pragma unroll
        for (int i = 0; i < 30; ++i) uv[i] = newseq ? (f32x2){0.f, 0.f} : uv[i + TT];
    }
}
namespace hgs {
typedef short bf16x8 __attribute__((ext_vector_type(8)));
typedef short s16x4 __attribute__((ext_vector_type(4)));
typedef float f32x4 __attribute__((ext_vector_type(4)));
typedef float f32x2 __attribute__((ext_vector_type(2)));
typedef unsigned u32x4 __attribute__((ext_vector_type(4)));
typedef unsigned u32x2 __attribute__((ext_vector_type(2)));
constexpr int RS = 272, RK = 144, RO = 528;
constexpr int OFF_KT = 0, OFF_LF = 0, OFF_QI = 43520, OFF_VV = OFF_QI + 17408, OFF_QT = OFF_VV + 17408, OFF_KO = OFF_QT + 17408, OFF_AT = OFF_KO + 18432, OFF_SEG = OFF_AT + 9216, OFF_AL = OFF_SEG + 4096,
              OFF_OUT = OFF_QT, LDS_END = OFF_AL + 512;
static_assert(LDS_END <= 131072 && 64 * RO <= 17408 + 18432 && 10 * 16 * RS <= OFF_QI && 64 * 512 <= OFF_QI, "scan LDS map");
__device__ __forceinline__ unsigned pkbf(float lo, float hi) { unsigned r; asm volatile("v_cvt_pk_bf16_f32 %0, %1, %2" : "=v"(r) : "v"(lo), "v"(hi)); return r; }
__device__ __forceinline__ float bflo(unsigned w) { return __builtin_bit_cast(float, w << 16); }
__device__ __forceinline__ float bfhi(unsigned w) { return __builtin_bit_cast(float, w & 0xffff0000u); }
__device__ __forceinline__ void trrd4(s16x4& a, s16x4& b, s16x4& c, s16x4& d, unsigned addr) {
    asm volatile("ds_read_b64_tr_b16 %0, %4\n\tds_read_b64_tr_b16 %1, %4 offset:%5\n\tds_read_b64_tr_b16 %2, %4 offset:%6\n\tds_read_b64_tr_b16 %3, %4 offset:%7\n\ts_waitcnt lgkmcnt(0)"
                 : "=&v"(a), "=&v"(b), "=&v"(c), "=&v"(d) : "v"(addr), "n"(4 * RS), "n"(32 * RS), "n"(32 * RS + 4 * RS) : "memory");
}

__device__ __forceinline__ void scan_unit(LAS unsigned char* lds, unsigned short* hq, const unsigned short* hv, const unsigned short* hg, const float* hlf, const float* onorm, unsigned short* ho, int unit, int wave_s) {
    int tid_ = wave_s * 64 + mk_lane(); asm volatile("" : "+v"(tid_));
    const int tid = tid_, lane = tid & 63, w = __builtin_amdgcn_readfirstlane(tid >> 6);
    const int b = unit >> 3, h = unit & 7;
    const size_t gbase = (size_t)b * SEQ * 1024 + h * 128;
    u32x4 pq[2], pv[2], pg[2]; f32x4 pl[4];
#define SCAN_LOAD(c0) do { _Pragma("unroll") for (int i = 0; i < 2; ++i) { const int p = tid + 512 * i, t = p >> 4, c = p & 15; const size_t g = gbase + (size_t)((c0) + t) * 1024 + c * 8; \
            pq[i] = *(const u32x4*)(hq + g); pv[i] = *(const u32x4*)(hv + g); } \
        _Pragma("unroll") for (int i = 0; i < 4; ++i) { const int p = tid + 512 * i, t = p >> 5, c = p & 31; pl[i] = *(const f32x4*)(hlf + gbase + (size_t)((c0) + t) * 1024 + c * 4); } } while (0)
#define SCAN_STORE() do { _Pragma("unroll") for (int i = 0; i < 2; ++i) { const int p = tid + 512 * i, t = p >> 4, c = p & 15; \
            *(LAS u32x4*)(lds + OFF_QI + t * RS + c * 16) = pq[i]; *(LAS u32x4*)(lds + OFF_VV + t * RS + c * 16) = pv[i]; } \
        _Pragma("unroll") for (int i = 0; i < 4; ++i) { const int p = tid + 512 * i, t = p >> 5, c = p & 31; *(LAS f32x4*)(lds + OFF_LF + t * 512 + c * 16) = pl[i]; } } while (0)
    const int to = tid >> 3, d0 = (tid & 7) * 16;
    float gn[16];
#pragma unroll
    for (int e = 0; e < 16; ++e) gn[e] = onorm[d0 + e];
    for (int i = tid; i < 64 * RK / 4; i += 512) *(LAS unsigned*)(lds + OFF_AT + i * 4) = 0u;
    f32x4 S[8];
#pragma unroll
    for (int k = 0; k < 8; ++k) S[k] = (f32x4){0.f, 0.f, 0.f, 0.f};
    SCAN_LOAD(0); SCAN_STORE();
    const int col = lane & 15, rq = lane >> 4;
    f32x2 fv[8], R[8], Sx[8];
#define SCAN_S2() do { f32x2 ls = (f32x2){0.f, 0.f};                                                                                                   \
        _Pragma("unroll") for (int i = 0; i < 8; ++i) { const f32x2 l = *(const LAS f32x2*)(lds + OFF_LF + (8 * w + i) * 512 + lane * 8); ls += l; fv[i] = (f32x2){__expf(l.x), __expf(l.y)}; } \
        R[0] = fv[0];                                                                                                                                  \
        _Pragma("unroll") for (int i = 1; i < 8; ++i) R[i] = R[i - 1] * fv[i];                                                                         \
        Sx[7] = (f32x2){1.f, 1.f};                                                                                                                     \
        _Pragma("unroll") for (int i = 6; i >= 0; --i) Sx[i] = Sx[i + 1] * fv[i + 1];                                                                  \
        *(LAS f32x2*)(lds + OFF_SEG + w * 512 + lane * 8) = ls; } while (0)
    __syncthreads();
    SCAN_S2();
    for (int c0 = 0; c0 < SEQ; c0 += 64) {
        __syncthreads();
        if (c0 + 64 < SEQ) SCAN_LOAD(c0 + 64);
        { const size_t g = gbase + (size_t)(c0 + to) * 1024 + d0; pg[0] = *(const u32x4*)(hg + g); pg[1] = *(const u32x4*)(hg + g + 8); }
        {
            f32x2 tt[8];
#pragma unroll
            for (int s = 0; s < 8; ++s) tt[s] = *(const LAS f32x2*)(lds + OFF_SEG + s * 512 + lane * 8);
            f32x2 base = (f32x2){0.f, 0.f}, after = (f32x2){0.f, 0.f}, all = (f32x2){0.f, 0.f};
#pragma unroll
            for (int s = 0; s < 8; ++s) { if (s < w) base += tt[s]; if (s > w) after += tt[s]; all += tt[s]; }
            const int J = w >> 1, odd = w & 1;
            f32x2 prevt = (f32x2){0.f, 0.f};
#pragma unroll
            for (int s = 0; s < 8; ++s) if (odd && s == w - 1) prevt = tt[s];
            const f32x2 eb = (f32x2){__expf(base.x), __expf(base.y)};
            const f32x2 ep = (f32x2){__expf(prevt.x), __expf(prevt.y)};
            const f32x2 epi = (f32x2){__expf(-prevt.x), __expf(-prevt.y)};
            const f32x2 el = (f32x2){__expf(after.x), __expf(after.y)};
            f32x2 eI[3];
#pragma unroll
            for (int I = 1; I < 4; ++I) { f32x2 a = (f32x2){0.f, 0.f};
#pragma unroll
                for (int s = 0; s < 8; ++s) if (s > w && s < 2 * I) a += tt[s];
                eI[I - 1] = (f32x2){__expf(a.x), __expf(a.y)}; }
            if (w == 0) *(LAS f32x2*)(lds + OFF_AL + lane * 8) = (f32x2){__expf(all.x), __expf(all.y)};
            unsigned kow[2][4];
            const int sl0 = 8 * odd;
            unsigned qws[8];
#pragma unroll
            for (int i = 0; i < 8; ++i) qws[i] = *(const LAS unsigned*)(lds + OFF_QI + (8 * w + i) * RS + lane * 4);
#pragma unroll
            for (int i = 0; i < 8; ++i) {
                const int t = 8 * w + i;
                const unsigned qw = qws[i];
                const f32x2 q = (f32x2){bflo(qw), bfhi(qw)};
                const f32x2 k = (f32x2){1.f, 1.f} - fv[i];
                const f32x2 qin = q * eb * R[i], qt = q * ep * R[i];
                *(LAS unsigned*)(lds + OFF_QI + t * RS + lane * 4) = pkbf(qin.x, qin.y);
                *(LAS unsigned*)(lds + OFF_QT + t * RS + lane * 4) = pkbf(qt.x, qt.y);
                const f32x2 ks = k * Sx[i];
                const f32x2 ko = ks * el;
                if (i & 1) { kow[0][i >> 1] |= pkbf(0.f, ko.x) & 0xffff0000u; kow[1][i >> 1] |= pkbf(0.f, ko.y) & 0xffff0000u; }
                else { kow[0][i >> 1] = pkbf(ko.x, 0.f) & 0xffffu; kow[1][i >> 1] = pkbf(ko.y, 0.f) & 0xffffu; }
                const f32x2 ri = (f32x2){__builtin_amdgcn_rcpf(R[i].x), __builtin_amdgcn_rcpf(R[i].y)};
                const f32x2 kd = k * epi * ri;
                *(LAS unsigned*)(lds + OFF_KT + ((J * (J + 1) / 2 + J) * 16 + sl0 + i) * RS + lane * 4) = pkbf(kd.x, kd.y);
#pragma unroll
                for (int I = 1; I < 4; ++I) if (I > J) { const f32x2 kk = ks * eI[I - 1];
                    *(LAS unsigned*)(lds + OFF_KT + ((I * (I + 1) / 2 + J) * 16 + sl0 + i) * RS + lane * 4) = pkbf(kk.x, kk.y); }
            }
            *(LAS u32x4*)(lds + OFF_KO + (2 * lane) * RK + 16 * w) = (u32x4){kow[0][0], kow[0][1], kow[0][2], kow[0][3]};
            *(LAS u32x4*)(lds + OFF_KO + (2 * lane + 1) * RK + 16 * w) = (u32x4){kow[1][0], kow[1][1], kow[1][2], kow[1][3]};
        }
        __syncthreads();
#pragma unroll
        for (int rep = 0; rep < 2; ++rep) {
            const int idx = w + 8 * rep;
            if (idx < 10) {
                const int I = idx >= 6 ? 3 : (idx >= 3 ? 2 : (idx >= 1 ? 1 : 0)), Jb = idx - I * (I + 1) / 2;
                f32x4 d = (f32x4){0.f, 0.f, 0.f, 0.f};
                bf16x8 ka[4], qb[4];
#pragma unroll
                for (int j = 0; j < 4; ++j) { ka[j] = *(const LAS bf16x8*)(lds + OFF_KT + (idx * 16 + col) * RS + (32 * j + 8 * rq) * 2);
                                              qb[j] = *(const LAS bf16x8*)(lds + OFF_QT + (16 * I + col) * RS + (32 * j + 8 * rq) * 2); }
                __builtin_amdgcn_sched_barrier(0);
#pragma unroll
                for (int j = 0; j < 4; ++j) d = __builtin_amdgcn_mfma_f32_16x16x32_bf16(ka[j], qb[j], d, 0, 0, 0);
                if (I == Jb) {
#pragma unroll
                    for (int i = 0; i < 4; ++i) if (4 * rq + i > col) d[i] = 0.f; }
                *(LAS u32x2*)(lds + OFF_AT + (16 * I + col) * RK + (16 * Jb + 4 * rq) * 2) = (u32x2){pkbf(d[0], d[1]), pkbf(d[2], d[3])};
            }
        }
        bf16x8 vf[2];
        {
            const unsigned va = (unsigned)(size_t)(lds + OFF_VV) + (unsigned)((8 * rq + ((lane & 15) >> 2)) * RS + w * 32 + (lane & 3) * 8);
            s16x4 l0, h0, l1, h1; trrd4(l0, h0, l1, h1, va);
            vf[0] = (bf16x8){l0[0], l0[1], l0[2], l0[3], h0[0], h0[1], h0[2], h0[3]}; vf[1] = (bf16x8){l1[0], l1[1], l1[2], l1[3], h1[0], h1[1], h1[2], h1[3]};
        }
        f32x4 oacc[4];
        {
            bf16x8 sb[4];
#pragma unroll
            for (int j = 0; j < 4; ++j) { const u32x4 wv = (u32x4){pkbf(S[2 * j][0], S[2 * j][1]), pkbf(S[2 * j][2], S[2 * j][3]), pkbf(S[2 * j + 1][0], S[2 * j + 1][1]), pkbf(S[2 * j + 1][2], S[2 * j + 1][3])};
                sb[j] = __builtin_bit_cast(bf16x8, wv); }
            u32x4 av[4][4];
#pragma unroll
            for (int mb = 0; mb < 4; ++mb)
#pragma unroll
                for (int j = 0; j < 4; ++j) {
                    const u32x2 lo = *(const LAS u32x2*)(lds + OFF_QI + (16 * mb + col) * RS + (32 * j + 4 * rq) * 2), hi = *(const LAS u32x2*)(lds + OFF_QI + (16 * mb + col) * RS + (32 * j + 16 + 4 * rq) * 2);
                    av[mb][j] = (u32x4){lo.x, lo.y, hi.x, hi.y}; }
            __builtin_amdgcn_sched_barrier(0);
#pragma unroll
            for (int mb = 0; mb < 4; ++mb) oacc[mb] = (f32x4){0.f, 0.f, 0.f, 0.f};
#pragma unroll
            for (int j = 0; j < 4; ++j)
#pragma unroll
                for (int mb = 0; mb < 4; ++mb) oacc[mb] = __builtin_amdgcn_mfma_f32_16x16x32_bf16(__builtin_bit_cast(bf16x8, av[mb][j]), sb[j], oacc[mb], 0, 0, 0);
            __builtin_amdgcn_sched_barrier(0);
        }
#pragma unroll
        for (int bh = 0; bh < 2; ++bh) {
            f32x4 al[4]; bf16x8 ka[4][2];
#pragma unroll
            for (int b4 = 0; b4 < 4; ++b4) { const int blk = 4 * bh + b4; al[b4] = *(const LAS f32x4*)(lds + OFF_AL + (16 * blk + 4 * rq) * 4);
#pragma unroll
                for (int ks = 0; ks < 2; ++ks) ka[b4][ks] = *(const LAS bf16x8*)(lds + OFF_KO + (16 * blk + col) * RK + (32 * ks + 8 * rq) * 2); }
            __builtin_amdgcn_sched_barrier(0);
#pragma unroll
            for (int b4 = 0; b4 < 4; ++b4) S[4 * bh + b4] = S[4 * bh + b4] * al[b4];
#pragma unroll
            for (int ks = 0; ks < 2; ++ks)
#pragma unroll
                for (int b4 = 0; b4 < 4; ++b4) S[4 * bh + b4] = __builtin_amdgcn_mfma_f32_16x16x32_bf16(ka[b4][ks], vf[ks], S[4 * bh + b4], 0, 0, 0);
            __builtin_amdgcn_sched_barrier(0);
        }
        __syncthreads();
        if (c0 + 64 < SEQ) SCAN_STORE();
        {
            bf16x8 aa[4][2];
#pragma unroll
            for (int mb = 0; mb < 4; ++mb)
#pragma unroll
                for (int ks = 0; ks < 2; ++ks) if (ks == 0 || mb >= 2) aa[mb][ks] = *(const LAS bf16x8*)(lds + OFF_AT + (16 * mb + col) * RK + (32 * ks + 8 * rq) * 2);
            __builtin_amdgcn_sched_barrier(0);
#pragma unroll
            for (int ks = 0; ks < 2; ++ks)
#pragma unroll
                for (int mb = 0; mb < 4; ++mb) if (ks == 0 || mb >= 2) oacc[mb] = __builtin_amdgcn_mfma_f32_16x16x32_bf16(aa[mb][ks], vf[ks], oacc[mb], 0, 0, 0);
#pragma unroll
            for (int mb = 0; mb < 4; ++mb)
#pragma unroll
                for (int i = 0; i < 4; ++i) *(LAS float*)(lds + OFF_OUT + (16 * mb + 4 * rq + i) * RO + (16 * w + col) * 4) = oacc[mb][i];
        }
        __syncthreads();
        {
            f32x4 ov[4]; float sq = 0.f;
#pragma unroll
            for (int e = 0; e < 4; ++e) { ov[e] = *(const LAS f32x4*)(lds + OFF_OUT + to * RO + (d0 + 4 * e) * 4); sq += (ov[e][0] * ov[e][0] + ov[e][1] * ov[e][1]) + (ov[e][2] * ov[e][2] + ov[e][3] * ov[e][3]); }
            sq += __shfl_xor(sq, 1); sq += __shfl_xor(sq, 2); sq += __shfl_xor(sq, 4);
            const float rn = rsqrtf(sq * (1.0f / 128.0f) + 1e-6f);
            unsigned ow[8];
#pragma unroll
            for (int e = 0; e < 8; ++e) { const unsigned gw = e < 4 ? pg[0][e] : pg[1][e - 4];
                ow[e] = pkbf(ov[e >> 1][(2 * e) & 3] * rn * gn[2 * e] * bflo(gw), ov[e >> 1][(2 * e + 1) & 3] * rn * gn[2 * e + 1] * bfhi(gw)); }
            const size_t g = gbase + (size_t)(c0 + to) * 1024 + d0;
            *(u32x4*)(ho + g) = (u32x4){ow[0], ow[1], ow[2], ow[3]}; *(u32x4*)(ho + g + 8) = (u32x4){ow[4], ow[5], ow[6], ow[7]};
        }
        if (c0 + 64 < SEQ) SCAN_S2();
    }
    __syncthreads();
#undef SCAN_S2
#undef SCAN_LOAD
#undef SCAN_STORE
}
}
static_assert(att::LDS_BYTES <= RING_BYTES && pg8::STAGE_BYTES <= RING_BYTES && hgs::LDS_END <= RING_BYTES && EXTRA_OFF + 4096 <= LDS_BYTES, "LDS map");
__global__ void __launch_bounds__(NWAVES * 64, 2) mk_fwd(Args args) {
    extern __shared__ __attribute__((aligned(16))) unsigned char lds_raw[];
    LAS unsigned char* lds = (LAS unsigned char*)lds_raw;
    volatile LAS unsigned* MISC = (volatile LAS unsigned*)(lds + MISC_OFF);
    const int wave = __builtin_amdgcn_readfirstlane(threadIdx.x >> 6);
    const int tid = wave * 64 + mk_lane();
    const int G = gridDim.x; const int bx = blockIdx.x; const int vcu = (G % 8 == 0) ? (bx % 8) * (G / 8) + bx / 8 : bx;
    gu32* ctl = (gu32*)(args.ws + WS_CTL);
    for (int u = tid; u < (LDS_BYTES - LDSCTL_OFF) / 4; u += NWAVES * 64) ((LAS unsigned*)(lds + LDSCTL_OFF))[u] = 0u;
    __syncthreads();
#if MK_PER_PHASE
#define GRID_BAR() do { } while (0)
#else
    XcdBarrier bar = xcd_barrier_post((unsigned*)(ctl + CW_BAR), MISC + 8, wave == 0 && mk_lane() == 0);
#define GRID_BAR() xcd_barrier(bar, wave == 0 && mk_lane() == 0)
#endif
    const int lo = args.ph_lo, hi = args.ph_hi;
#ifndef REP_PHASE
#define REP_PHASE -1
#define REP_COUNT 2
#endif
#define REPEAT(k) _Pragma("unroll") for (int r_ = 0; r_ < (((k) == REP_PHASE) ? REP_COUNT : 1); ++r_)
#ifndef STAG_TICKS
#define STAG_TICKS 0
#endif
#ifndef MLPOUT_REV
#define MLPOUT_REV 1
#endif
#ifndef GEMM_SP2
#define GEMM_SP2 true
#endif
#ifndef SCAN_SIMPLE
#define SCAN_SIMPLE 0
#endif
#ifndef EXP_SKIP_CONV
#define EXP_SKIP_CONV 0
#endif
#ifndef NO_UQ
#define NO_UQ 0
#endif
#ifndef NO_UKV
#define NO_UKV 0
#endif
#ifndef ONLY_LO
#define ONLY_LO 0
#define ONLY_HI 99
#endif
#define IN(k) ((ONLY_LO) <= (k) && (k) <= (ONLY_HI) && lo <= (k) && (k) < hi)
#define SEAM(k) do { if (IN(k) && IN((k) + 1)) GRID_BAR(); } while (0)
#define WSDEF unsigned long long z_ = 0; asm volatile("" : "+s"(z_)); unsigned char* ws_ = args.ws + z_
#define P_OUT (args.out)
#define P_PV ((const float*)(ws_ + WS_PV))
#define P_POS ((const int*)(P_PV + PV_POS))
#define P_SSB ((pg8::ssq_t*)(ws_ + CTL_SS))
#define P_SSCQ ((pg8::ssq_t*)(ws_ + CTL_SSCQ))
#define P_SSCKV ((pg8::ssq_t*)(ws_ + CTL_SSCKV))
#define P_WB ((pg8::bf16_t*)(ws_ + WS_W))
#define P_XB ((pg8::bf16_t*)(ws_ + WS_XB))
#define P_HH ((pg8::bf16_t*)(ws_ + WS_HH))
#define P_Q ((pg8::bf16_t*)(ws_ + WS_Q))
#define P_K ((pg8::bf16_t*)(ws_ + WS_K))
#define P_V ((pg8::bf16_t*)(ws_ + WS_V))
#define P_O ((pg8::bf16_t*)(ws_ + WS_O))
#define P_CQ ((pg8::bf16_t*)(ws_ + WS_CQ))
#define P_CKV ((pg8::bf16_t*)(ws_ + WS_CKV))
#define P_KR ((pg8::bf16_t*)(ws_ + WS_KR))
#define P_HQ ((pg8::bf16_t*)(ws_ + WS_HQ))
#define P_HV ((pg8::bf16_t*)(ws_ + WS_HV))
#define P_HG ((pg8::bf16_t*)(ws_ + WS_HG))
#define P_HLF ((float*)(ws_ + WS_HLF))
#define P_CU ((pg8::bf16_t*)(ws_ + WS_CU))
#define P_CY ((pg8::bf16_t*)(ws_ + WS_CY))
#define P_LB ((const float*)(ws_ + WS_LB))

#define RUN_GEMM(EpiT, Aptr, Btptr, Nn, Kk, ...) do { pg8::Gemm g_{(Aptr), (Btptr), T, (Nn), (Kk)}; pg8::StaticOrder S_; S_.init(T, (Nn), G, (int)blockIdx.x); \
        EpiT E_{__VA_ARGS__}; pg8::gemm_phase<EpiT, pg8::StaticOrder, true, GEMM_SP2, false, true>(lds + RING_OFF, g_, S_, E_, wave); } while (0)
#define RUN_GEMM_STAG(EpiT, Aptr, Btptr, Nn, Kk, ...) do { pg8::Gemm g_{(Aptr), (Btptr), T, (Nn), (Kk)}; pg8::StaticOrder S_; S_.init(T, (Nn), G, (int)blockIdx.x); \
        EpiT E_{__VA_ARGS__}; pg8::gemm_phase<EpiT, pg8::StaticOrder, true, GEMM_SP2, false, true>(lds + RING_OFF, g_, S_, E_, wave, (int)((blockIdx.x >> 3) & 3) * STAG_TICKS); } while (0)
#define RUN_GEMM_TILED_P(EpiT, Aptr, Btptr, Nn, Kk, ...) do { pg8::Gemm g_{(Aptr), (Btptr), T, (Nn), (Kk)}; pg8::StaticOrder S_; S_.init(T, (Nn), G, (int)blockIdx.x, 2); \
        EpiT E_{__VA_ARGS__}; pg8::gemm_phase<EpiT, pg8::StaticOrder, true, GEMM_SP2, true>(lds + RING_OFF, g_, S_, E_, wave); } while (0)
#define RUN_GEMM_TILED(EpiT, Aptr, Btptr, Nn, Kk, ...) do { pg8::Gemm g_{(Aptr), (Btptr), T, (Nn), (Kk)}; pg8::StaticOrder S_; S_.init(T, (Nn), G, (int)blockIdx.x, MLPOUT_REV); \
        EpiT E_{__VA_ARGS__}; pg8::gemm_phase<EpiT, pg8::StaticOrder, true, GEMM_SP2, true>(lds + RING_OFF, g_, S_, E_, wave); } while (0)

#define MLP_LAYER(l, P) do { \
    if (IN(P) && (P) == REP_PHASE) { WSDEF; RUN_GEMM(EPI_ROW_NOSTORE, P_XB, P_WB + W_MI + (size_t)(l) * FF * D, FF, D, P_HH, FF, P_SSB + (size_t)(2 * (l) + 1) * T, 1.0f / 1024.0f); } \
    if (IN(P)) { WSDEF; RUN_GEMM_STAG(EPI_ROW_TILED, P_XB, P_WB + W_MI + (size_t)(l) * FF * D, FF, D, P_HH, FF, P_SSB + (size_t)(2 * (l) + 1) * T, 1.0f / 1024.0f); } SEAM(P); \
    if (IN((P) + 1) && (P) + 1 == REP_PHASE) { WSDEF; RUN_GEMM_TILED_P(pg8::EpiResid<false>, P_HH, P_WB + W_MO + (size_t)(l) * FF * D, D, FF, P_OUT, P_XB, (const float*)nullptr, (pg8::ssq_t*)(ws_ + CTL_DUMMY), (pg8::bf16_t*)P_OUT); } \
    if (IN((P) + 1)) { WSDEF; if ((l) < 3) { RUN_GEMM_TILED(pg8::EpiResid<false>, P_HH, P_WB + W_MO + (size_t)(l) * FF * D, D, FF, P_OUT, P_XB, (const float*)nullptr, P_SSB + (size_t)(2 * (l) + 2) * T, P_XB); } \
                       else { RUN_GEMM_TILED(pg8::EpiResid<true>, P_HH, P_WB + W_MO + (size_t)(l) * FF * D, D, FF, P_OUT, P_XB, (const float*)nullptr, (pg8::ssq_t*)nullptr, P_XB); } } SEAM((P) + 1); } while (0)

#define MLA_LAYER(j, l, P) do { \
    if (IN(P)) { WSDEF; RUN_GEMM(pg8::EpiDown, P_XB, P_WB + W_DN + (size_t)(j) * 768 * D, 768, D, P_SSB + (size_t)(2 * (l)) * T, P_CQ, P_CKV, P_KR, P_SSCQ + (size_t)(j) * T, P_SSCKV + (size_t)(j) * T); } \
    if (IN(P) && (j) == 0 && bx >= 128) { OPQ; p0_weights<3>(args, lds, (bx - 128) * NWAVES + w_, 128 * NWAVES, l_, w_); }     \
    SEAM(P); \
    if (IN((P) + 1)) { { WSDEF; OPQ; kr_finalize(P_POS, P_PV + PV_GK + (j) * 192, P_KR, (float*)(ws_ + WS_CS), vcu, G, l_, w_); } \
                       { WSDEF; RUN_GEMM(pg8::EpiUQ, P_CQ, P_WB + W_UQ + (size_t)(j) * 1536 * 384, 1536, 384, P_SSCQ + (size_t)(j) * T, P_Q); } \
                       { WSDEF; RUN_GEMM(pg8::EpiUKV, P_CKV, P_WB + W_UKV + (size_t)(j) * 2048 * 256, 2048, 256, P_SSCKV + (size_t)(j) * T, P_K, P_V, P_PV + PV_GK + (j) * 192, (PG8_LAS float*)(lds + EXTRA_OFF)); } } SEAM((P) + 1); \
    if (IN((P) + 3)) REPEAT((P) + 3) { WSDEF; att::attn_phase((char*)lds_raw + RING_OFF, P_Q, P_K, P_KR, P_V, P_O, P_PV + PV_GQ + (j) * 192, (const float*)(ws_ + WS_CS), G, (int)blockIdx.x, wave); } SEAM((P) + 3); \
    if (IN((P) + 4) && (P) + 4 == REP_PHASE) { WSDEF; RUN_GEMM(pg8::EpiResid<false>, P_O, P_WB + W_AO + (size_t)(j) * D * D, D, D, P_OUT, P_XB, (const float*)nullptr, (pg8::ssq_t*)(ws_ + CTL_DUMMY), (pg8::bf16_t*)P_OUT); } \
    if (IN((P) + 4)) { WSDEF; RUN_GEMM(pg8::EpiResid<false>, P_O, P_WB + W_AO + (size_t)(j) * D * D, D, D, P_OUT, P_XB, (const float*)nullptr, P_SSB + (size_t)(2 * (l) + 1) * T, P_XB); } SEAM((P) + 4); } while (0)

#define EPI_RESID_BIAS pg8::EpiResid<false, true>
#define EPI_ROW_NOSTORE pg8::EpiRow<1, true>
#define EPI_ROW_TILED pg8::EpiRow<1, false, true>
#define OPQ int t_ = wave * 64 + mk_lane(); asm volatile("" : "+v"(t_)); const int l_ = t_ & 63, w_ = __builtin_amdgcn_readfirstlane(t_ >> 6)
    if (IN(0)) REPEAT(0) { OPQ; p0_prologue(args, lds, vcu, G, t_, l_, w_); } SEAM(0);
#if REP_PHASE == 99
    {
        typedef float f32x16 __attribute__((ext_vector_type(16))); typedef short bf16x8v __attribute__((ext_vector_type(8)));
        f32x16 c0 = {}, c1 = {}, c2 = {}, c3 = {}; bf16x8v a = {1, 2, 3, 4, 5, 6, 7, 8}, b = {8, 7, 6, 5, 4, 3, 2, 1};
        asm volatile("" : "+v"(a), "+v"(b));
        for (int it = 0; it < 8192; ++it) {
            c0 = __builtin_amdgcn_mfma_f32_32x32x16_bf16(a, b, c0, 0, 0, 0); c1 = __builtin_amdgcn_mfma_f32_32x32x16_bf16(a, b, c1, 0, 0, 0);
            c2 = __builtin_amdgcn_mfma_f32_32x32x16_bf16(a, b, c2, 0, 0, 0); c3 = __builtin_amdgcn_mfma_f32_32x32x16_bf16(a, b, c3, 0, 0, 0);
        }
        int never = 0; asm volatile("" : "+s"(never));
        if (never) { float s = 0.f; for (int e = 0; e < 16; ++e) s += c0[e] + c1[e] + c2[e] + c3[e]; args.out[tid] = s; }
    }
#endif
    MLA_LAYER(0, 0, 1);
    MLP_LAYER(0, 6);
    if (IN(8)) REPEAT(8) { WSDEF; RUN_GEMM(pg8::EpiHG, P_XB, P_WB + W_HI, FF, D, P_SSB + (size_t)2 * T, P_LB, P_HQ, P_HLF, (size_t)(WS_HV - WS_HQ) / 2); } SEAM(8);
    if (IN(9) && bx >= 128) { OPQ; p0_weights<1>(args, lds, (bx - 128) * NWAVES + w_, 128 * NWAVES, l_, w_); }
    if (IN(9)) { WSDEF; const int nrep9 = (REP_PHASE == 9) ? args.pad : 1; for (int r9 = 0; r9 < nrep9; ++r9) { if (bx < 128) hgs::scan_unit(lds, P_HQ, P_HV, P_HG, P_HLF, P_PV + PV_ON, (r9 + 1 < nrep9) ? (unsigned short*)P_OUT : P_HQ, bx, wave); } } SEAM(9);
    if (IN(10)) { WSDEF; RUN_GEMM(pg8::EpiResid<false>, P_HQ, P_WB + W_HO, D, D, P_OUT, P_XB, (const float*)nullptr, P_SSB + (size_t)3 * T, P_XB); } SEAM(10);
    MLP_LAYER(1, 11);
    if (IN(13)) REPEAT(13) { WSDEF; RUN_GEMM(pg8::EpiGLU, P_XB, P_WB + W_P1, 2048, D, P_SSB + (size_t)4 * T, P_PV + PV_BP1, P_CU); } SEAM(13);
    if (IN(14)) REPEAT(14) { WSDEF; OPQ; conv_phase(lds, P_CU, P_CY, P_PV + PV_WDW, P_PV + PV_BDW, P_PV + PV_LNG, P_PV + PV_LNB, vcu, G, t_, l_, w_); } SEAM(14);
    if (IN(15)) { WSDEF; RUN_GEMM(EPI_RESID_BIAS, P_CY, P_WB + W_P2, D, D, P_OUT, P_XB, P_PV + PV_BP2, P_SSB + (size_t)5 * T, P_XB); } SEAM(15);
    MLP_LAYER(2, 16);
    MLA_LAYER(1, 3, 18);
    MLP_LAYER(3, 23);
#undef IN
#undef SEAM
}

extern "C" void kernel_launch(void* const* d_in, const int* in_sizes, int n_in, void* d_out, int out_size, void* d_ws, size_t ws_size, hipStream_t stream) {
    static int grid = 0;
    if (grid == 0) {
        if (n_in != 26 || in_sizes[0] != T * D || out_size != T * D || ws_size < WS_END) { fprintf(stderr, "kernel_launch: unexpected shapes (n_in %d, in0 %d, out %d, ws %zu)\n", n_in, n_in > 0 ? in_sizes[0] : -1, out_size, ws_size); grid = -1; return; }
        int dev = 0, cus = 0, per_cu = 0;
        if (hipGetDevice(&dev) != hipSuccess || hipDeviceGetAttribute(&cus, hipDeviceAttributeMultiprocessorCount, dev) != hipSuccess) { grid = -1; return; }
        if (hipFuncSetAttribute((const void*)mk_fwd, hipFuncAttributeMaxDynamicSharedMemorySize, LDS_BYTES) != hipSuccess) { fprintf(stderr, "kernel_launch: hipFuncSetAttribute failed\n"); grid = -1; return; }
        if (hipOccupancyMaxActiveBlocksPerMultiprocessor(&per_cu, (const void*)mk_fwd, NWAVES * 64, LDS_BYTES) != hipSuccess || per_cu < 1) { fprintf(stderr, "kernel_launch: occupancy query says %d\n", per_cu); }
        (void)hipGetLastError();
        grid = cus;
    }
    if (grid < 0) return;
    if (hipMemsetAsync((char*)d_ws + WS_CTL, 0, CTL_ZERO_BYTES, stream) != hipSuccess) return;
    Args a{};
    for (int i = 0; i < 26; ++i) a.in[i] = (const float*)d_in[i];
    a.out = (float*)d_out; a.ws = (unsigned char*)d_ws; a.pad = (REP_PHASE == 9) ? 2 : 0;
#if MK_PER_PHASE
    for (int p = 0; p < NPHASE; ++p) { a.ph_lo = p; a.ph_hi = p + 1; a.li = p; hipLaunchKernelGGL(mk_fwd, dim3(grid), dim3(NWAVES * 64), LDS_BYTES, stream, a); }
#else
    a.ph_lo = 0; a.ph_hi = NPHASE; a.li = 0;
    hipLaunchKernelGGL(mk_fwd, dim3(grid), dim3(NWAVES * 64), LDS_BYTES, stream, a);
#endif
}
```

```cpp
#include <hip/hip_runtime.h>
#include <cstdio>
#include <cstdint>
#include <cmath>
__device__ __forceinline__ int mk_lane() { int l; asm volatile("v_mbcnt_lo_u32_b32 %0, -1, 0\n\tv_mbcnt_hi_u32_b32 %0, -1, %0" : "=v"(l)); return l; }
namespace pg8 {
#define PG8_LAS __attribute__((address_space(3)))
typedef unsigned short bf16_t;
typedef short bf16x8 __attribute__((ext_vector_type(8)));
typedef float f32x4 __attribute__((ext_vector_type(4)));
typedef unsigned u32x4 __attribute__((ext_vector_type(4)));
constexpr int BM = 256, BK = 64, HALF = 128, HTB = HALF * BK * 2  , STAGE_BYTES = 8 * HTB, NXCD = 8, WGM = 8;

__host__ __device__ __forceinline__ int lds_byte(int r, int c) { const int st = (r >> 4) * 2 + (c >> 5), rr = r & 15, cc = c & 31, ob = rr * 64 + cc * 2; return st * 1024 + (ob ^ (((ob >> 9) & 1) << 5)); }
__host__ __device__ __forceinline__ void stage_rc(int b, int& R, int& C) { const int st = b / 1024, sb = b % 1024, swz = sb ^ (((sb >> 9) & 1) << 5); R = (st >> 1) * 16 + swz / 64; C = (st & 1) * 32 + (swz % 64) / 2; }
__host__ __device__ __forceinline__ int perm32(int rho) { const int n = rho >> 4, i = rho & 15; return 8 * (i >> 2) + 4 * n + (i & 3); }

struct Unit { int pm, pn; };
struct Gemm { const bf16_t* A; const bf16_t* Bt; int M, N, K; };

struct StaticOrder {
    int nM, nN, nwg, G, c, rev;
    __host__ __device__ void init(int M, int N, int G_, int c_, int rev_ = 0) { nM = M / BM; nN = N / BM; nwg = nM * nN; G = G_; c = c_; rev = rev_; }
    __host__ __device__ bool next(int i, Unit& u) const {
        const long L = (long)i * G + c; if (L >= nwg) return false;
        int wgid = (int)L; { const int q = nwg / NXCD, r = nwg % NXCD, xcd = wgid % NXCD, off = wgid / NXCD; wgid = (xcd < r ? xcd * (q + 1) : r * (q + 1) + (xcd - r) * q) + off; }
        const int nig = WGM * nN, gid = wgid / nig, fm = gid * WGM, gsz = (nM - fm) < WGM ? (nM - fm) : WGM;
        u.pm = fm + ((wgid % nig) % gsz); u.pn = (wgid % nig) / gsz; if (rev == 1) u.pm = nM - 1 - u.pm; if (rev == 2) u.pm = u.pm & 7; return true;
    }
    __device__ __forceinline__ void a_ready(const Unit&) const {}
    __device__ __forceinline__ void done(const Unit&) const {}
};
__device__ __forceinline__ unsigned cvt_pk_bf16(float lo, float hi) { unsigned r; asm volatile("v_cvt_pk_bf16_f32 %0, %1, %2" : "=v"(r) : "v"(lo), "v"(hi)); return r; }
constexpr float RMS_EPS = 1e-6f;
typedef unsigned long long ssq_t;
constexpr float SS_SCALE = 1048576.0f, SS_INV = 1.0f / 1048576.0f;
__device__ __forceinline__ float row_rstd(const ssq_t* ss, int row, float inv_n) { return rsqrtf((float)ss[row] * (inv_n * SS_INV) + RMS_EPS); }
__device__ __forceinline__ void row_rstd8(float (&rs)[2][4], const ssq_t* ss, int row0, float inv_n) {
    ssq_t v[2][4];
#pragma unroll
    for (int ai = 0; ai < 2; ++ai)
#pragma unroll
        for (int m = 0; m < 4; ++m) v[ai][m] = ss[row0 + ai * HALF + m * 16];
#pragma unroll
    for (int ai = 0; ai < 2; ++ai)
#pragma unroll
        for (int m = 0; m < 4; ++m) rs[ai][m] = rsqrtf((float)v[ai][m] * (inv_n * SS_INV) + RMS_EPS);
}
__device__ __forceinline__ void ss_add(ssq_t* p, float v) { (void)__hip_atomic_fetch_add(p, (ssq_t)(v * SS_SCALE + 0.5f), __ATOMIC_RELAXED, __HIP_MEMORY_SCOPE_AGENT); }
__device__ __forceinline__ float sigm(float x) { return __builtin_amdgcn_rcpf(1.0f + __expf(-x)); }
__device__ __forceinline__ u32x4 pack8v(f32x4 a, f32x4 b) { u32x4 w; w.x = cvt_pk_bf16(a[0], a[1]); w.y = cvt_pk_bf16(a[2], a[3]); w.z = cvt_pk_bf16(b[0], b[1]); w.w = cvt_pk_bf16(b[2], b[3]); return w; }
__device__ __forceinline__ float dot4(f32x4 a) { return (a[0] * a[0] + a[1] * a[1]) + (a[2] * a[2] + a[3] * a[3]); }
__device__ __forceinline__ float quad_sum(float s) { s += __shfl_xor(s, 16); s += __shfl_xor(s, 32); return s; }

template <int ACT, bool NOSTORE = false, bool TILEDOUT = false> struct EpiRow {
    static constexpr bool PERM = true, AFTER_DRAIN = false;
    bf16_t* O; int ldc; const ssq_t* ss; float inv_n;
    __device__ __forceinline__ void operator()(const f32x4 (&acc)[2][2][4][2], const Unit& u, int wr, int wc, int fr, int fq) const {
        { const int ln_ = mk_lane(); fr = ln_ & 15; fq = ln_ >> 4; }
        const int row0 = u.pm * BM + wr * 64 + fr, col0 = u.pn * BM + wc * 32 + 8 * fq;
        float rsv[2][4]; row_rstd8(rsv, ss, row0, inv_n);
        int never = 0; asm volatile("" : "+s"(never));
#pragma unroll
        for (int ai = 0; ai < 2; ++ai)
#pragma unroll
            for (int m = 0; m < 4; ++m) {
                const int row = row0 + ai * HALF + m * 16;
                const float rs = rsv[ai][m];
                bf16_t* rowp = TILEDOUT ? O + ((size_t)u.pm * (ldc / 64) + (size_t)(u.pn * 4 + (wc >> 1))) * (BM * 64) + (size_t)(row & 255) * 64 + (wc & 1) * 32 + 8 * fq - (TILEDOUT ? 0 : 0)
                                        : O + (size_t)row * ldc + col0;
#pragma unroll
                for (int bj = 0; bj < 2; ++bj) {
                    f32x4 v0 = acc[ai][bj][m][0] * rs, v1 = acc[ai][bj][m][1] * rs;
                    if (ACT == 1) {
#pragma unroll
                        for (int e = 0; e < 4; ++e) { const float a = fmaxf(v0[e], 0.f), b = fmaxf(v1[e], 0.f); v0[e] = a * a; v1[e] = b * b; }
                    }
                    if (!NOSTORE || never) *(u32x4*)(rowp + (TILEDOUT ? bj * 2 * (BM * 64) : bj * HALF)) = pack8v(v0, v1);
                }
            }
    }
};

__device__ __forceinline__ void unpack8(u32x4 w, f32x4& a, f32x4& b) {
    a = (f32x4){__builtin_bit_cast(float, w.x << 16), __builtin_bit_cast(float, w.x & 0xffff0000u), __builtin_bit_cast(float, w.y << 16), __builtin_bit_cast(float, w.y & 0xffff0000u)};
    b = (f32x4){__builtin_bit_cast(float, w.z << 16), __builtin_bit_cast(float, w.z & 0xffff0000u), __builtin_bit_cast(float, w.w << 16), __builtin_bit_cast(float, w.w & 0xffff0000u)};
}
template <bool LAST, bool HAS_BIAS = false> struct EpiResid {
    static constexpr bool PERM = true, AFTER_DRAIN = false;
    float* xout; bf16_t* xb; const float* bias; ssq_t* ssn; bf16_t* xbw;
    __device__ __forceinline__ void operator()(const f32x4 (&acc)[2][2][4][2], const Unit& u, int wr, int wc, int fr, int fq) const {
        { const int ln_ = mk_lane(); fr = ln_ & 15; fq = ln_ >> 4; }
        const int row0 = u.pm * BM + wr * 64 + fr, col0 = u.pn * BM + wc * 32 + 8 * fq;
        f32x4 (&accw)[2][2][4][2] = const_cast<f32x4 (&)[2][2][4][2]>(acc);
        if (HAS_BIAS) {
#pragma unroll
            for (int bj = 0; bj < 2; ++bj)
#pragma unroll
                for (int n = 0; n < 2; ++n) { const f32x4 bvv = *(const f32x4*)(bias + col0 + bj * HALF + 4 * n);
#pragma unroll
                    for (int ai = 0; ai < 2; ++ai)
#pragma unroll
                        for (int m = 0; m < 4; ++m) accw[ai][bj][m][n] += bvv; }
        }
        constexpr int NB_ = HAS_BIAS ? 2 : 1, AI_ = HAS_BIAS ? 1 : 2;
#pragma unroll
        for (int hb = 0; hb < NB_; ++hb) {
            u32x4 xr[AI_][4][2];
#pragma unroll
            for (int a2 = 0; a2 < AI_; ++a2)
#pragma unroll
                for (int m = 0; m < 4; ++m)
#pragma unroll
                    for (int bj = 0; bj < 2; ++bj) xr[a2][m][bj] = *(const u32x4*)(xb + (size_t)(row0 + (hb * AI_ + a2) * HALF + m * 16) * 1024 + col0 + bj * HALF);
#pragma unroll
            for (int a2 = 0; a2 < AI_; ++a2)
#pragma unroll
                for (int m = 0; m < 4; ++m) {
                    const int ai = hb * AI_ + a2;
                    const int row = row0 + ai * HALF + m * 16;
                    const size_t off = (size_t)row * 1024 + col0;
                    float sq = 0.f;
#pragma unroll
                    for (int bj = 0; bj < 2; ++bj) {
                        f32x4 x0, x1; unpack8(xr[a2][m][bj], x0, x1);
                        const f32x4 v0 = accw[ai][bj][m][0] + x0, v1 = accw[ai][bj][m][1] + x1;
                        if (LAST) { *(f32x4*)(xout + off + bj * HALF) = v0; *(f32x4*)(xout + off + bj * HALF + 4) = v1; }
                        else { const u32x4 w = pack8v(v0, v1); *(u32x4*)(xbw + off + bj * HALF) = w; f32x4 r0, r1; unpack8(w, r0, r1); sq += dot4(r0) + dot4(r1); }
                    }
                    if (!LAST) { sq = quad_sum(sq); if (fq == 0) ss_add(ssn + row, sq); }
                }
        }
    }
};

struct EpiDown {
    static constexpr bool PERM = true, AFTER_DRAIN = false;
    const ssq_t* ss; bf16_t* cq; bf16_t* ckv; bf16_t* kr; ssq_t* sscq; ssq_t* ssckv;
    __device__ __forceinline__ void operator()(const f32x4 (&acc)[2][2][4][2], const Unit& u, int wr, int wc, int fr, int fq) const {
        { const int ln_ = mk_lane(); fr = ln_ & 15; fq = ln_ >> 4; }
        const int row0 = u.pm * BM + wr * 64 + fr, cw = wc * 32 + 8 * fq;
        float rsv[2][4]; row_rstd8(rsv, ss, row0, 1.0f / 1024.0f);
#pragma unroll
        for (int ai = 0; ai < 2; ++ai)
#pragma unroll
            for (int m = 0; m < 4; ++m) {
                const int row = row0 + ai * HALF + m * 16;
                const float rs = rsv[ai][m];
                float sq_q = 0.f, sq_kv = 0.f;
#pragma unroll
                for (int bj = 0; bj < 2; ++bj) {
                    const int seg = u.pn * 2 + bj;
                    const f32x4 v0 = acc[ai][bj][m][0] * rs, v1 = acc[ai][bj][m][1] * rs;
                    const u32x4 w = pack8v(v0, v1);
                    if (seg < 3) { *(u32x4*)(cq + (size_t)row * 384 + seg * 128 + cw) = w; sq_q += dot4(v0) + dot4(v1); }
                    else if (seg < 5) { *(u32x4*)(ckv + (size_t)row * 256 + (seg - 3) * 128 + cw) = w; sq_kv += dot4(v0) + dot4(v1); }
                    else if (wc < 2) { *(u32x4*)(kr + (size_t)row * 64 + cw) = w; }
                }
                sq_q = quad_sum(sq_q); sq_kv = quad_sum(sq_kv);
                if (fq == 0) { if (u.pn <= 1) ss_add(sscq + row, sq_q); if (u.pn >= 1) ss_add(ssckv + row, sq_kv); }
            }
    }
};

struct EpiUQ {
    static constexpr bool PERM = true, AFTER_DRAIN = false;
    const ssq_t* ss; bf16_t* Q;
    __device__ __forceinline__ void operator()(const f32x4 (&acc)[2][2][4][2], const Unit& u, int wr, int wc, int fr, int fq) const {
        { const int ln_ = mk_lane(); fr = ln_ & 15; fq = ln_ >> 4; }
        const int row0 = u.pm * BM + wr * 64 + fr, col0 = u.pn * BM + wc * 32 + 8 * fq;
        float rsv[2][4]; row_rstd8(rsv, ss, row0, 1.0f / 384.0f);
        int hoff[2];
#pragma unroll
        for (int bj = 0; bj < 2; ++bj) { const int col = col0 + bj * HALF, h = col / 192; hoff[bj] = h * (2048 * 192) + (col - h * 192); }
        const int bq = row0 >> 11;
        bf16_t* base = Q + (size_t)bq * (8 * 2048 * 192) + (size_t)(row0 & 2047) * 192;
#pragma unroll
        for (int ai = 0; ai < 2; ++ai)
#pragma unroll
            for (int m = 0; m < 4; ++m) {
                const float rs = rsv[ai][m];
#pragma unroll
                for (int bj = 0; bj < 2; ++bj) {
                    const f32x4 v0 = acc[ai][bj][m][0] * rs, v1 = acc[ai][bj][m][1] * rs;
                    *(u32x4*)(base + (ai * HALF + m * 16) * 192 + hoff[bj]) = pack8v(v0, v1);
                }
            }
    }
};

struct EpiUKV {
    static constexpr bool PERM = true, AFTER_DRAIN = false;
    const ssq_t* ss; bf16_t* Kn; bf16_t* V; const float* gk; PG8_LAS float* X;
    __device__ __forceinline__ void operator()(const f32x4 (&acc)[2][2][4][2], const Unit& u, int wr, int wc, int fr, int fq) const {
        { const int ln_ = mk_lane(); fr = ln_ & 15; fq = ln_ >> 4; }
        const int row0 = u.pm * BM + wr * 64 + fr, cw = wc * 32 + 8 * fq, h = u.pn;
        float rsv[2][4]; row_rstd8(rsv, ss, row0, 1.0f / 256.0f);
        const f32x4 g0 = *(const f32x4*)(gk + cw), g1 = *(const f32x4*)(gk + cw + 4);
        const size_t off0 = ((size_t)(((row0 >> 11) * 8 + h) * 2048 + (row0 & 2047))) * 128 + cw;
#pragma unroll
        for (int ai = 0; ai < 2; ++ai)
#pragma unroll
            for (int m = 0; m < 4; ++m) {
                const float rs = rsv[ai][m];
                const f32x4 a0 = acc[ai][0][m][0] * rs, a1 = acc[ai][0][m][1] * rs;
                const float s = quad_sum(dot4(a0) + dot4(a1));
                if (fq == 0) X[(ai * HALF + wr * 64 + m * 16 + fr) * 4 + wc] = s;
                const size_t off = off0 + (size_t)(ai * HALF + m * 16) * 128;
                { const f32x4 v0 = acc[ai][1][m][0] * rs, v1 = acc[ai][1][m][1] * rs; *(u32x4*)(V + off) = pack8v(v0, v1); }
            }
        asm volatile("s_waitcnt lgkmcnt(0)" ::: "memory"); __builtin_amdgcn_s_barrier(); asm volatile("" ::: "memory");
#pragma unroll
        for (int ai = 0; ai < 2; ++ai)
#pragma unroll
            for (int m = 0; m < 4; ++m) {
                const f32x4 p = *(const PG8_LAS f32x4*)(X + (ai * HALF + wr * 64 + m * 16 + fr) * 4);
                const float rk = rsqrtf(((p[0] + p[1]) + (p[2] + p[3])) * (1.0f / 128.0f) + RMS_EPS) * rsv[ai][m];
                const size_t off = off0 + (size_t)(ai * HALF + m * 16) * 128;
                const f32x4 v0 = acc[ai][0][m][0] * rk * g0, v1 = acc[ai][0][m][1] * rk * g1;
                *(u32x4*)(Kn + off) = pack8v(v0, v1);
            }
    }
};

struct EpiHG {
    static constexpr bool PERM = true, AFTER_DRAIN = false;
    const ssq_t* ss; const float* lb; bf16_t* hq; float* hlf; size_t sec_stride;
    __device__ __forceinline__ void operator()(const f32x4 (&acc)[2][2][4][2], const Unit& u, int wr, int wc, int fr, int fq) const {
        { const int ln_ = mk_lane(); fr = ln_ & 15; fq = ln_ >> 4; }
        const int row0 = u.pm * BM + wr * 64 + fr, sec = u.pn >> 2, cc0 = (u.pn & 3) * BM + wc * 32 + 8 * fq;
        float rsv[2][4]; row_rstd8(rsv, ss, row0, 1.0f / 1024.0f);
        if (sec == 1) {
            f32x4 lbv[2][2];
#pragma unroll
            for (int bj = 0; bj < 2; ++bj)
#pragma unroll
                for (int n = 0; n < 2; ++n) lbv[bj][n] = *(const f32x4*)(lb + cc0 + bj * HALF + 4 * n);
#pragma unroll
            for (int ai = 0; ai < 2; ++ai)
#pragma unroll
                for (int m = 0; m < 4; ++m) {
                    const int row = row0 + ai * HALF + m * 16;
                    const float rs = rsv[ai][m];
#pragma unroll
                    for (int bj = 0; bj < 2; ++bj)
#pragma unroll
                        for (int n = 0; n < 2; ++n) {
                            const f32x4 v = acc[ai][bj][m][n] * rs; f32x4 o;
#pragma unroll
                            for (int e = 0; e < 4; ++e) { const float l = lbv[bj][n][e]; o[e] = __logf(l + (1.0f - l) * sigm(v[e])); }
                            *(f32x4*)(hlf + (size_t)row * 1024 + cc0 + bj * HALF + 4 * n) = o;
                        }
                }
        } else {
            bf16_t* dst = hq + (size_t)((sec + 1) >> 1) * sec_stride;
#pragma unroll
            for (int ai = 0; ai < 2; ++ai)
#pragma unroll
                for (int m = 0; m < 4; ++m) {
                    const int row = row0 + ai * HALF + m * 16;
                    const float rs = rsv[ai][m];
#pragma unroll
                    for (int bj = 0; bj < 2; ++bj) {
                        f32x4 v0 = acc[ai][bj][m][0] * rs, v1 = acc[ai][bj][m][1] * rs;
                        if (sec == 3) {
#pragma unroll
                            for (int e = 0; e < 4; ++e) { v0[e] = v0[e] * sigm(v0[e]); v1[e] = v1[e] * sigm(v1[e]); }
                        }
                        *(u32x4*)(dst + (size_t)row * 1024 + cc0 + bj * HALF) = pack8v(v0, v1);
                    }
                }
        }
    }
};

struct EpiGLU {
    static constexpr bool PERM = true, AFTER_DRAIN = false;
    const ssq_t* ss; const float* bias; bf16_t* cu;
    __device__ __forceinline__ void operator()(const f32x4 (&acc)[2][2][4][2], const Unit& u, int wr, int wc, int fr, int fq) const {
        { const int ln_ = mk_lane(); fr = ln_ & 15; fq = ln_ >> 4; }
        const int row0 = u.pm * BM + wr * 64 + fr, j0 = u.pn * HALF + wc * 32 + 8 * fq;
        const f32x4 ba0 = *(const f32x4*)(bias + j0), ba1 = *(const f32x4*)(bias + j0 + 4), bg0 = *(const f32x4*)(bias + 1024 + j0), bg1 = *(const f32x4*)(bias + 1024 + j0 + 4);
        float rsv[2][4]; row_rstd8(rsv, ss, row0, 1.0f / 1024.0f);
#pragma unroll
        for (int ai = 0; ai < 2; ++ai)
#pragma unroll
            for (int m = 0; m < 4; ++m) {
                const int row = row0 + ai * HALF + m * 16;
                const float rs = rsv[ai][m];
                f32x4 a0 = acc[ai][0][m][0] * rs + ba0, a1 = acc[ai][0][m][1] * rs + ba1;
                const f32x4 g0 = acc[ai][1][m][0] * rs + bg0, g1 = acc[ai][1][m][1] * rs + bg1;
#pragma unroll
                for (int e = 0; e < 4; ++e) { a0[e] *= sigm(g0[e]); a1[e] *= sigm(g1[e]); }
                *(u32x4*)(cu + (size_t)row * 1024 + j0) = pack8v(a0, a1);
            }
    }
};
template <class Epi, class Sched, bool ALIGN_EPI = false, bool SP2 = false, bool TILED = false, bool TILEDB = TILED>
__device__ __forceinline__ void gemm_phase(PG8_LAS unsigned char* lds, const Gemm g, const Sched& S, const Epi& E, int wave_s, int stagger_ticks = 0) {
    int tid_ = wave_s * 64 + mk_lane(); asm volatile("" : "+v"(tid_));
    const int tid = tid_, wid = __builtin_amdgcn_readfirstlane(tid >> 6), lane = tid & 63, wr = wid >> 2, wc = wid & 3, fr = lane & 15, fq = lane >> 4;
    const int K = g.K, nt = K / BK;
    unsigned voffA[2], voffB[2];
#pragma unroll
    for (int i = 0; i < 2; ++i) { int R, C; stage_rc(tid * 16 + i * 8192, R, C); const int Rb = Epi::PERM ? ((R & ~31) + perm32(R & 31)) : R;
        voffA[i] = (unsigned)(R * (TILED ? BK : K) + C) * 2u; voffB[i] = (unsigned)(Rb * (TILEDB ? BK : K) + C) * 2u; }
    const size_t kstep = TILED ? (size_t)(BM * BK * 2) : (size_t)(BK * 2), kstepB = TILEDB ? (size_t)(BM * BK * 2) : (size_t)(BK * 2);
    const size_t hstep = TILED ? (size_t)(HALF * BK * 2) : (size_t)HALF * K * 2, hstepB = TILEDB ? (size_t)(HALF * BK * 2) : (size_t)HALF * K * 2;
    const size_t tstep = (size_t)BM * K * 2;
    const unsigned ldsw = (unsigned)wid * 1024u;
    const int aoff = lds_byte(wr * 64 + fr, fq * 8), boff = lds_byte(wc * 32 + fr, fq * 8);
#define PG8_SA(b, h) (((b) * 2 + (h)) * HTB)
#define PG8_SB(b, h) ((4 + (b) * 2 + (h)) * HTB)
#define PG8_STAGE(bufoff, gbase, voff) do { _Pragma("unroll") for (int _i = 0; _i < 2; ++_i) \
        __builtin_amdgcn_global_load_lds((const unsigned*)((const char*)(gbase) + (voff)[_i]), (PG8_LAS unsigned*)(lds + (bufoff) + ldsw + _i * 8192), 16, 0, 0); } while (0)
#define PG8_LDA(dst, b, h) do { _Pragma("unroll") for (int m = 0; m < 4; ++m) _Pragma("unroll") for (int k = 0; k < 2; ++k) dst[m][k] = *(const PG8_LAS bf16x8*)(lds + PG8_SA(b, h) + aoff + m * 2048 + k * 1024); } while (0)
#define PG8_LDB(dst, b, h) do { _Pragma("unroll") for (int n = 0; n < 2; ++n) _Pragma("unroll") for (int k = 0; k < 2; ++k) dst[n][k] = *(const PG8_LAS bf16x8*)(lds + PG8_SB(b, h) + boff + n * 2048 + k * 1024); } while (0)
#define PG8_MMA(ai, bj, At, Bt) do { __builtin_amdgcn_s_setprio(1); _Pragma("unroll") for (int m = 0; m < 4; ++m) _Pragma("unroll") for (int n = 0; n < 2; ++n) _Pragma("unroll") for (int k = 0; k < 2; ++k) \
        acc[ai][bj][m][n] = __builtin_amdgcn_mfma_f32_16x16x32_bf16(Bt[n][k], At[m][k], acc[ai][bj][m][n], 0, 0, 0); __builtin_amdgcn_s_setprio(0); } while (0)
#define PG8_WAIT_V(n) asm volatile("s_waitcnt vmcnt(" #n ")" ::: "memory")
#define PG8_WAIT_L(n) asm volatile("s_waitcnt lgkmcnt(" #n ")" ::: "memory")
#define PG8_BAR __builtin_amdgcn_s_barrier()
#define PG8_SCHED __builtin_amdgcn_sched_barrier(0)
    Unit cur, nxt; int ui = 0;
    if (!S.next(0, cur)) return;
    if (stagger_ticks > 0) { const unsigned long long t0_ = __builtin_amdgcn_s_memrealtime(); while (__builtin_amdgcn_s_memrealtime() - t0_ < (unsigned long long)stagger_ticks) __builtin_amdgcn_s_sleep(8); }
    f32x4 acc[2][2][4][2];
#pragma unroll
    for (int a = 0; a < 2; ++a)
#pragma unroll
        for (int b = 0; b < 2; ++b)
#pragma unroll
            for (int m = 0; m < 4; ++m)
#pragma unroll
                for (int n = 0; n < 2; ++n) acc[a][b][m][n] = (f32x4){0.f, 0.f, 0.f, 0.f};
    bf16x8 At[4][2], B0[2][2], B1[2][2];
    const char* cA = (const char*)g.A + (size_t)cur.pm * tstep; const char* cB = (const char*)g.Bt + (size_t)cur.pn * tstep;
    S.a_ready(cur);
    if constexpr (SP2) {
        PG8_STAGE(PG8_SB(0, 0), cB, voffB); PG8_STAGE(PG8_SB(0, 1), cB + hstepB, voffB); PG8_STAGE(PG8_SA(0, 0), cA, voffA); PG8_STAGE(PG8_SA(0, 1), cA + hstep, voffA);
        if (wr == 1) PG8_BAR;
        PG8_WAIT_V(2); PG8_BAR;
        PG8_STAGE(PG8_SB(1, 0), cB + kstepB, voffB); PG8_STAGE(PG8_SA(1, 0), cA + kstep, voffA); PG8_STAGE(PG8_SB(1, 1), cB + hstepB + kstepB, voffB);
        PG8_WAIT_V(6); PG8_BAR;
    } else {
        PG8_STAGE(PG8_SB(0, 0), cB, voffB); PG8_STAGE(PG8_SA(0, 0), cA, voffA); PG8_STAGE(PG8_SB(0, 1), cB + hstepB, voffB); PG8_STAGE(PG8_SA(0, 1), cA + hstep, voffA);
        if (wr == 1) PG8_BAR;
        PG8_WAIT_V(4); PG8_BAR;
        PG8_STAGE(PG8_SB(1, 0), cB + kstepB, voffB); PG8_STAGE(PG8_SA(1, 0), cA + kstep, voffA); PG8_STAGE(PG8_SB(1, 1), cB + hstepB + kstepB, voffB);
        PG8_WAIT_V(6); PG8_BAR;
    }
    for (;;) {
        const bool has_next = S.next(ui + 1, nxt);
        const char* nA = has_next ? (const char*)g.A + (size_t)nxt.pm * tstep : cA; const char* nB = has_next ? (const char*)g.Bt + (size_t)nxt.pn * tstep : cB;
#pragma unroll 1
        for (int t = 0; t < nt; t += 2) {
            const bool last = (t == nt - 2);
            const char* a1 = cA + (size_t)(t + 1) * kstep;
            const char* a2 = last ? nA : cA + (size_t)(t + 2) * kstep; const char* b2 = last ? nB : cB + (size_t)(t + 2) * kstepB;
            const char* a3 = a2 + kstep; const char* b3 = b2 + kstepB;
            if (last && has_next) S.a_ready(nxt);
            if constexpr (SP2) {
            PG8_LDB(B0, 0, 0); PG8_LDB(B1, 0, 1); PG8_SCHED; PG8_LDA(At, 0, 0); PG8_STAGE(PG8_SA(1, 1), a1 + hstep, voffA);
            PG8_WAIT_V(8); PG8_WAIT_L(0); PG8_BAR; PG8_MMA(0, 0, At, B0); PG8_MMA(0, 1, At, B1); PG8_BAR; PG8_SCHED;
            PG8_LDA(At, 0, 1); PG8_STAGE(PG8_SB(0, 0), b2, voffB); PG8_STAGE(PG8_SB(0, 1), b2 + hstepB, voffB); PG8_STAGE(PG8_SA(0, 0), a2, voffA);
            PG8_WAIT_V(8); PG8_WAIT_L(0); PG8_BAR; PG8_MMA(1, 0, At, B0); PG8_MMA(1, 1, At, B1); PG8_BAR; PG8_SCHED;
            PG8_LDB(B0, 1, 0); PG8_LDB(B1, 1, 1); PG8_SCHED; PG8_LDA(At, 1, 0); PG8_STAGE(PG8_SA(0, 1), a2 + hstep, voffA);
            PG8_WAIT_V(8); PG8_WAIT_L(0); PG8_BAR; PG8_MMA(0, 0, At, B0); PG8_MMA(0, 1, At, B1); PG8_BAR; PG8_SCHED;
            PG8_LDA(At, 1, 1); PG8_STAGE(PG8_SB(1, 0), b3, voffB); PG8_STAGE(PG8_SB(1, 1), b3 + hstepB, voffB); PG8_STAGE(PG8_SA(1, 0), a3, voffA);
            PG8_WAIT_V(8); PG8_WAIT_L(0); PG8_BAR; PG8_MMA(1, 0, At, B0); PG8_MMA(1, 1, At, B1); PG8_BAR; PG8_SCHED;
            } else {
            PG8_LDB(B0, 0, 0); PG8_SCHED; PG8_LDA(At, 0, 0); PG8_STAGE(PG8_SA(1, 1), a1 + hstep, voffA);
            PG8_WAIT_L(8); PG8_BAR; PG8_WAIT_L(0); PG8_MMA(0, 0, At, B0); PG8_BAR; PG8_SCHED;
            PG8_LDB(B1, 0, 1); PG8_STAGE(PG8_SB(0, 0), b2, voffB);
            PG8_BAR; PG8_WAIT_L(0); PG8_MMA(0, 1, At, B1); PG8_BAR;
            PG8_LDA(At, 0, 1); PG8_STAGE(PG8_SA(0, 0), a2, voffA);
            PG8_BAR; PG8_WAIT_L(0); PG8_MMA(1, 0, At, B0); PG8_BAR; PG8_SCHED;
            PG8_STAGE(PG8_SB(0, 1), b2 + hstepB, voffB);
            PG8_WAIT_V(6); PG8_BAR; PG8_MMA(1, 1, At, B1); PG8_BAR;
            PG8_LDB(B0, 1, 0); PG8_SCHED; PG8_LDA(At, 1, 0); PG8_STAGE(PG8_SA(0, 1), a2 + hstep, voffA);
            PG8_WAIT_L(8); PG8_BAR; PG8_WAIT_L(0); PG8_MMA(0, 0, At, B0); PG8_BAR; PG8_SCHED;
            PG8_LDB(B1, 1, 1); PG8_STAGE(PG8_SB(1, 0), b3, voffB);
            PG8_BAR; PG8_WAIT_L(0); PG8_MMA(0, 1, At, B1); PG8_BAR;
            PG8_LDA(At, 1, 1); PG8_STAGE(PG8_SA(1, 0), a3, voffA);
            PG8_BAR; PG8_WAIT_L(0); PG8_MMA(1, 0, At, B0); PG8_BAR; PG8_SCHED;
            PG8_STAGE(PG8_SB(1, 1), b3 + hstepB, voffB);
            PG8_WAIT_V(6); PG8_BAR; PG8_MMA(1, 1, At, B1); PG8_BAR;
            }
        }
        if constexpr (ALIGN_EPI) { if (wr == 0) PG8_BAR; }
        if constexpr (!Epi::AFTER_DRAIN) { E(acc, cur, wr, wc, fr, fq); S.done(cur); }
        if (!has_next) break;
#pragma unroll
        for (int a = 0; a < 2; ++a)
#pragma unroll
            for (int b = 0; b < 2; ++b)
#pragma unroll
                for (int m = 0; m < 4; ++m)
#pragma unroll
                    for (int n = 0; n < 2; ++n) acc[a][b][m][n] = (f32x4){0.f, 0.f, 0.f, 0.f};
        cur = nxt; cA = nA; cB = nB; ++ui;
        if constexpr (ALIGN_EPI) { if (wr == 1) PG8_BAR; }
    }
    PG8_WAIT_V(0);
    if constexpr (!ALIGN_EPI) { if (wr == 0) PG8_BAR; }
    PG8_BAR;
    if constexpr (Epi::AFTER_DRAIN) { E.fused(acc, cur, wr, wc, fr, fq, lds, wid, lane); S.done(cur); }
#undef PG8_SA
#undef PG8_SB
#undef PG8_STAGE
#undef PG8_LDA
#undef PG8_LDB
#undef PG8_MMA
#undef PG8_WAIT_V
#undef PG8_WAIT_L
#undef PG8_BAR
#undef PG8_SCHED
}
}
namespace att {
typedef unsigned short bf16;
typedef short bf16x8 __attribute__((ext_vector_type(8)));
typedef short s16x4 __attribute__((ext_vector_type(4)));
typedef float f32x16 __attribute__((ext_vector_type(16)));
typedef float f32x4 __attribute__((ext_vector_type(4)));
typedef unsigned u32x4 __attribute__((ext_vector_type(4)));
constexpr int NW = 8, QBLK = 32, KVBLK = 64, QB = NW * QBLK;
constexpr int DN = 128, DR = 64, DQ = 192, DV = 128, SEQ = 2048, NH = 8, NB = 16, OSTR = 1024;
constexpr int SHM_V = KVBLK * DV * 2, SHM_K = KVBLK * DN * 2, RPAD = 144, SHM_R = KVBLK * RPAD;
constexpr int OFF_V = 0, OFF_K = 3 * SHM_V, OFF_R = OFF_K + 2 * SHM_K, OFF_WS = OFF_R + 2 * SHM_R, OFF_QS = OFF_WS + NW * 64 * 4, LDS_BYTES = OFF_QS + NW * 4096;
constexpr float SCALE = 0.07216878364870323f;
constexpr float THR = 8.f;
constexpr int WIN = 1 << 30;

#define KSWZ(row, colB) ((row) * 256 + ((colB) ^ (((row) & 7) << 4)))
#define SBAR() __builtin_amdgcn_sched_barrier(0)
__device__ __forceinline__ int v_st(int k, int c) { const int kk = (k & ~0xC) | ((k & 4) << 1) | ((k & 8) >> 1); return ((kk >> 3) * 4 + (c >> 5)) * 512 + ((kk & 7) * 32 + (c & 31)) * 2; }
__device__ __forceinline__ int v_rd_base(int lane) { return ((lane & 3) << 3) | (((lane >> 2) & 3) << 6) | (((lane >> 4) & 1) << 5) | (((lane >> 5) & 1) << 8); }
constexpr int v_rd_off(int d0, int ks, int half) { return d0 * 512 + ks * 4096 + half * 2048; }
__device__ __forceinline__ int crow(int r, int hi) { return (r & 3) + 8 * (r >> 2) + 4 * hi; }
__device__ __forceinline__ unsigned cvtpk(float lo, float hi) { unsigned r; asm volatile("v_cvt_pk_bf16_f32 %0, %1, %2" : "=v"(r) : "v"(lo), "v"(hi)); return r; }
__device__ __forceinline__ bf16x8 load8(const bf16* p) { return *reinterpret_cast<const bf16x8*>(p); }
__device__ __forceinline__ void mask_tile(f32x16& p0, f32x16& p1, int dq, unsigned W) {
    const float NEG = -__builtin_inff();
#pragma unroll
    for (int r = 0; r < 16; ++r) {
        const int c = (r & 3) + 8 * (r >> 2);
        if ((unsigned)(dq - c) >= W) p0[r] = NEG;
        if ((unsigned)(dq - c - 32) >= W) p1[r] = NEG;
    }
}
__device__ __forceinline__ void partialSM(f32x16& p0, f32x16& p1, float& m_reg, float& mn, float& alpha) {
    float pmax = p0[0]; for (int r = 1; r < 16; ++r) pmax = fmaxf(pmax, p0[r]); for (int r = 0; r < 16; ++r) pmax = fmaxf(pmax, p1[r]);
    { auto rr = __builtin_amdgcn_permlane32_swap(__float_as_uint(pmax), __float_as_uint(pmax), false, false);
      pmax = fmaxf(__uint_as_float(rr[0]), __uint_as_float(rr[1])); }
    constexpr float C2 = 1.4426950408889634f * SCALE;
    if (__builtin_expect(__all((pmax - m_reg) * SCALE <= THR), 1)) { mn = m_reg; alpha = 1.f; }
    else { mn = fmaxf(m_reg, pmax); alpha = __builtin_amdgcn_exp2f((m_reg - mn) * C2); m_reg = mn; }
    const float mnL = -mn * C2;
    for (int r = 0; r < 16; ++r) p0[r] = fmaf(p0[r], C2, mnL); for (int r = 0; r < 16; ++r) p1[r] = fmaf(p1[r], C2, mnL);
    for (int r = 0; r < 16; ++r) p0[r] = __builtin_amdgcn_exp2f(p0[r]);
}
__device__ __forceinline__ void finishSM(f32x16& p0, f32x16& p1, float alpha, float& l_reg, bf16x8& pa0, bf16x8& pa1, bf16x8& pa2, bf16x8& pa3) {
    for (int r = 0; r < 16; ++r) p1[r] = __builtin_amdgcn_exp2f(p1[r]);
    float ps = 0; for (int r = 0; r < 16; ++r) ps += p0[r]; for (int r = 0; r < 16; ++r) ps += p1[r];
    { auto rr = __builtin_amdgcn_permlane32_swap(__float_as_uint(ps), __float_as_uint(ps), false, false);
      ps = __uint_as_float(rr[0]) + __uint_as_float(rr[1]); }
    l_reg = l_reg * alpha + ps;
#define PK4(P, B_, OUT) do { unsigned a0 = cvtpk(P[B_+0], P[B_+1]), a1 = cvtpk(P[B_+2], P[B_+3]);                          \
        unsigned b0 = cvtpk(P[B_+4], P[B_+5]), b1 = cvtpk(P[B_+6], P[B_+7]);                                             \
        auto r0 = __builtin_amdgcn_permlane32_swap(a0, b0, false, false); auto r1 = __builtin_amdgcn_permlane32_swap(a1, b1, false, false); \
        u32x4 w = {r0[0], r1[0], r0[1], r1[1]}; OUT = *reinterpret_cast<bf16x8*>(&w); } while (0)
    PK4(p0, 0, pa0); PK4(p0, 8, pa1); PK4(p1, 0, pa2); PK4(p1, 8, pa3);
#undef PK4
}
template <int KB>
__device__ __forceinline__ void qkt(f32x16& p0, f32x16& p1, const char* K_lds, const char* R_lds, int r32, int hi, const bf16x8* qr, const char* qsp) {
    p0 = f32x16{}; p1 = f32x16{};
    const char* kb[4];
#pragma unroll
    for (int dd = 0; dd < 4; ++dd) kb[dd] = K_lds + KB * SHM_K + KSWZ(r32, (dd * 16 + hi * 8) * 2);
#pragma unroll
    for (int d0 = 0; d0 < 8; ++d0) { const char* a = kb[d0 & 3] + (d0 >> 2) * 128;
        bf16x8 b0 = *reinterpret_cast<const bf16x8*>(a);
        bf16x8 b1 = *reinterpret_cast<const bf16x8*>(a + 32 * 256);
        p0 = __builtin_amdgcn_mfma_f32_32x32x16_bf16(b0, qr[d0], p0, 0, 0, 0);
        p1 = __builtin_amdgcn_mfma_f32_32x32x16_bf16(b1, qr[d0], p1, 0, 0, 0); }
    const char* rb = R_lds + KB * SHM_R + r32 * RPAD + hi * 16;
#pragma unroll
    for (int d0 = 0; d0 < 4; ++d0) {
        bf16x8 b0 = *reinterpret_cast<const bf16x8*>(rb + d0 * 32);
        bf16x8 b1 = *reinterpret_cast<const bf16x8*>(rb + d0 * 32 + 32 * RPAD);
        const bf16x8 qf = *reinterpret_cast<const bf16x8*>(qsp + d0 * 1024);
        p0 = __builtin_amdgcn_mfma_f32_32x32x16_bf16(b0, qf, p0, 0, 0, 0);
        p1 = __builtin_amdgcn_mfma_f32_32x32x16_bf16(b1, qf, p1, 0, 0, 0); }
}
template <int VB>
__device__ __forceinline__ void pv_tile(f32x16* o, int vb0, bf16x8 pa0, bf16x8 pa1, bf16x8 pa2, bf16x8 pa3) {
#define TRRD(dst, off) asm volatile("ds_read_b64_tr_b16 %0, %1 offset:%2" : "=&v"(dst) : "v"(vb0), "i"(off) : "memory")
#define PV_KS(ks, PA) do { s16x4 l0, l1, l2, l3, h0, h1, h2, h3; constexpr int b_ = VB * SHM_V + v_rd_off(0, ks, 0);   \
        TRRD(l0, b_); TRRD(h0, b_ + 2048); TRRD(l1, b_ + 512); TRRD(h1, b_ + 512 + 2048); TRRD(l2, b_ + 1024); TRRD(h2, b_ + 1024 + 2048); TRRD(l3, b_ + 1536); TRRD(h3, b_ + 1536 + 2048); \
        asm volatile("s_waitcnt lgkmcnt(0)" ::: "memory"); SBAR();   \
        o[0] = __builtin_amdgcn_mfma_f32_32x32x16_bf16(PA, (bf16x8){l0[0], l0[1], l0[2], l0[3], h0[0], h0[1], h0[2], h0[3]}, o[0], 0, 0, 0);   \
        o[1] = __builtin_amdgcn_mfma_f32_32x32x16_bf16(PA, (bf16x8){l1[0], l1[1], l1[2], l1[3], h1[0], h1[1], h1[2], h1[3]}, o[1], 0, 0, 0);   \
        o[2] = __builtin_amdgcn_mfma_f32_32x32x16_bf16(PA, (bf16x8){l2[0], l2[1], l2[2], l2[3], h2[0], h2[1], h2[2], h2[3]}, o[2], 0, 0, 0);   \
        o[3] = __builtin_amdgcn_mfma_f32_32x32x16_bf16(PA, (bf16x8){l3[0], l3[1], l3[2], l3[3], h3[0], h3[1], h3[2], h3[3]}, o[3], 0, 0, 0); } while (0)
    PV_KS(0, pa0); PV_KS(1, pa1); PV_KS(2, pa2); PV_KS(3, pa3);
#undef PV_KS
#undef TRRD
}

struct BlockRef { const bf16* Q; const bf16* K; const bf16* R; const bf16* V; bf16* O; int P0; int row0; };
__device__ __forceinline__ BlockRef make_ref(int L, int pass, const bf16* Q, const bf16* K, const bf16* R, const bf16* V, bf16* O) {
    const int xcd = L & 7, k = L >> 3, bh = (k >> 2) * 8 + xcd, x = k & 3, qb = pass ? 7 - x : x, b = bh >> 3, h = bh & 7;
    BlockRef r;
    r.Q = Q + ((size_t)bh * SEQ + (size_t)qb * QB) * DQ; r.K = K + (size_t)bh * SEQ * DN; r.V = V + (size_t)bh * SEQ * DV; r.R = R + (size_t)b * SEQ * DR;
    r.O = O + ((size_t)b * SEQ + (size_t)qb * QB) * OSTR + h * DV; r.P0 = qb * QB; r.row0 = b * SEQ + qb * QB;
    return r;
}
#define ROW(p, k0, rr) ((p) + (size_t)((k0) + (rr)) * 128 + sc)
#define RROW(p, k0) ((p) + (size_t)((k0) + rsr) * 64 + rsc)
#define VMW() asm volatile("s_waitcnt vmcnt(0)" ::: "memory")
#define SLOAD_H(Kp, Rp, Vp, k0) do { st_v0 = load8(ROW(Vp, k0, sr)); st_v1 = load8(ROW(Vp, k0, 32 + sr));              \
                         st_k0 = load8(ROW(Kp, k0, sr)); st_k1 = load8(ROW(Kp, k0, 32 + sr)); st_r = load8(RROW(Rp, k0)); } while (0)
#define SWRITE_H(bf) do { *(bf16x8*)(V_lds + (bf) * SHM_V + vst0) = st_v0; *(bf16x8*)(V_lds + (bf) * SHM_V + vst1) = st_v1; \
                          *(bf16x8*)(K_lds + (bf) * SHM_K + kws) = st_k0; *(bf16x8*)(K_lds + (bf) * SHM_K + kws + 32 * 256) = st_k1; *(bf16x8*)(R_lds + (bf) * SHM_R + rws) = st_r; } while (0)
__device__ __forceinline__ void q_finalize(bf16x8 (&qr)[8], const BlockRef& cur, char* lds, int wid, const float* gq, const float* cs_tab) {
    {
            const int ln2_ = mk_lane(), r32 = ln2_ & 31, hi = ln2_ >> 5;
            const bf16* qp = cur.Q + (size_t)(wid * QBLK + r32) * DQ + hi * 8;
            char* qsp = lds + OFF_QS + wid * 4096 + ln2_ * 16;
            {
                bf16x8 raw[8];
#pragma unroll
                for (int d0 = 0; d0 < 8; ++d0) raw[d0] = load8(qp + d0 * 16);
                float sn = 0.f;
#pragma unroll
                for (int d0 = 0; d0 < 8; ++d0)
#pragma unroll
                    for (int j = 0; j < 8; ++j) { const float x = __builtin_bit_cast(float, (unsigned)(unsigned short)raw[d0][j] << 16); sn += x * x; }
                { auto rr = __builtin_amdgcn_permlane32_swap(__float_as_uint(sn), __float_as_uint(sn), false, false); sn = __uint_as_float(rr[0]) + __uint_as_float(rr[1]); }
                const float rn = rsqrtf(sn * (1.0f / 128.0f) + 1e-6f);
#pragma unroll
                for (int d0 = 0; d0 < 8; ++d0) { const f32x4 ga = *(const f32x4*)(gq + d0 * 16 + hi * 8), gb = *(const f32x4*)(gq + d0 * 16 + hi * 8 + 4); u32x4 w;
#define QX(j) (__builtin_bit_cast(float, (unsigned)(unsigned short)raw[d0][j] << 16) * rn)
                    w.x = cvtpk(QX(0) * ga[0], QX(1) * ga[1]); w.y = cvtpk(QX(2) * ga[2], QX(3) * ga[3]); w.z = cvtpk(QX(4) * gb[0], QX(5) * gb[1]); w.w = cvtpk(QX(6) * gb[2], QX(7) * gb[3]);
#undef QX
                    qr[d0] = *reinterpret_cast<bf16x8*>(&w); }
                asm volatile("" : "+v"(qr[0]), "+v"(qr[1]), "+v"(qr[2]), "+v"(qr[3]), "+v"(qr[4]), "+v"(qr[5]), "+v"(qr[6]), "+v"(qr[7]));
            }
            bf16x8 raw[12];
#pragma unroll
            for (int d0 = 8; d0 < 12; ++d0) raw[d0] = load8(qp + d0 * 16);
            float sr = 0.f;
#pragma unroll
            for (int d0 = 8; d0 < 12; ++d0)
#pragma unroll
                for (int j = 0; j < 8; ++j) { const float x = __builtin_bit_cast(float, (unsigned)(unsigned short)raw[d0][j] << 16); sr += x * x; }
            { auto rr = __builtin_amdgcn_permlane32_swap(__float_as_uint(sr), __float_as_uint(sr), false, false); sr = __uint_as_float(rr[0]) + __uint_as_float(rr[1]); }
            const float rrs = rsqrtf(sr * (1.0f / 64.0f) + 1e-6f);
            const float* csr = cs_tab + (size_t)(cur.row0 + wid * QBLK + r32) * 64;
#pragma unroll
            for (int dp = 0; dp < 2; ++dp) { u32x4 wlo, whi; unsigned lo[4], hi4[4];
#pragma unroll
                for (int jj = 0; jj < 4; ++jj) {
                    const f32x4 cs4 = *(const f32x4*)(csr + (16 * dp + 8 * hi + 2 * jj) * 2);
                    const int j = 2 * jj;
                    const float g1a = gq[128 + 16 * dp + 8 * hi + j], g1b = gq[128 + 16 * dp + 8 * hi + j + 1], g2a = gq[128 + 32 + 16 * dp + 8 * hi + j], g2b = gq[128 + 32 + 16 * dp + 8 * hi + j + 1];
                    const float t1a = __builtin_bit_cast(float, (unsigned)(unsigned short)raw[8 + dp][j] << 16) * rrs * g1a, t1b = __builtin_bit_cast(float, (unsigned)(unsigned short)raw[8 + dp][j + 1] << 16) * rrs * g1b;
                    const float t2a = __builtin_bit_cast(float, (unsigned)(unsigned short)raw[10 + dp][j] << 16) * rrs * g2a, t2b = __builtin_bit_cast(float, (unsigned)(unsigned short)raw[10 + dp][j + 1] << 16) * rrs * g2b;
                    lo[jj] = cvtpk(t1a * cs4[0] - t2a * cs4[1], t1b * cs4[2] - t2b * cs4[3]);
                    hi4[jj] = cvtpk(t2a * cs4[0] + t1a * cs4[1], t2b * cs4[2] + t1b * cs4[3]);
                }
                wlo = (u32x4){lo[0], lo[1], lo[2], lo[3]}; whi = (u32x4){hi4[0], hi4[1], hi4[2], hi4[3]};
                *reinterpret_cast<u32x4*>(qsp + dp * 1024) = wlo; *reinterpret_cast<u32x4*>(qsp + (dp + 2) * 1024) = whi; }
        }
}
__device__ __forceinline__ void o_epilogue(const f32x16 (&o)[4], float l_reg, bf16* Oblk, char* lds, float* li_l, int wid, int lane, int r32, int hi) {
        if (hi == 0) li_l[r32] = l_reg; asm volatile("s_waitcnt lgkmcnt(0)" ::: "memory");
        float rli[16];
#pragma unroll
        for (int r = 0; r < 16; ++r) rli[r] = __builtin_amdgcn_rcpf(li_l[crow(r, hi)]);
        bf16* Ow = Oblk + (size_t)(wid * QBLK) * OSTR;
        bf16* stg = (bf16*)(lds + OFF_QS + wid * 4096);
#pragma unroll
        for (int hf = 0; hf < 2; ++hf) {
#pragma unroll
            for (int r = 0; r < 16; ++r) { const int orow = crow(r, hi);
#pragma unroll
                for (int d = 0; d < 2; ++d) stg[orow * 64 + d * 32 + r32] = (bf16)(cvtpk(o[2 * hf + d][r] * rli[r], 0.f) & 0xffffu); }
            asm volatile("s_waitcnt lgkmcnt(0)" ::: "memory");
#pragma unroll
            for (int i = 0; i < 4; ++i) { const int row = i * 8 + (lane >> 3), ch = lane & 7; const u32x4 v = *(const u32x4*)(stg + row * 64 + ch * 8); *(u32x4*)(Ow + (size_t)row * OSTR + hf * 64 + ch * 8) = v; }
            asm volatile("s_waitcnt lgkmcnt(0)" ::: "memory");
        }
}
__device__ __forceinline__ void attn_phase(char* lds, const bf16* Q, const bf16* K, const bf16* R, const bf16* V, bf16* O, const float* gq, const float* cs_tab, int G, int c, int wave_s) {
    constexpr int total = 4 * NB * NH;
    int tid_ = wave_s * 64 + mk_lane(); asm volatile("" : "+v"(tid_));
    const int tid = tid_, wid = __builtin_amdgcn_readfirstlane(tid >> 6), lane = tid & 63, r32 = lane & 31, hi = lane >> 5;
    const int grp = wid >> 2;
    int L = c; if (L >= total) return;
    int pass = 0;
    BlockRef cur = make_ref(L, 0, Q, K, R, V, O);
    char* V_lds = lds + OFF_V; char* K_lds = lds + OFF_K; char* R_lds = lds + OFF_R;
    float* ws = (float*)(lds + OFF_WS) + wid * 64; float* li_l = ws, * al_l = ws + 32;
    char* qsp = lds + OFF_QS + wid * 4096 + lane * 16;
    const int sr = tid >> 4, sc = (tid & 15) * 8, vst0 = v_st(sr, sc), vst1 = v_st(32 + sr, sc), kws = KSWZ(sr, sc * 2);
    const int rsr = tid >> 3, rsc = (tid & 7) * 8, rws = rsr * RPAD + rsc * 2;
    const int vb0 = (int)(uintptr_t)V_lds + v_rd_base(lane);
    bf16x8 st_v0 = {}, st_v1 = {}, st_k0 = {}, st_k1 = {}, st_r = {};
#define SWRITE_KV(kb, vr) do { *(bf16x8*)(V_lds + (vr) * SHM_V + vst0) = st_v0; *(bf16x8*)(V_lds + (vr) * SHM_V + vst1) = st_v1; \
                               *(bf16x8*)(K_lds + (kb) * SHM_K + kws) = st_k0; *(bf16x8*)(K_lds + (kb) * SHM_K + kws + 32 * 256) = st_k1; *(bf16x8*)(R_lds + (kb) * SHM_R + rws) = st_r; } while (0)
    SLOAD_H(cur.K, cur.R, cur.V, 0); VMW(); SWRITE_KV(0, 0);
    __syncthreads();
    int vsel = 0;
    bool pend = false, have_old = false;
    bf16* oldO = cur.O;
    bf16x8 pa0 = {}, pa1 = {}, pa2 = {}, pa3 = {}; bf16x8 qr[8] = {};
    float m_reg = -1e30f, l_reg = 0; f32x16 o[4] = {};
#define RESC(a) do { if (__any((a) < 1.f)) { if (hi == 0) al_l[r32] = (a); asm volatile("s_waitcnt lgkmcnt(0)" ::: "memory");              \
                     for (int d_ = 0; d_ < 4; ++d_) for (int r = 0; r < 16; ++r) o[d_][r] *= al_l[crow(r, hi)]; } } while (0)
#define NEWBLOCK() do { q_finalize(qr, cur, lds, wid, gq, cs_tab); m_reg = -1e30f; l_reg = 0; _Pragma("unroll") for (int d_ = 0; d_ < 4; ++d_) o[d_] = f32x16{}; } while (0)
#define STEP(t, KB) do { const int kb_ = (t) * KVBLK; const int vprev = vsel == 0 ? 2 : vsel - 1, vnext = vsel == 2 ? 0 : vsel + 1;       \
        if (grp) {                                                              \
            if (pend) { pv_tile<0>(o, vb0 + vprev * SHM_V, pa0, pa1, pa2, pa3); pend = false; }                                          \
            if ((t) == 0) { if (have_old) o_epilogue(o, l_reg, oldO, lds, li_l, wid, lane, r32, hi); NEWBLOCK(); } }                     \
        if (kb_ <= qlo + QBLK - 1) {                                            \
            f32x16 p0 = {}, p1 = {}; float mn = 0.f, al = 1.f;                                                                                                 \
            SBAR(); qkt<KB>(p0, p1, K_lds, R_lds, r32, hi, qr, qsp);                                                                     \
            if (kb_ + KVBLK - 1 > qlo) mask_tile(p0, p1, qm - kb_, (unsigned)WIN);                                                        \
            partialSM(p0, p1, m_reg, mn, al); RESC(al);                                                                                  \
            finishSM(p0, p1, al, l_reg, pa0, pa1, pa2, pa3); SBAR();                                                                     \
            if (grp) pend = true; else pv_tile<0>(o, vb0 + vsel * SHM_V, pa0, pa1, pa2, pa3); }                                          \
        VMW(); SWRITE_KV((KB) ^ 1, vnext); __syncthreads(); vsel = vnext; } while (0)
    for (;;) {
        const bool more_pass = pass == 0, more_item = L + G < total, last = !more_pass && !more_item;
        int passn = pass + 1, Ln = L;
        if (!more_pass) { passn = 0; Ln = more_item ? L + G : L; }
        const BlockRef nxt = last ? cur : make_ref(Ln, passn, Q, K, R, V, O);
        const int NT = cur.P0 / KVBLK + 4;
        const int qlo = cur.P0 + wid * QBLK, qm = qlo + r32 - 4 * hi;
        const bf16* Kh = cur.K; const bf16* Vh = cur.V; const bf16* Rh = cur.R;
        if (!grp) NEWBLOCK();
        for (int t = 0; t < NT; t += 2) {
            SLOAD_H(Kh, Rh, Vh, (t + 1) * KVBLK); SBAR();
            STEP(t, 0);
            const bool lt = t + 2 >= NT;
            if (!lt) { SLOAD_H(Kh, Rh, Vh, (t + 2) * KVBLK); } else { SLOAD_H(nxt.K, nxt.R, nxt.V, 0); }
            SBAR();
            STEP(t + 1, 1);
        }
        if (grp) { oldO = cur.O; have_old = true; } else o_epilogue(o, l_reg, cur.O, lds, li_l, wid, lane, r32, hi);
        if (last) break;
        cur = nxt; pass = passn; L = Ln;
    }
    if (grp) { if (pend) pv_tile<0>(o, vb0 + (vsel == 0 ? 2 : vsel - 1) * SHM_V, pa0, pa1, pa2, pa3); o_epilogue(o, l_reg, oldO, lds, li_l, wid, lane, r32, hi); }
    __syncthreads();
#undef RESC
#undef NEWBLOCK
#undef STEP
#undef SWRITE_KV
}
#undef ROW
#undef RROW
#undef VMW
#undef SLOAD_H
#undef SWRITE_H
#undef KSWZ
#undef SBAR
}
#define GAS __attribute__((address_space(1)))
#define LAS __attribute__((address_space(3)))
typedef unsigned short bf16;
typedef unsigned v4u __attribute__((ext_vector_type(4)));
typedef float f32x4 __attribute__((ext_vector_type(4)));
typedef short bf16x8 __attribute__((ext_vector_type(8)));
typedef GAS unsigned gu32;
typedef GAS unsigned long long gu64;
#define RLX_AGENT __ATOMIC_RELAXED, __HIP_MEMORY_SCOPE_AGENT
#define LDS_WAIT() asm volatile("s_waitcnt lgkmcnt(0)" ::: "memory")
#define VM_WAIT() asm volatile("s_waitcnt vmcnt(0)" ::: "memory")
__device__ __forceinline__ unsigned long long rt() { return __builtin_amdgcn_s_memrealtime(); }
__device__ __forceinline__ unsigned f2bf(float f) { unsigned u = __builtin_bit_cast(unsigned, f); return (u + 0x7fffu + ((u >> 16) & 1u)) >> 16; }
__device__ __forceinline__ unsigned pk2(float lo, float hi) { return f2bf(lo) | (f2bf(hi) << 16); }
#define XB_TMO      128
#define XB_XCNT(j)  (256  + 64 * (j))
#define XB_XSUB(j)  (1280 + 64 * (j))
#define XB_XGEN(j)  (2304 + 64 * (j))
#define XB_TOP      3328
#define XB_TOPGEN   3392
#define XCD_BAR_WORDS 3456
#define XB_SPIN_CAP (1u << 18)

__device__ __forceinline__ unsigned xb_ld(unsigned* p)              { return __hip_atomic_load(p, __ATOMIC_RELAXED, __HIP_MEMORY_SCOPE_AGENT); }
__device__ __forceinline__ unsigned xb_add(unsigned* p, unsigned v) { return __hip_atomic_fetch_add(p, v, __ATOMIC_RELAXED, __HIP_MEMORY_SCOPE_AGENT); }
__device__ __forceinline__ unsigned xb_xcc_id() { return (unsigned)__builtin_amdgcn_s_getreg((3 << 11) | 20) & 0xFu; }
#define XB_SPIN(cond, bar) do { unsigned _sp = 0; while (cond) { __builtin_amdgcn_s_sleep(1); \
    if ((++_sp & 255u) == 0u) { if (xb_ld(&(bar)[XB_TMO])) break; if (_sp > XB_SPIN_CAP) { atomicAdd(&(bar)[XB_TMO], 1u); break; } } } } while (0)

struct XcdBarrier {
    unsigned* bar; unsigned x;
    volatile LAS unsigned* st;
};

__device__ __forceinline__ XcdBarrier xcd_barrier_post(unsigned* bar, volatile LAS unsigned* st, bool t0  ) {
    XcdBarrier b; b.bar = bar; b.x = xb_xcc_id(); b.st = st;
    if (t0) (void)xb_add(&bar[XB_XCNT(b.x)], 1u);
    return b;
}
__device__ __forceinline__ void xcd_barrier_complete(unsigned* bar, unsigned x, unsigned& nloc, unsigned& nx) {
    const unsigned G = gridDim.x * gridDim.y * gridDim.z;
    unsigned sum, cnt, mine, sp = 0u;
    for (;;) {
        sum = 0u; cnt = 0u; mine = 0u;
#pragma unroll
        for (unsigned j = 0; j < 16; ++j) { const unsigned c = xb_ld(&bar[XB_XCNT(j)]); sum += c; cnt += (c > 0u) ? 1u : 0u; mine = (j == x) ? c : mine; }
        if (sum == G) break;
        __builtin_amdgcn_s_sleep(1);
        if ((++sp & 255u) == 0u) { if (xb_ld(&bar[XB_TMO])) break; if (sp > XB_SPIN_CAP) { atomicAdd(&bar[XB_TMO], 1u); break; } }
    }
    nloc = mine > 0u ? mine : 1u; nx = cnt > 0u ? cnt : 1u;
}

__device__ __forceinline__ void xcd_barrier(const XcdBarrier& b, bool t0) {
    asm volatile("s_waitcnt vmcnt(0)" ::: "memory");
    __syncthreads();
    if (t0) {
        unsigned* bar = b.bar;
        __builtin_amdgcn_s_waitcnt(0);
        unsigned nloc = b.st[0], nx = b.st[1];
        if (nloc == 0u) { xcd_barrier_complete(bar, b.x, nloc, nx); b.st[0] = nloc; b.st[1] = nx; }
        const unsigned old = xb_add(&bar[XB_XSUB(b.x)], 1u);
        const unsigned gen = old / nloc;
        if (old + 1u == (gen + 1u) * nloc) {
            __builtin_amdgcn_fence(__ATOMIC_RELEASE, "agent");
            asm volatile("s_waitcnt vmcnt(0)" ::: "memory");
            const unsigned og = xb_add(&bar[XB_TOP], 1u);
            const unsigned tg = og / nx;
            if (og + 1u == (tg + 1u) * nx) xb_add(&bar[XB_TOPGEN], 1u);
            else XB_SPIN(xb_ld(&bar[XB_TOPGEN]) == tg, bar);
            __builtin_amdgcn_fence(__ATOMIC_ACQUIRE, "agent");
            xb_add(&bar[XB_XGEN(b.x)], 1u);
            asm volatile("s_waitcnt vmcnt(0)" ::: "memory");
        } else {
            XB_SPIN(xb_ld(&bar[XB_XGEN(b.x)]) == gen, bar);
            __builtin_amdgcn_fence(__ATOMIC_ACQUIRE, "agent");
            asm volatile("s_waitcnt vmcnt(0)" ::: "memory");
        }
    }
    __syncthreads();
}
constexpr int NWAVES = 8;
constexpr int BATCH = 16, SEQ = 2048, T = BATCH * SEQ, D = 1024, FF = 4096;
constexpr int NPHASE = 25;
#ifndef MK_PER_PHASE
#define MK_PER_PHASE 0
#endif

constexpr size_t MiB = 1u << 20;
constexpr size_t WS_CTL = 0, CTL_ZERO_BYTES = 4 * MiB;
constexpr size_t CTL_SS = 256 * 1024;
constexpr size_t CTL_SSCQ = CTL_SS + 8 * (size_t)T * 8;
constexpr size_t CTL_SSCKV = CTL_SSCQ + 2 * (size_t)T * 8;
constexpr size_t CTL_DUMMY = CTL_SSCKV + 2 * (size_t)T * 8;
static_assert(CTL_DUMMY + (size_t)T * 8 <= CTL_ZERO_BYTES, "ctl");
constexpr size_t WS_W = 4 * MiB;
constexpr size_t W_MI = 0, W_MO = W_MI + 4 * (size_t)FF * D, W_DN = W_MO + 4 * (size_t)FF * D, W_UQ = W_DN + 2 * (size_t)768 * 1024, W_UKV = W_UQ + 2 * (size_t)1536 * 384,
                 W_AO = W_UKV + 2 * (size_t)2048 * 256, W_HI = W_AO + 2 * (size_t)1024 * 1024, W_HO = W_HI + (size_t)4096 * 1024, W_P1 = W_HO + (size_t)1024 * 1024,
                 W_P2 = W_P1 + (size_t)2048 * 1024, W_END = W_P2 + (size_t)1024 * 1024;
constexpr size_t WS_LB = WS_W + W_END * 2;
constexpr size_t WS_PV = WS_LB + 4096;
constexpr int PV_GQ = 0, PV_GK = 384, PV_ON = 768, PV_BP1 = 896, PV_WDW = 2944, PV_BDW = 34688, PV_LNG = 35712, PV_LNB = 36736, PV_BP2 = 37760, PV_POS = 38784, PV_END = PV_POS + T;
static_assert(WS_PV + (size_t)PV_END * 4 <= 96 * MiB, "weights + params");
constexpr size_t WS_XB = 96 * MiB;
constexpr size_t WS_OV = 160 * MiB;
constexpr size_t WS_HH = WS_OV;
constexpr size_t WS_Q = WS_OV, WS_K = WS_OV + 96 * MiB, WS_V = WS_OV + 160 * MiB, WS_O = WS_OV + 224 * MiB, WS_CQ = WS_OV + 288 * MiB, WS_CKV = WS_OV + 312 * MiB, WS_KR = WS_OV + 328 * MiB;
constexpr size_t WS_HQ = WS_OV, WS_HV = WS_OV + 64 * MiB, WS_HG = WS_OV + 128 * MiB, WS_HLF = WS_OV + 192 * MiB;
constexpr size_t WS_CU = WS_OV, WS_CY = WS_OV + 64 * MiB;
constexpr size_t WS_CS = 496 * MiB;
constexpr size_t WS_END = 512 * MiB;
static_assert(WS_KR + (size_t)T * 64 * 2 <= WS_END && WS_HLF + (size_t)T * 1024 * 4 <= WS_END && WS_HH + (size_t)T * FF * 2 <= WS_O + 0 * MiB + 64 * MiB, "ws map");

constexpr int CW_BAR = 4096;

constexpr int RING_OFF = 0, RING_BYTES = 135168;
constexpr int LDSCTL_OFF = RING_BYTES, MISC_OFF = LDSCTL_OFF + 320, EXTRA_OFF = RING_BYTES + 1024;
constexpr int LDS_BYTES = 147456;

__device__ __forceinline__ float wave_sum(float v) {
#pragma unroll
    for (int o = 1; o < 64; o <<= 1) v += __shfl_xor(v, o);
    return v;
}
__device__ __forceinline__ float bf2f(unsigned h) { return __builtin_bit_cast(float, h << 16); }
template <bool TILED = false> __device__ __forceinline__ void p0_transpose_item(const float* W, int K, int N, const float* gain, bf16* WT, int dst_row0, LAS float* scr, int k0, int n0, int lane) {
    float wv_[32];
#pragma unroll
    for (int i = 0; i < 32; ++i) wv_[i] = W[(size_t)(k0 + 2 * i + (lane >> 5)) * N + n0 + (lane & 31)];
#pragma unroll
    for (int i = 0; i < 32; ++i) { const int kk = 2 * i + (lane >> 5); const float gk = gain ? gain[k0 + kk] : 1.0f; scr[kk * 33 + (lane & 31)] = wv_[i] * gk; }
    LDS_WAIT(); asm volatile("" ::: "memory");
    const int c = lane & 7;
#pragma unroll
    for (int j = 0; j < 4; ++j) { const int n = (lane >> 3) + 8 * j; const LAS float* s = scr + (8 * c) * 33 + n;
        v4u o; o.x = pk2(s[0 * 33], s[1 * 33]); o.y = pk2(s[2 * 33], s[3 * 33]); o.z = pk2(s[4 * 33], s[5 * 33]); o.w = pk2(s[6 * 33], s[7 * 33]);
        const int rr = dst_row0 + n;
        if (TILED) *(GAS v4u*)(WT + (((size_t)(rr >> 8) * (K / 64) + (k0 >> 6)) * 256 + (rr & 255)) * 64 + 8 * c) = o;
        else *(GAS v4u*)(WT + (size_t)rr * K + k0 + 8 * c) = o; }
    LDS_WAIT(); asm volatile("" ::: "memory");
}

struct Args {
    const float* in[26]; float* out; unsigned char* ws; int ph_lo, ph_hi, li, pad;
};

#define P0_MAT(cnt_per, nmats, Wbase, Wstride, Kd, Nd, gainexpr, WTbase, WTstride) P0_MATX(true, cnt_per, nmats, Wbase, Wstride, Kd, Nd, gainexpr, WTbase, WTstride)
#define P0_MATX(TL, cnt_per, nmats, Wbase, Wstride, Kd, Nd, gainexpr, WTbase, WTstride) \
    if (r < (cnt_per) * (nmats)) { const int mi = r / (cnt_per), it = r % (cnt_per); const int nnb = (Nd) / 32, kb = it / nnb, nb = it % nnb; \
        p0_transpose_item<TL>((Wbase) + (size_t)mi * (Wstride), (Kd), (Nd), (gainexpr), (WTbase) + (size_t)mi * (WTstride), 32 * nb, scr, 64 * kb, 32 * nb, lane); continue; } r -= (cnt_per) * (nmats);

template <int PART> __device__ __forceinline__ void p0_weights(const Args& a, LAS unsigned char* lds, int gw, int NGW, int lane, int wave) {
    bf16* Wb = (bf16*)(a.ws + WS_W);
    LAS float* scr = (LAS float*)(lds + RING_OFF + wave * 16384);
    const float* norm_mix = a.in[2]; const float* norm_mlp = a.in[3];
    constexpr int I_MI = 16 * 128, I_MO = 64 * 32, I_DN = 16 * 22, I_UQ = 6 * 48, I_UKV = 4 * 64, I_SQ = 16 * 32, I_HI = 16 * 128, I_P1 = 16 * 64;
    constexpr int NM = PART < 2 ? 2 : 1, L0 = PART == 0 ? 0 : PART == 1 ? 2 : PART == 2 ? 0 : 1, J0 = PART == 1 ? 1 : 0;
    constexpr bool HAS_MLA = PART != 3, TAIL_HG = PART == 0 || PART == 3, TAIL_CV = PART == 1;
    constexpr int NITEMS = NM * (I_MI + I_MO) + (HAS_MLA ? I_DN + I_UQ + I_UKV + I_SQ : 0) + (TAIL_HG ? I_HI + I_SQ : 0) + (TAIL_CV ? I_P1 + I_SQ : 0);
    for (int item = gw; item < NITEMS; item += NGW) {
        int r = item;
        P0_MAT(I_MI, NM, a.in[4] + (size_t)L0 * D * FF, (size_t)D * FF, D, FF, norm_mlp + (L0 + mi) * D, Wb + W_MI + (size_t)L0 * FF * D, (size_t)FF * D)
        P0_MATX(true, I_MO, NM, a.in[5] + (size_t)L0 * FF * D, (size_t)FF * D, FF, D, (const float*)nullptr, Wb + W_MO + (size_t)L0 * FF * D, (size_t)FF * D)
        if (HAS_MLA) {
            P0_MAT(I_DN, 1, a.in[6] + (size_t)J0 * D * 704, 0, D, 704, norm_mix + J0 * 3 * D, Wb + W_DN + (size_t)J0 * 768 * D, 0)
            P0_MAT(I_UQ, 1, a.in[9] + (size_t)J0 * 384 * 1536, 0, 384, 1536, a.in[7] + J0 * 384, Wb + W_UQ + (size_t)J0 * 1536 * 384, 0)
            P0_MAT(I_UKV, 1, a.in[10] + (size_t)J0 * 256 * 2048, 0, 256, 2048, a.in[8] + J0 * 256, Wb + W_UKV + (size_t)J0 * 2048 * 256, 0)
            P0_MAT(I_SQ, 1, a.in[13] + (size_t)J0 * D * D, 0, D, D, (const float*)nullptr, Wb + W_AO + (size_t)J0 * D * D, 0)
        }
        if (TAIL_HG) {
            P0_MAT(I_HI, 1, a.in[14], 0, D, FF, norm_mix + 1 * D, Wb + W_HI, 0)
            { const int nnb = D / 32, kb = r / nnb, nb = r % nnb; p0_transpose_item<true>(a.in[17], D, D, nullptr, Wb + W_HO, 32 * nb, scr, 64 * kb, 32 * nb, lane); }
        } else if (TAIL_CV) {
            if (r < I_P1) {
                const int nnb = 2048 / 32, kb = r / nnb, nb = r % nnb, n0 = 32 * nb, bj = n0 >> 10, j0 = n0 & 1023;
                p0_transpose_item<true>(a.in[18], D, 2048, norm_mix + 2 * D, Wb + W_P1, 256 * (j0 >> 7) + 128 * bj + (j0 & 127), scr, 64 * kb, n0, lane); continue; }
            r -= I_P1;
            { const int nnb = D / 32, kb = r / nnb, nb = r % nnb; p0_transpose_item<true>(a.in[24], D, D, nullptr, Wb + W_P2, 32 * nb, scr, 64 * kb, 32 * nb, lane); }
        }
    }
}
__device__ __forceinline__ void p0_prologue(const Args& a, LAS unsigned char* lds, int vcu, int G, int tid, int lane, int wave) {
    unsigned char* ws = a.ws;
    bf16* Wb = (bf16*)(ws + WS_W);
    const int gw = vcu * NWAVES + wave, NGW = G * NWAVES;
    p0_weights<2>(a, lds, gw, NGW, lane, wave);
    for (int i = vcu * 512 + tid; i < 2 * 8192; i += G * 512) { const int j = i >> 13, rem = i & 8191, kt = rem >> 9, ch = rem & 511;
        *(GAS v4u*)(Wb + W_DN + (size_t)j * 768 * D + ((size_t)(2 * 16 + kt) * 256 + 192) * 64 + ch * 8) = (v4u){0u, 0u, 0u, 0u}; }
    for (int c = vcu * 512 + tid; c < 1024; c += G * 512) {
        const float* lg = a.in[15]; const float l0 = lg[c], l1 = lg[1024 + c], l2 = lg[2048 + c], l3 = lg[3072 + c];
        const float mx = fmaxf(fmaxf(l0, l1), fmaxf(l2, l3)); const float e0 = expf(l0 - mx), e1 = expf(l1 - mx), e2 = expf(l2 - mx), e3 = expf(l3 - mx);
        ((float*)(ws + WS_LB))[c] = e1 / (e0 + e1 + e2 + e3);
    }
    { float* pv = (float*)(ws + WS_PV); const int gt = vcu * 512 + tid, NT_ = G * 512;
#define P0_COPY(dst, src, n) for (int i = gt; i < (n); i += NT_) pv[(dst) + i] = (src)[i];
      P0_COPY(PV_GQ, a.in[11], 384) P0_COPY(PV_GK, a.in[12], 384) P0_COPY(PV_ON, a.in[16], 128) P0_COPY(PV_BP1, a.in[19], 2048) P0_COPY(PV_WDW, a.in[20], 31 * 1024)
      P0_COPY(PV_BDW, a.in[21], 1024) P0_COPY(PV_LNG, a.in[22], 1024) P0_COPY(PV_LNB, a.in[23], 1024) P0_COPY(PV_BP2, a.in[25], 1024) P0_COPY(PV_POS, a.in[1], T)
#undef P0_COPY
    }
    const float* x = a.in[0]; bf16* xb = (bf16*)(ws + WS_XB); unsigned long long* ss0 = (unsigned long long*)(ws + CTL_SS);
    for (int m0 = gw; m0 < T; m0 += 2 * NGW) {
        f32x4 v[2][4];
#pragma unroll
        for (int u = 0; u < 2; ++u) { const int mr_ = (m0 + u * NGW < T) ? m0 + u * NGW : m0; const GAS f32x4* xr = (const GAS f32x4*)(x + (size_t)mr_ * D) + lane;
#pragma unroll
            for (int j = 0; j < 4; ++j) v[u][j] = xr[64 * j]; }
#pragma unroll
        for (int u = 0; u < 2; ++u) { const int m = (m0 + u * NGW < T) ? m0 + u * NGW : m0; float s = 0.f;
#pragma unroll
            for (int j = 0; j < 4; ++j) { const float r0 = bf2f(f2bf(v[u][j].x)), r1 = bf2f(f2bf(v[u][j].y)), r2 = bf2f(f2bf(v[u][j].z)), r3 = bf2f(f2bf(v[u][j].w)); s += (r0 * r0 + r1 * r1) + (r2 * r2 + r3 * r3); }
            s = wave_sum(s);
            GAS unsigned long long* o8 = (GAS unsigned long long*)(xb + (size_t)m * D) + lane;
#pragma unroll
            for (int j = 0; j < 4; ++j) o8[64 * j] = (unsigned long long)pk2(v[u][j].x, v[u][j].y) | ((unsigned long long)pk2(v[u][j].z, v[u][j].w) << 32);
            if (lane == 0) ss0[m] = (unsigned long long)(s * 1048576.0f + 0.5f); }
    }
}

__device__ __forceinline__ void mla_finalize(const int* pos, const float* gq, const float* gk, bf16* Q, bf16* Kn, bf16* Kr, int vcu, int G, int lane, int wave) {
    const int gw = vcu * NWAVES + wave, NGW = G * NWAVES;
    const float gq0 = gq[2 * lane], gq1 = gq[2 * lane + 1], gqr = gq[128 + lane], gk0 = gk[2 * lane], gk1 = gk[2 * lane + 1], gkr = gk[128 + lane];
    const float inv_freq = powf(10000.0f, -(float)(2 * (lane & 31)) / 64.0f);
    for (int row = gw; row < T; row += NGW) {
        const int b = row >> 11, s = row & 2047;
        const float ang = (float)pos[row] * inv_freq; float sn, cs; sincosf(ang, &sn, &cs);
        const float sgn = lane < 32 ? -sn : sn;
#pragma unroll 2
        for (int h = 0; h < 8; ++h) {
            bf16* qp = Q + ((size_t)((b * 8 + h) * 2048 + s)) * 192; bf16* kp = Kn + ((size_t)((b * 8 + h) * 2048 + s)) * 128;
            const unsigned wq = *(const unsigned*)(qp + 2 * lane), wk = *(const unsigned*)(kp + 2 * lane); const unsigned er = qp[128 + lane];
            float a0 = bf2f(wq & 0xffffu), a1 = bf2f(wq >> 16), k0 = bf2f(wk & 0xffffu), k1 = bf2f(wk >> 16), e = bf2f(er);
            const float sq = wave_sum(a0 * a0 + a1 * a1), sk = wave_sum(k0 * k0 + k1 * k1), se = wave_sum(e * e);
            const float rq = rsqrtf(sq * (1.0f / 128.0f) + 1e-6f), rk = rsqrtf(sk * (1.0f / 128.0f) + 1e-6f), re = rsqrtf(se * (1.0f / 64.0f) + 1e-6f);
            *(unsigned*)(qp + 2 * lane) = pk2(a0 * rq * gq0, a1 * rq * gq1);
            *(unsigned*)(kp + 2 * lane) = pk2(k0 * rk * gk0, k1 * rk * gk1);
            e = e * re * gqr; const float pe = __shfl_xor(e, 32);
            qp[128 + lane] = (bf16)f2bf(e * cs + pe * sgn);
        }
        { bf16* rp = Kr + (size_t)row * 64; float e = bf2f(rp[lane]); const float se = wave_sum(e * e); e = e * rsqrtf(se * (1.0f / 64.0f) + 1e-6f) * gkr;
          const float pe = __shfl_xor(e, 32); rp[lane] = (bf16)f2bf(e * cs + pe * sgn); }
    }
}

__device__ __forceinline__ void kr_finalize(const int* pos, const float* gk, bf16* Kr, float* cs_tab, int vcu, int G, int lane, int wave) {
    typedef float f32x2 __attribute__((ext_vector_type(2)));
    const int gw = vcu * NWAVES + wave, NGW = G * NWAVES;
    const float gkr = gk[128 + lane];
    const float inv_freq = powf(10000.0f, -(float)(2 * (lane & 31)) / 64.0f);
    for (int row = gw; row < T; row += NGW) {
        const float ang = (float)pos[row] * inv_freq; float sn, cs; sincosf(ang, &sn, &cs);
        const float sgn = lane < 32 ? -sn : sn;
        bf16* rp = Kr + (size_t)row * 64; float e = bf2f(rp[lane]); const float se = wave_sum(e * e); e = e * rsqrtf(se * (1.0f / 64.0f) + 1e-6f) * gkr;
        const float pe = __shfl_xor(e, 32); rp[lane] = (bf16)f2bf(e * cs + pe * sgn);
        if (lane < 32) *(f32x2*)(cs_tab + (size_t)row * 64 + 2 * lane) = (f32x2){cs, sn};
    }
}

__device__ __forceinline__ void hgrn_scan_simple(LAS unsigned char* lds, bf16* hq, const bf16* hv, const bf16* hg, const float* hlf, const float* onorm, int unit, int tid) {
    LAS float* Lf = (LAS float*)(lds); LAS float* Lk = Lf + 4096; LAS float* Lq = Lk + 4096; LAS float* Lv = Lq + 4096; LAS float* Lp = Lv + 4096;
    const int b = unit >> 3, h = unit & 7, dv = tid & 127, kg = tid >> 7;
    float S[32];
#pragma unroll
    for (int j = 0; j < 32; ++j) S[j] = 0.f;
    for (int c0 = 0; c0 < SEQ; c0 += 32) {
#pragma unroll
        for (int i = 0; i < 8; ++i) { const int idx = tid + 512 * i, t = idx >> 7, c = idx & 127; const size_t g = (size_t)(b * SEQ + c0 + t) * 1024 + h * 128 + c;
            const float f = __expf(hlf[g]); Lf[idx] = f; Lk[idx] = 1.0f - f; Lq[idx] = bf2f(hq[g]); Lv[idx] = bf2f(hv[g]); }
        __syncthreads();
        for (int t = 0; t < 32; ++t) {
            const float vv = Lv[t * 128 + dv]; float acc = 0.f;
            const LAS f32x4* pf = (const LAS f32x4*)(Lf + t * 128 + kg * 32); const LAS f32x4* pk = (const LAS f32x4*)(Lk + t * 128 + kg * 32); const LAS f32x4* pq = (const LAS f32x4*)(Lq + t * 128 + kg * 32);
#pragma unroll
            for (int j4 = 0; j4 < 8; ++j4) { const f32x4 f4 = pf[j4], k4 = pk[j4], q4 = pq[j4];
#pragma unroll
                for (int e = 0; e < 4; ++e) { const int j = j4 * 4 + e; S[j] = f4[e] * S[j] + k4[e] * vv; acc += q4[e] * S[j]; } }
            Lp[(kg * 32 + t) * 128 + dv] = acc;
        }
        __syncthreads();
        { const int t = tid >> 4, d0 = (tid & 15) * 8; float o[8]; float sq = 0.f;
#pragma unroll
            for (int e = 0; e < 8; ++e) { o[e] = (Lp[(0 * 32 + t) * 128 + d0 + e] + Lp[(1 * 32 + t) * 128 + d0 + e]) + (Lp[(2 * 32 + t) * 128 + d0 + e] + Lp[(3 * 32 + t) * 128 + d0 + e]); sq += o[e] * o[e]; }
            sq += __shfl_xor(sq, 1); sq += __shfl_xor(sq, 2); sq += __shfl_xor(sq, 4); sq += __shfl_xor(sq, 8);
            const float rn = rsqrtf(sq * (1.0f / 128.0f) + 1e-6f);
            const size_t g = (size_t)(b * SEQ + c0 + t) * 1024 + h * 128 + d0;
            const v4u gv = *(const v4u*)(hg + g); unsigned w[4];
#pragma unroll
            for (int e = 0; e < 4; ++e) { const unsigned gg = e == 0 ? gv.x : e == 1 ? gv.y : e == 2 ? gv.z : gv.w;
                w[e] = pk2(o[2 * e] * rn * onorm[d0 + 2 * e] * bf2f(gg & 0xffffu), o[2 * e + 1] * rn * onorm[d0 + 2 * e + 1] * bf2f(gg >> 16)); }
            *(v4u*)(hq + g) = (v4u){w[0], w[1], w[2], w[3]}; }
        __syncthreads();
    }
}

#ifndef EXP_NO_LN
#define EXP_NO_LN 0
#endif
__device__ __forceinline__ void conv_phase(LAS unsigned char* lds, const bf16* cu, bf16* cy, const float* wdw, const float* bdw, const float* lng, const float* lnb, int vcu, int G, int tid, int lane, int wave) {
    typedef float f32x2 __attribute__((ext_vector_type(2)));
    constexpr int TT = 16, NU = TT + 30;
    LAS f32x2* red = (LAS f32x2*)(lds + RING_OFF);
    const int c0 = 2 * tid;
    f32x2 wv[31];
#pragma unroll
    for (int k = 0; k < 31; ++k) wv[k] = *(const f32x2*)(wdw + k * 1024 + c0);
    const f32x2 bd = *(const f32x2*)(bdw + c0), g2 = *(const f32x2*)(lng + c0), b2 = *(const f32x2*)(lnb + c0);
    int par = 0;
    const int NT = T / TT, TPW = (NT + G - 1) / G, tb = vcu * TPW, te = (tb + TPW < NT) ? tb + TPW : NT;
    if (tb >= te) return;
    f32x2 uv[NU];
    unsigned nx[TT];
    {
        const int row0 = tb * TT, s0 = row0 & 2047;
#pragma unroll
        for (int i = 0; i < 30; ++i) {
            unsigned u = 0u;
            if (s0 - 30 + i >= 0) u = *(const unsigned*)(cu + (size_t)(row0 - 30 + i) * 1024 + c0);
            uv[i] = (f32x2){bf2f(u & 0xffffu), bf2f(u >> 16)};
        }
#pragma unroll
        for (int i = 0; i < TT; ++i) nx[i] = *(const unsigned*)(cu + (size_t)(row0 + i) * 1024 + c0);
    }
    for (int tile = tb; tile < te; ++tile) {
        const int row0 = tile * TT;
#pragma unroll
        for (int i = 0; i < TT; ++i) uv[30 + i] = (f32x2){bf2f(nx[i] & 0xffffu), bf2f(nx[i] >> 16)};
        if (tile + 1 < te) {
#pragma unroll
            for (int i = 0; i < TT; ++i) nx[i] = *(const unsigned*)(cu + (size_t)(row0 + TT + i) * 1024 + c0);
        }
        f32x2 yv[TT];
#pragma unroll
        for (int t = 0; t < TT; t += 2) { f32x2 a = bd, b = bd;
#pragma unroll
            for (int k = 0; k < 31; ++k) { a = __builtin_elementwise_fma(wv[k], uv[t + k], a); b = __builtin_elementwise_fma(wv[k], uv[t + 1 + k], b); }
            yv[t] = a; yv[t + 1] = b; }
        LAS f32x2* wp = red + (size_t)(par * TT * 8); par ^= 1;
        float zs[TT];
#define DPPA(v, c) v += __builtin_bit_cast(float, __builtin_amdgcn_mov_dpp(__builtin_bit_cast(int, v), c, 0xf, 0xf, true))
#pragma unroll
        for (int t = 0; t < TT; ++t) { float A = yv[t].x + yv[t].y, B = yv[t].x * yv[t].x + yv[t].y * yv[t].y;
            DPPA(A, 0xB1); DPPA(B, 0xB1); DPPA(A, 0x4E); DPPA(B, 0x4E); DPPA(A, 0x141); DPPA(B, 0x141); DPPA(A, 0x140); DPPA(B, 0x140);
            auto r1 = __builtin_amdgcn_permlane32_swap(__float_as_uint(A), __float_as_uint(B), false, false);
            const float X = __uint_as_float(r1[0]) + __uint_as_float(r1[1]);
            auto r2 = __builtin_amdgcn_permlane16_swap(__float_as_uint(X), __float_as_uint(X), false, false);
            zs[t] = __uint_as_float(r2[0]) + __uint_as_float(r2[1]); }
#undef DPPA
        if ((lane & 31) == 0) {
#pragma unroll
            for (int t = 0; t < TT; ++t) ((LAS float*)wp)[(t * 8 + wave) * 2 + (lane >> 5)] = zs[t];
        }
        __syncthreads();
#pragma unroll
        for (int t = 0; t < TT; ++t) { float s1 = 0.f, s2 = 0.f;
#pragma unroll
            for (int q = 0; q < 8; ++q) { const f32x2 v = wp[t * 8 + q]; s1 += v.x; s2 += v.y; }
            const float mean = s1 * (1.0f / 1024.0f), var = fmaxf(s2 * (1.0f / 1024.0f) - mean * mean, 0.f);
            const f32x2 st = (f32x2){mean, rsqrtf(var + 1e-6f)};
            float a = (yv[t].x - st.x) * st.y * g2.x + b2.x, b = (yv[t].y - st.x) * st.y * g2.y + b2.y;
            a = a * __builtin_amdgcn_rcpf(1.0f + __expf(-a)); b = b * __builtin_amdgcn_rcpf(1.0f + __expf(-b));
            *(unsigned*)(cy + (size_t)(row0 + t) * 1024 + c0) = pk2(a, b); }
        const bool newseq = ((row0 + TT) & 2047) == 0;
#pragma unroll
        for (int i = 0; i < 30; ++i) uv[i] = newseq ? (f32x2){0.f, 0.f} : uv[i + TT];
    }
}
namespace hgs {
typedef short bf16x8 __attribute__((ext_vector_type(8)));
typedef short s16x4 __attribute__((ext_vector_type(4)));
typedef float f32x4 __attribute__((ext_vector_type(4)));
typedef float f32x2 __attribute__((ext_vector_type(2)));
typedef unsigned u32x4 __attribute__((ext_vector_type(4)));
typedef unsigned u32x2 __attribute__((ext_vector_type(2)));
constexpr int RS = 272, RK = 144, RO = 528;
constexpr int OFF_KT = 0, OFF_LF = 0, OFF_QI = 43520, OFF_VV = OFF_QI + 17408, OFF_QT = OFF_VV + 17408, OFF_KO = OFF_QT + 17408, OFF_AT = OFF_KO + 18432, OFF_SEG = OFF_AT + 9216, OFF_AL = OFF_SEG + 4096,
              OFF_OUT = OFF_QT, LDS_END = OFF_AL + 512;
static_assert(LDS_END <= 131072 && 64 * RO <= 17408 + 18432 && 10 * 16 * RS <= OFF_QI && 64 * 512 <= OFF_QI, "scan LDS map");
__device__ __forceinline__ unsigned pkbf(float lo, float hi) { unsigned r; asm volatile("v_cvt_pk_bf16_f32 %0, %1, %2" : "=v"(r) : "v"(lo), "v"(hi)); return r; }
__device__ __forceinline__ float bflo(unsigned w) { return __builtin_bit_cast(float, w << 16); }
__device__ __forceinline__ float bfhi(unsigned w) { return __builtin_bit_cast(float, w & 0xffff0000u); }
__device__ __forceinline__ void trrd4(s16x4& a, s16x4& b, s16x4& c, s16x4& d, unsigned addr) {
    asm volatile("ds_read_b64_tr_b16 %0, %4\n\tds_read_b64_tr_b16 %1, %4 offset:%5\n\tds_read_b64_tr_b16 %2, %4 offset:%6\n\tds_read_b64_tr_b16 %3, %4 offset:%7\n\ts_waitcnt lgkmcnt(0)"
                 : "=&v"(a), "=&v"(b), "=&v"(c), "=&v"(d) : "v"(addr), "n"(4 * RS), "n"(32 * RS), "n"(32 * RS + 4 * RS) : "memory");
}

__device__ __forceinline__ void scan_unit(LAS unsigned char* lds, unsigned short* hq, const unsigned short* hv, const unsigned short* hg, const float* hlf, const float* onorm, unsigned short* ho, int unit, int wave_s) {
    int tid_ = wave_s * 64 + mk_lane(); asm volatile("" : "+v"(tid_));
    const int tid = tid_, lane = tid & 63, w = __builtin_amdgcn_readfirstlane(tid >> 6);
    const int b = unit >> 3, h = unit & 7;
    const size_t gbase = (size_t)b * SEQ * 1024 + h * 128;
    u32x4 pq[2], pv[2], pg[2]; f32x4 pl[4];
#define SCAN_LOAD(c0) do { _Pragma("unroll") for (int i = 0; i < 2; ++i) { const int p = tid + 512 * i, t = p >> 4, c = p & 15; const size_t g = gbase + (size_t)((c0) + t) * 1024 + c * 8; \
            pq[i] = *(const u32x4*)(hq + g); pv[i] = *(const u32x4*)(hv + g); } \
        _Pragma("unroll") for (int i = 0; i < 4; ++i) { const int p = tid + 512 * i, t = p >> 5, c = p & 31; pl[i] = *(const f32x4*)(hlf + gbase + (size_t)((c0) + t) * 1024 + c * 4); } } while (0)
#define SCAN_STORE() do { _Pragma("unroll") for (int i = 0; i < 2; ++i) { const int p = tid + 512 * i, t = p >> 4, c = p & 15; \
            *(LAS u32x4*)(lds + OFF_QI + t * RS + c * 16) = pq[i]; *(LAS u32x4*)(lds + OFF_VV + t * RS + c * 16) = pv[i]; } \
        _Pragma("unroll") for (int i = 0; i < 4; ++i) { const int p = tid + 512 * i, t = p >> 5, c = p & 31; *(LAS f32x4*)(lds + OFF_LF + t * 512 + c * 16) = pl[i]; } } while (0)
    const int to = tid >> 3, d0 = (tid & 7) * 16;
    float gn[16];
#pragma unroll
    for (int e = 0; e < 16; ++e) gn[e] = onorm[d0 + e];
    for (int i = tid; i < 64 * RK / 4; i += 512) *(LAS unsigned*)(lds + OFF_AT + i * 4) = 0u;
    f32x4 S[8];
#pragma unroll
    for (int k = 0; k < 8; ++k) S[k] = (f32x4){0.f, 0.f, 0.f, 0.f};
    SCAN_LOAD(0); SCAN_STORE();
    const int col = lane & 15, rq = lane >> 4;
    f32x2 fv[8], R[8], Sx[8];
#define SCAN_S2() do { f32x2 ls = (f32x2){0.f, 0.f};                                                                                                   \
        _Pragma("unroll") for (int i = 0; i < 8; ++i) { const f32x2 l = *(const LAS f32x2*)(lds + OFF_LF + (8 * w + i) * 512 + lane * 8); ls += l; fv[i] = (f32x2){__expf(l.x), __expf(l.y)}; } \
        R[0] = fv[0];                                                                                                                                  \
        _Pragma("unroll") for (int i = 1; i < 8; ++i) R[i] = R[i - 1] * fv[i];                                                                         \
        Sx[7] = (f32x2){1.f, 1.f};                                                                                                                     \
        _Pragma("unroll") for (int i = 6; i >= 0; --i) Sx[i] = Sx[i + 1] * fv[i + 1];                                                                  \
        *(LAS f32x2*)(lds + OFF_SEG + w * 512 + lane * 8) = ls; } while (0)
    __syncthreads();
    SCAN_S2();
    for (int c0 = 0; c0 < SEQ; c0 += 64) {
        __syncthreads();
        if (c0 + 64 < SEQ) SCAN_LOAD(c0 + 64);
        { const size_t g = gbase + (size_t)(c0 + to) * 1024 + d0; pg[0] = *(const u32x4*)(hg + g); pg[1] = *(const u32x4*)(hg + g + 8); }
        {
            f32x2 tt[8];
#pragma unroll
            for (int s = 0; s < 8; ++s) tt[s] = *(const LAS f32x2*)(lds + OFF_SEG + s * 512 + lane * 8);
            f32x2 base = (f32x2){0.f, 0.f}, after = (f32x2){0.f, 0.f}, all = (f32x2){0.f, 0.f};
#pragma unroll
            for (int s = 0; s < 8; ++s) { if (s < w) base += tt[s]; if (s > w) after += tt[s]; all += tt[s]; }
            const int J = w >> 1, odd = w & 1;
            f32x2 prevt = (f32x2){0.f, 0.f};
#pragma unroll
            for (int s = 0; s < 8; ++s) if (odd && s == w - 1) prevt = tt[s];
            const f32x2 eb = (f32x2){__expf(base.x), __expf(base.y)};
            const f32x2 ep = (f32x2){__expf(prevt.x), __expf(prevt.y)};
            const f32x2 epi = (f32x2){__expf(-prevt.x), __expf(-prevt.y)};
            const f32x2 el = (f32x2){__expf(after.x), __expf(after.y)};
            f32x2 eI[3];
#pragma unroll
            for (int I = 1; I < 4; ++I) { f32x2 a = (f32x2){0.f, 0.f};
#pragma unroll
                for (int s = 0; s < 8; ++s) if (s > w && s < 2 * I) a += tt[s];
                eI[I - 1] = (f32x2){__expf(a.x), __expf(a.y)}; }
            if (w == 0) *(LAS f32x2*)(lds + OFF_AL + lane * 8) = (f32x2){__expf(all.x), __expf(all.y)};
            unsigned kow[2][4];
            const int sl0 = 8 * odd;
            unsigned qws[8];
#pragma unroll
            for (int i = 0; i < 8; ++i) qws[i] = *(const LAS unsigned*)(lds + OFF_QI + (8 * w + i) * RS + lane * 4);
#pragma unroll
            for (int i = 0; i < 8; ++i) {
                const int t = 8 * w + i;
                const unsigned qw = qws[i];
                const f32x2 q = (f32x2){bflo(qw), bfhi(qw)};
                const f32x2 k = (f32x2){1.f, 1.f} - fv[i];
                const f32x2 qin = q * eb * R[i], qt = q * ep * R[i];
                *(LAS unsigned*)(lds + OFF_QI + t * RS + lane * 4) = pkbf(qin.x, qin.y);
                *(LAS unsigned*)(lds + OFF_QT + t * RS + lane * 4) = pkbf(qt.x, qt.y);
                const f32x2 ks = k * Sx[i];
                const f32x2 ko = ks * el;
                if (i & 1) { kow[0][i >> 1] |= pkbf(0.f, ko.x) & 0xffff0000u; kow[1][i >> 1] |= pkbf(0.f, ko.y) & 0xffff0000u; }
                else { kow[0][i >> 1] = pkbf(ko.x, 0.f) & 0xffffu; kow[1][i >> 1] = pkbf(ko.y, 0.f) & 0xffffu; }
                const f32x2 ri = (f32x2){__builtin_amdgcn_rcpf(R[i].x), __builtin_amdgcn_rcpf(R[i].y)};
                const f32x2 kd = k * epi * ri;
                *(LAS unsigned*)(lds + OFF_KT + ((J * (J + 1) / 2 + J) * 16 + sl0 + i) * RS + lane * 4) = pkbf(kd.x, kd.y);
#pragma unroll
                for (int I = 1; I < 4; ++I) if (I > J) { const f32x2 kk = ks * eI[I - 1];
                    *(LAS unsigned*)(lds + OFF_KT + ((I * (I + 1) / 2 + J) * 16 + sl0 + i) * RS + lane * 4) = pkbf(kk.x, kk.y); }
            }
            *(LAS u32x4*)(lds + OFF_KO + (2 * lane) * RK + 16 * w) = (u32x4){kow[0][0], kow[0][1], kow[0][2], kow[0][3]};
            *(LAS u32x4*)(lds + OFF_KO + (2 * lane + 1) * RK + 16 * w) = (u32x4){kow[1][0], kow[1][1], kow[1][2], kow[1][3]};
        }
        __syncthreads();
#pragma unroll
        for (int rep = 0; rep < 2; ++rep) {
            const int idx = w + 8 * rep;
            if (idx < 10) {
                const int I = idx >= 6 ? 3 : (idx >= 3 ? 2 : (idx >= 1 ? 1 : 0)), Jb = idx - I * (I + 1) / 2;
                f32x4 d = (f32x4){0.f, 0.f, 0.f, 0.f};
                bf16x8 ka[4], qb[4];
#pragma unroll
                for (int j = 0; j < 4; ++j) { ka[j] = *(const LAS bf16x8*)(lds + OFF_KT + (idx * 16 + col) * RS + (32 * j + 8 * rq) * 2);
                                              qb[j] = *(const LAS bf16x8*)(lds + OFF_QT + (16 * I + col) * RS + (32 * j + 8 * rq) * 2); }
                __builtin_amdgcn_sched_barrier(0);
#pragma unroll
                for (int j = 0; j < 4; ++j) d = __builtin_amdgcn_mfma_f32_16x16x32_bf16(ka[j], qb[j], d, 0, 0, 0);
                if (I == Jb) {
#pragma unroll
                    for (int i = 0; i < 4; ++i) if (4 * rq + i > col) d[i] = 0.f; }
                *(LAS u32x2*)(lds + OFF_AT + (16 * I + col) * RK + (16 * Jb + 4 * rq) * 2) = (u32x2){pkbf(d[0], d[1]), pkbf(d[2], d[3])};
            }
        }
        bf16x8 vf[2];
        {
            const unsigned va = (unsigned)(size_t)(lds + OFF_VV) + (unsigned)((8 * rq + ((lane & 15) >> 2)) * RS + w * 32 + (lane & 3) * 8);
            s16x4 l0, h0, l1, h1; trrd4(l0, h0, l1, h1, va);
            vf[0] = (bf16x8){l0[0], l0[1], l0[2], l0[3], h0[0], h0[1], h0[2], h0[3]}; vf[1] = (bf16x8){l1[0], l1[1], l1[2], l1[3], h1[0], h1[1], h1[2], h1[3]};
        }
        f32x4 oacc[4];
        {
            bf16x8 sb[4];
#pragma unroll
            for (int j = 0; j < 4; ++j) { const u32x4 wv = (u32x4){pkbf(S[2 * j][0], S[2 * j][1]), pkbf(S[2 * j][2], S[2 * j][3]), pkbf(S[2 * j + 1][0], S[2 * j + 1][1]), pkbf(S[2 * j + 1][2], S[2 * j + 1][3])};
                sb[j] = __builtin_bit_cast(bf16x8, wv); }
            u32x4 av[4][4];
#pragma unroll
            for (int mb = 0; mb < 4; ++mb)
#pragma unroll
                for (int j = 0; j < 4; ++j) {
                    const u32x2 lo = *(const LAS u32x2*)(lds + OFF_QI + (16 * mb + col) * RS + (32 * j + 4 * rq) * 2), hi = *(const LAS u32x2*)(lds + OFF_QI + (16 * mb + col) * RS + (32 * j + 16 + 4 * rq) * 2);
                    av[mb][j] = (u32x4){lo.x, lo.y, hi.x, hi.y}; }
            __builtin_amdgcn_sched_barrier(0);
#pragma unroll
            for (int mb = 0; mb < 4; ++mb) oacc[mb] = (f32x4){0.f, 0.f, 0.f, 0.f};
#pragma unroll
            for (int j = 0; j < 4; ++j)
#pragma unroll
                for (int mb = 0; mb < 4; ++mb) oacc[mb] = __builtin_amdgcn_mfma_f32_16x16x32_bf16(__builtin_bit_cast(bf16x8, av[mb][j]), sb[j], oacc[mb], 0, 0, 0);
            __builtin_amdgcn_sched_barrier(0);
        }
#pragma unroll
        for (int bh = 0; bh < 2; ++bh) {
            f32x4 al[4]; bf16x8 ka[4][2];
#pragma unroll
            for (int b4 = 0; b4 < 4; ++b4) { const int blk = 4 * bh + b4; al[b4] = *(const LAS f32x4*)(lds + OFF_AL + (16 * blk + 4 * rq) * 4);
#pragma unroll
                for (int ks = 0; ks < 2; ++ks) ka[b4][ks] = *(const LAS bf16x8*)(lds + OFF_KO + (16 * blk + col) * RK + (32 * ks + 8 * rq) * 2); }
            __builtin_amdgcn_sched_barrier(0);
#pragma unroll
            for (int b4 = 0; b4 < 4; ++b4) S[4 * bh + b4] = S[4 * bh + b4] * al[b4];
#pragma unroll
            for (int ks = 0; ks < 2; ++ks)
#pragma unroll
                for (int b4 = 0; b4 < 4; ++b4) S[4 * bh + b4] = __builtin_amdgcn_mfma_f32_16x16x32_bf16(ka[b4][ks], vf[ks], S[4 * bh + b4], 0, 0, 0);
            __builtin_amdgcn_sched_barrier(0);
        }
        __syncthreads();
        if (c0 + 64 < SEQ) SCAN_STORE();
        {
            bf16x8 aa[4][2];
#pragma unroll
            for (int mb = 0; mb < 4; ++mb)
#pragma unroll
                for (int ks = 0; ks < 2; ++ks) if (ks == 0 || mb >= 2) aa[mb][ks] = *(const LAS bf16x8*)(lds + OFF_AT + (16 * mb + col) * RK + (32 * ks + 8 * rq) * 2);
            __builtin_amdgcn_sched_barrier(0);
#pragma unroll
            for (int ks = 0; ks < 2; ++ks)
#pragma unroll
                for (int mb = 0; mb < 4; ++mb) if (ks == 0 || mb >= 2) oacc[mb] = __builtin_amdgcn_mfma_f32_16x16x32_bf16(aa[mb][ks], vf[ks], oacc[mb], 0, 0, 0);
#pragma unroll
            for (int mb = 0; mb < 4; ++mb)
#pragma unroll
                for (int i = 0; i < 4; ++i) *(LAS float*)(lds + OFF_OUT + (16 * mb + 4 * rq + i) * RO + (16 * w + col) * 4) = oacc[mb][i];
        }
        __syncthreads();
        {
            f32x4 ov[4]; float sq = 0.f;
#pragma unroll
            for (int e = 0; e < 4; ++e) { ov[e] = *(const LAS f32x4*)(lds + OFF_OUT + to * RO + (d0 + 4 * e) * 4); sq += (ov[e][0] * ov[e][0] + ov[e][1] * ov[e][1]) + (ov[e][2] * ov[e][2] + ov[e][3] * ov[e][3]); }
            sq += __shfl_xor(sq, 1); sq += __shfl_xor(sq, 2); sq += __shfl_xor(sq, 4);
            const float rn = rsqrtf(sq * (1.0f / 128.0f) + 1e-6f);
            unsigned ow[8];
#pragma unroll
            for (int e = 0; e < 8; ++e) { const unsigned gw = e < 4 ? pg[0][e] : pg[1][e - 4];
                ow[e] = pkbf(ov[e >> 1][(2 * e) & 3] * rn * gn[2 * e] * bflo(gw), ov[e >> 1][(2 * e + 1) & 3] * rn * gn[2 * e + 1] * bfhi(gw)); }
            const size_t g = gbase + (size_t)(c0 + to) * 1024 + d0;
            *(u32x4*)(ho + g) = (u32x4){ow[0], ow[1], ow[2], ow[3]}; *(u32x4*)(ho + g + 8) = (u32x4){ow[4], ow[5], ow[6], ow[7]};
        }
        if (c0 + 64 < SEQ) SCAN_S2();
    }
    __syncthreads();
#undef SCAN_S2
#undef SCAN_LOAD
#undef SCAN_STORE
}
}
static_assert(att::LDS_BYTES <= RING_BYTES && pg8::STAGE_BYTES <= RING_BYTES && hgs::LDS_END <= RING_BYTES && EXTRA_OFF + 4096 <= LDS_BYTES, "LDS map");
__global__ void __launch_bounds__(NWAVES * 64, 2) mk_fwd(Args args) {
    extern __shared__ __attribute__((aligned(16))) unsigned char lds_raw[];
    LAS unsigned char* lds = (LAS unsigned char*)lds_raw;
    volatile LAS unsigned* MISC = (volatile LAS unsigned*)(lds + MISC_OFF);
    const int wave = __builtin_amdgcn_readfirstlane(threadIdx.x >> 6);
    const int tid = wave * 64 + mk_lane();
    const int G = gridDim.x; const int bx = blockIdx.x; const int vcu = (G % 8 == 0) ? (bx % 8) * (G / 8) + bx / 8 : bx;
    gu32* ctl = (gu32*)(args.ws + WS_CTL);
    for (int u = tid; u < (LDS_BYTES - LDSCTL_OFF) / 4; u += NWAVES * 64) ((LAS unsigned*)(lds + LDSCTL_OFF))[u] = 0u;
    __syncthreads();
#if MK_PER_PHASE
#define GRID_BAR() do { } while (0)
#else
    XcdBarrier bar = xcd_barrier_post((unsigned*)(ctl + CW_BAR), MISC + 8, wave == 0 && mk_lane() == 0);
#define GRID_BAR() xcd_barrier(bar, wave == 0 && mk_lane() == 0)
#endif
    const int lo = args.ph_lo, hi = args.ph_hi;
#ifndef REP_PHASE
#define REP_PHASE -1
#define REP_COUNT 2
#endif
#define REPEAT(k) _Pragma("unroll") for (int r_ = 0; r_ < (((k) == REP_PHASE) ? REP_COUNT : 1); ++r_)
#ifndef STAG_TICKS
#define STAG_TICKS 0
#endif
#ifndef MLPOUT_REV
#define MLPOUT_REV 1
#endif
#ifndef GEMM_SP2
#define GEMM_SP2 true
#endif
#ifndef SCAN_SIMPLE
#define SCAN_SIMPLE 0
#endif
#ifndef EXP_SKIP_CONV
#define EXP_SKIP_CONV 0
#endif
#ifndef NO_UQ
#define NO_UQ 0
#endif
#ifndef NO_UKV
#define NO_UKV 0
#endif
#ifndef ONLY_LO
#define ONLY_LO 0
#define ONLY_HI 99
#endif
#define IN(k) ((ONLY_LO) <= (k) && (k) <= (ONLY_HI) && lo <= (k) && (k) < hi)
#define SEAM(k) do { if (IN(k) && IN((k) + 1)) GRID_BAR(); } while (0)
#define WSDEF unsigned long long z_ = 0; asm volatile("" : "+s"(z_)); unsigned char* ws_ = args.ws + z_
#define P_OUT (args.out)
#define P_PV ((const float*)(ws_ + WS_PV))
#define P_POS ((const int*)(P_PV + PV_POS))
#define P_SSB ((pg8::ssq_t*)(ws_ + CTL_SS))
#define P_SSCQ ((pg8::ssq_t*)(ws_ + CTL_SSCQ))
#define P_SSCKV ((pg8::ssq_t*)(ws_ + CTL_SSCKV))
#define P_WB ((pg8::bf16_t*)(ws_ + WS_W))
#define P_XB ((pg8::bf16_t*)(ws_ + WS_XB))
#define P_HH ((pg8::bf16_t*)(ws_ + WS_HH))
#define P_Q ((pg8::bf16_t*)(ws_ + WS_Q))
#define P_K ((pg8::bf16_t*)(ws_ + WS_K))
#define P_V ((pg8::bf16_t*)(ws_ + WS_V))
#define P_O ((pg8::bf16_t*)(ws_ + WS_O))
#define P_CQ ((pg8::bf16_t*)(ws_ + WS_CQ))
#define P_CKV ((pg8::bf16_t*)(ws_ + WS_CKV))
#define P_KR ((pg8::bf16_t*)(ws_ + WS_KR))
#define P_HQ ((pg8::bf16_t*)(ws_ + WS_HQ))
#define P_HV ((pg8::bf16_t*)(ws_ + WS_HV))
#define P_HG ((pg8::bf16_t*)(ws_ + WS_HG))
#define P_HLF ((float*)(ws_ + WS_HLF))
#define P_CU ((pg8::bf16_t*)(ws_ + WS_CU))
#define P_CY ((pg8::bf16_t*)(ws_ + WS_CY))
#define P_LB ((const float*)(ws_ + WS_LB))

#define RUN_GEMM(EpiT, Aptr, Btptr, Nn, Kk, ...) do { pg8::Gemm g_{(Aptr), (Btptr), T, (Nn), (Kk)}; pg8::StaticOrder S_; S_.init(T, (Nn), G, (int)blockIdx.x); \
        EpiT E_{__VA_ARGS__}; pg8::gemm_phase<EpiT, pg8::StaticOrder, true, GEMM_SP2, false, true>(lds + RING_OFF, g_, S_, E_, wave); } while (0)
#define RUN_GEMM_STAG(EpiT, Aptr, Btptr, Nn, Kk, ...) do { pg8::Gemm g_{(Aptr), (Btptr), T, (Nn), (Kk)}; pg8::StaticOrder S_; S_.init(T, (Nn), G, (int)blockIdx.x); \
        EpiT E_{__VA_ARGS__}; pg8::gemm_phase<EpiT, pg8::StaticOrder, true, GEMM_SP2, false, true>(lds + RING_OFF, g_, S_, E_, wave, (int)((blockIdx.x >> 3) & 3) * STAG_TICKS); } while (0)
#define RUN_GEMM_TILED_P(EpiT, Aptr, Btptr, Nn, Kk, ...) do { pg8::Gemm g_{(Aptr), (Btptr), T, (Nn), (Kk)}; pg8::StaticOrder S_; S_.init(T, (Nn), G, (int)blockIdx.x, 2); \
        EpiT E_{__VA_ARGS__}; pg8::gemm_phase<EpiT, pg8::StaticOrder, true, GEMM_SP2, true>(lds + RING_OFF, g_, S_, E_, wave); } while (0)
#define RUN_GEMM_TILED(EpiT, Aptr, Btptr, Nn, Kk, ...) do { pg8::Gemm g_{(Aptr), (Btptr), T, (Nn), (Kk)}; pg8::StaticOrder S_; S_.init(T, (Nn), G, (int)blockIdx.x, MLPOUT_REV); \
        EpiT E_{__VA_ARGS__}; pg8::gemm_phase<EpiT, pg8::StaticOrder, true, GEMM_SP2, true>(lds + RING_OFF, g_, S_, E_, wave); } while (0)

#define MLP_LAYER(l, P) do { \
    if (IN(P) && (P) == REP_PHASE) { WSDEF; RUN_GEMM(EPI_ROW_NOSTORE, P_XB, P_WB + W_MI + (size_t)(l) * FF * D, FF, D, P_HH, FF, P_SSB + (size_t)(2 * (l) + 1) * T, 1.0f / 1024.0f); } \
    if (IN(P)) { WSDEF; RUN_GEMM_STAG(EPI_ROW_TILED, P_XB, P_WB + W_MI + (size_t)(l) * FF * D, FF, D, P_HH, FF, P_SSB + (size_t)(2 * (l) + 1) * T, 1.0f / 1024.0f); } SEAM(P); \
    if (IN((P) + 1) && (P) + 1 == REP_PHASE) { WSDEF; RUN_GEMM_TILED_P(pg8::EpiResid<false>, P_HH, P_WB + W_MO + (size_t)(l) * FF * D, D, FF, P_OUT, P_XB, (const float*)nullptr, (pg8::ssq_t*)(ws_ + CTL_DUMMY), (pg8::bf16_t*)P_OUT); } \
    if (IN((P) + 1)) { WSDEF; if ((l) < 3) { RUN_GEMM_TILED(pg8::EpiResid<false>, P_HH, P_WB + W_MO + (size_t)(l) * FF * D, D, FF, P_OUT, P_XB, (const float*)nullptr, P_SSB + (size_t)(2 * (l) + 2) * T, P_XB); } \
                       else { RUN_GEMM_TILED(pg8::EpiResid<true>, P_HH, P_WB + W_MO + (size_t)(l) * FF * D, D, FF, P_OUT, P_XB, (const float*)nullptr, (pg8::ssq_t*)nullptr, P_XB); } } SEAM((P) + 1); } while (0)

#define MLA_LAYER(j, l, P) do { \
    if (IN(P)) { WSDEF; RUN_GEMM(pg8::EpiDown, P_XB, P_WB + W_DN + (size_t)(j) * 768 * D, 768, D, P_SSB + (size_t)(2 * (l)) * T, P_CQ, P_CKV, P_KR, P_SSCQ + (size_t)(j) * T, P_SSCKV + (size_t)(j) * T); } \
    if (IN(P) && (j) == 0 && bx >= 128) { OPQ; p0_weights<3>(args, lds, (bx - 128) * NWAVES + w_, 128 * NWAVES, l_, w_); }     \
    SEAM(P); \
    if (IN((P) + 1)) { { WSDEF; OPQ; kr_finalize(P_POS, P_PV + PV_GK + (j) * 192, P_KR, (float*)(ws_ + WS_CS), vcu, G, l_, w_); } \
                       { WSDEF; RUN_GEMM(pg8::EpiUQ, P_CQ, P_WB + W_UQ + (size_t)(j) * 1536 * 384, 1536, 384, P_SSCQ + (size_t)(j) * T, P_Q); } \
                       { WSDEF; RUN_GEMM(pg8::EpiUKV, P_CKV, P_WB + W_UKV + (size_t)(j) * 2048 * 256, 2048, 256, P_SSCKV + (size_t)(j) * T, P_K, P_V, P_PV + PV_GK + (j) * 192, (PG8_LAS float*)(lds + EXTRA_OFF)); } } SEAM((P) + 1); \
    if (IN((P) + 3)) REPEAT((P) + 3) { WSDEF; att::attn_phase((char*)lds_raw + RING_OFF, P_Q, P_K, P_KR, P_V, P_O, P_PV + PV_GQ + (j) * 192, (const float*)(ws_ + WS_CS), G, (int)blockIdx.x, wave); } SEAM((P) + 3); \
    if (IN((P) + 4) && (P) + 4 == REP_PHASE) { WSDEF; RUN_GEMM(pg8::EpiResid<false>, P_O, P_WB + W_AO + (size_t)(j) * D * D, D, D, P_OUT, P_XB, (const float*)nullptr, (pg8::ssq_t*)(ws_ + CTL_DUMMY), (pg8::bf16_t*)P_OUT); } \
    if (IN((P) + 4)) { WSDEF; RUN_GEMM(pg8::EpiResid<false>, P_O, P_WB + W_AO + (size_t)(j) * D * D, D, D, P_OUT, P_XB, (const float*)nullptr, P_SSB + (size_t)(2 * (l) + 1) * T, P_XB); } SEAM((P) + 4); } while (0)

#define EPI_RESID_BIAS pg8::EpiResid<false, true>
#define EPI_ROW_NOSTORE pg8::EpiRow<1, true>
#define EPI_ROW_TILED pg8::EpiRow<1, false, true>
#define OPQ int t_ = wave * 64 + mk_lane(); asm volatile("" : "+v"(t_)); const int l_ = t_ & 63, w_ = __builtin_amdgcn_readfirstlane(t_ >> 6)
    if (IN(0)) REPEAT(0) { OPQ; p0_prologue(args, lds, vcu, G, t_, l_, w_); } SEAM(0);
#if REP_PHASE == 99
    {
        typedef float f32x16 __attribute__((ext_vector_type(16))); typedef short bf16x8v __attribute__((ext_vector_type(8)));
        f32x16 c0 = {}, c1 = {}, c2 = {}, c3 = {}; bf16x8v a = {1, 2, 3, 4, 5, 6, 7, 8}, b = {8, 7, 6, 5, 4, 3, 2, 1};
        asm volatile("" : "+v"(a), "+v"(b));
        for (int it = 0; it < 8192; ++it) {
            c0 = __builtin_amdgcn_mfma_f32_32x32x16_bf16(a, b, c0, 0, 0, 0); c1 = __builtin_amdgcn_mfma_f32_32x32x16_bf16(a, b, c1, 0, 0, 0);
            c2 = __builtin_amdgcn_mfma_f32_32x32x16_bf16(a, b, c2, 0, 0, 0); c3 = __builtin_amdgcn_mfma_f32_32x32x16_bf16(a, b, c3, 0, 0, 0);
        }
        int never = 0; asm volatile("" : "+s"(never));
        if (never) { float s = 0.f; for (int e = 0; e < 16; ++e) s += c0[e] + c1[e] + c2[e] + c3[e]; args.out[tid] = s; }
    }
#endif
    MLA_LAYER(0, 0, 1);
    MLP_LAYER(0, 6);
    if (IN(8)) REPEAT(8) { WSDEF; RUN_GEMM(pg8::EpiHG, P_XB, P_WB + W_HI, FF, D, P_SSB + (size_t)2 * T, P_LB, P_HQ, P_HLF, (size_t)(WS_HV - WS_HQ) / 2); } SEAM(8);
    if (IN(9) && bx >= 128) { OPQ; p0_weights<1>(args, lds, (bx - 128) * NWAVES + w_, 128 * NWAVES, l_, w_); }
    if (IN(9)) { WSDEF; const int nrep9 = (REP_PHASE == 9) ? args.pad : 1; for (int r9 = 0; r9 < nrep9; ++r9) { if (bx < 128) hgs::scan_unit(lds, P_HQ, P_HV, P_HG, P_HLF, P_PV + PV_ON, (r9 + 1 < nrep9) ? (unsigned short*)P_OUT : P_HQ, bx, wave); } } SEAM(9);
    if (IN(10)) { WSDEF; RUN_GEMM(pg8::EpiResid<false>, P_HQ, P_WB + W_HO, D, D, P_OUT, P_XB, (const float*)nullptr, P_SSB + (size_t)3 * T, P_XB); } SEAM(10);
    MLP_LAYER(1, 11);
    if (IN(13)) REPEAT(13) { WSDEF; RUN_GEMM(pg8::EpiGLU, P_XB, P_WB + W_P1, 2048, D, P_SSB + (size_t)4 * T, P_PV + PV_BP1, P_CU); } SEAM(13);
    if (IN(14)) REPEAT(14) { WSDEF; OPQ; conv_phase(lds, P_CU, P_CY, P_PV + PV_WDW, P_PV + PV_BDW, P_PV + PV_LNG, P_PV + PV_LNB, vcu, G, t_, l_, w_); } SEAM(14);
    if (IN(15)) { WSDEF; RUN_GEMM(EPI_RESID_BIAS, P_CY, P_WB + W_P2, D, D, P_OUT, P_XB, P_PV + PV_BP2, P_SSB + (size_t)5 * T, P_XB); } SEAM(15);
    MLP_LAYER(2, 16);
    MLA_LAYER(1, 3, 18);
    MLP_LAYER(3, 23);
#undef IN
#undef SEAM
}

extern "C" void kernel_launch(void* const* d_in, const int* in_sizes, int n_in, void* d_out, int out_size, void* d_ws, size_t ws_size, hipStream_t stream) {
    static int grid = 0;
    if (grid == 0) {
        if (n_in != 26 || in_sizes[0] != T * D || out_size != T * D || ws_size < WS_END) { fprintf(stderr, "kernel_launch: unexpected shapes (n_in %d, in0 %d, out %d, ws %zu)\n", n_in, n_in > 0 ? in_sizes[0] : -1, out_size, ws_size); grid = -1; return; }
        int dev = 0, cus = 0, per_cu = 0;
        if (hipGetDevice(&dev) != hipSuccess || hipDeviceGetAttribute(&cus, hipDeviceAttributeMultiprocessorCount, dev) != hipSuccess) { grid = -1; return; }
        if (hipFuncSetAttribute((const void*)mk_fwd, hipFuncAttributeMaxDynamicSharedMemorySize, LDS_BYTES) != hipSuccess) { fprintf(stderr, "kernel_launch: hipFuncSetAttribute failed\n"); grid = -1; return; }
        if (hipOccupancyMaxActiveBlocksPerMultiprocessor(&per_cu, (const void*)mk_fwd, NWAVES * 64, LDS_BYTES) != hipSuccess || per_cu < 1) { fprintf(stderr, "kernel_launch: occupancy query says %d\n", per_cu); }
        (void)hipGetLastError();
        grid = cus;
    }
    if (grid < 0) return;
    if (hipMemsetAsync((char*)d_ws + WS_CTL, 0, CTL_ZERO_BYTES, stream) != hipSuccess) return;
    Args a{};
    for (int i = 0; i < 26; ++i) a.in[i] = (const float*)d_in[i];
    a.out = (float*)d_out; a.ws = (unsigned char*)d_ws; a.pad = (REP_PHASE == 9) ? 2 : 0;
#if MK_PER_PHASE
    for (int p = 0; p < NPHASE; ++p) { a.ph_lo = p; a.ph_hi = p + 1; a.li = p; hipLaunchKernelGGL(mk_fwd, dim3(grid), dim3(NWAVES * 64), LDS_BYTES, stream, a); }
#else
    a.ph_lo = 0; a.ph_hi = NPHASE; a.li = 0;
    hipLaunchKernelGGL(mk_fwd, dim3(grid), dim3(NWAVES * 64), LDS_BYTES, stream, a);
#endif
}
```

```cpp
#include <hip/hip_runtime.h>
#include <cstdio>
#include <cstdint>
#include <cmath>
__device__ __forceinline__ int mk_lane() { int l; asm volatile("v_mbcnt_lo_u32_b32 %0, -1, 0\n\tv_mbcnt_hi_u32_b32 %0, -1, %0" : "=v"(l)); return l; }
namespace pg8 {
#define PG8_LAS __attribute__((address_space(3)))
typedef unsigned short bf16_t;
typedef short bf16x8 __attribute__((ext_vector_type(8)));
typedef float f32x4 __attribute__((ext_vector_type(4)));
typedef unsigned u32x4 __attribute__((ext_vector_type(4)));
constexpr int BM = 256, BK = 64, HALF = 128, HTB = HALF * BK * 2  , STAGE_BYTES = 8 * HTB, NXCD = 8, WGM = 8;

__host__ __device__ __forceinline__ int lds_byte(int r, int c) { const int st = (r >> 4) * 2 + (c >> 5), rr = r & 15, cc = c & 31, ob = rr * 64 + cc * 2; return st * 1024 + (ob ^ (((ob >> 9) & 1) << 5)); }
__host__ __device__ __forceinline__ void stage_rc(int b, int& R, int& C) { const int st = b / 1024, sb = b % 1024, swz = sb ^ (((sb >> 9) & 1) << 5); R = (st >> 1) * 16 + swz / 64; C = (st & 1) * 32 + (swz % 64) / 2; }
__host__ __device__ __forceinline__ int perm32(int rho) { const int n = rho >> 4, i = rho & 15; return 8 * (i >> 2) + 4 * n + (i & 3); }

struct Unit { int pm, pn; };
struct Gemm { const bf16_t* A; const bf16_t* Bt; int M, N, K; };

struct StaticOrder {
    int nM, nN, nwg, G, c, rev;
    __host__ __device__ void init(int M, int N, int G_, int c_, int rev_ = 0) { nM = M / BM; nN = N / BM; nwg = nM * nN; G = G_; c = c_; rev = rev_; }
    __host__ __device__ bool next(int i, Unit& u) const {
        const long L = (long)i * G + c; if (L >= nwg) return false;
        int wgid = (int)L; { const int q = nwg / NXCD, r = nwg % NXCD, xcd = wgid % NXCD, off = wgid / NXCD; wgid = (xcd < r ? xcd * (q + 1) : r * (q + 1) + (xcd - r) * q) + off; }
        const int nig = WGM * nN, gid = wgid / nig, fm = gid * WGM, gsz = (nM - fm) < WGM ? (nM - fm) : WGM;
        u.pm = fm + ((wgid % nig) % gsz); u.pn = (wgid % nig) / gsz; if (rev == 1) u.pm = nM - 1 - u.pm; if (rev == 2) u.pm = u.pm & 7; return true;
    }
    __device__ __forceinline__ void a_ready(const Unit&) const {}
    __device__ __forceinline__ void done(const Unit&) const {}
};
__device__ __forceinline__ unsigned cvt_pk_bf16(float lo, float hi) { unsigned r; asm volatile("v_cvt_pk_bf16_f32 %0, %1, %2" : "=v"(r) : "v"(lo), "v"(hi)); return r; }
constexpr float RMS_EPS = 1e-6f;
typedef unsigned long long ssq_t;
constexpr float SS_SCALE = 1048576.0f, SS_INV = 1.0f / 1048576.0f;
__device__ __forceinline__ float row_rstd(const ssq_t* ss, int row, float inv_n) { return rsqrtf((float)ss[row] * (inv_n * SS_INV) + RMS_EPS); }
__device__ __forceinline__ void row_rstd8(float (&rs)[2][4], const ssq_t* ss, int row0, float inv_n) {
    ssq_t v[2][4];
#pragma unroll
    for (int ai = 0; ai < 2; ++ai)
#pragma unroll
        for (int m = 0; m < 4; ++m) v[ai][m] = ss[row0 + ai * HALF + m * 16];
#pragma unroll
    for (int ai = 0; ai < 2; ++ai)
#pragma unroll
        for (int m = 0; m < 4; ++m) rs[ai][m] = rsqrtf((float)v[ai][m] * (inv_n * SS_INV) + RMS_EPS);
}
__device__ __forceinline__ void ss_add(ssq_t* p, float v) { (void)__hip_atomic_fetch_add(p, (ssq_t)(v * SS_SCALE + 0.5f), __ATOMIC_RELAXED, __HIP_MEMORY_SCOPE_AGENT); }
__device__ __forceinline__ float sigm(float x) { return __builtin_amdgcn_rcpf(1.0f + __expf(-x)); }
__device__ __forceinline__ u32x4 pack8v(f32x4 a, f32x4 b) { u32x4 w; w.x = cvt_pk_bf16(a[0], a[1]); w.y = cvt_pk_bf16(a[2], a[3]); w.z = cvt_pk_bf16(b[0], b[1]); w.w = cvt_pk_bf16(b[2], b[3]); return w; }
__device__ __forceinline__ float dot4(f32x4 a) { return (a[0] * a[0] + a[1] * a[1]) + (a[2] * a[2] + a[3] * a[3]); }
__device__ __forceinline__ float quad_sum(float s) { s += __shfl_xor(s, 16); s += __shfl_xor(s, 32); return s; }

template <int ACT, bool NOSTORE = false, bool TILEDOUT = false> struct EpiRow {
    static constexpr bool PERM = true, AFTER_DRAIN = false;
    bf16_t* O; int ldc; const ssq_t* ss; float inv_n;
    __device__ __forceinline__ void operator()(const f32x4 (&acc)[2][2][4][2], const Unit& u, int wr, int wc, int fr, int fq) const {
        { const int ln_ = mk_lane(); fr = ln_ & 15; fq = ln_ >> 4; }
        const int row0 = u.pm * BM + wr * 64 + fr, col0 = u.pn * BM + wc * 32 + 8 * fq;
        float rsv[2][4]; row_rstd8(rsv, ss, row0, inv_n);
        int never = 0; asm volatile("" : "+s"(never));
#pragma unroll
        for (int ai = 0; ai < 2; ++ai)
#pragma unroll
            for (int m = 0; m < 4; ++m) {
                const int row = row0 + ai * HALF + m * 16;
                const float rs = rsv[ai][m];
                bf16_t* rowp = TILEDOUT ? O + ((size_t)u.pm * (ldc / 64) + (size_t)(u.pn * 4 + (wc >> 1))) * (BM * 64) + (size_t)(row & 255) * 64 + (wc & 1) * 32 + 8 * fq - (TILEDOUT ? 0 : 0)
                                        : O + (size_t)row * ldc + col0;
#pragma unroll
                for (int bj = 0; bj < 2; ++bj) {
                    f32x4 v0 = acc[ai][bj][m][0] * rs, v1 = acc[ai][bj][m][1] * rs;
                    if (ACT == 1) {
#pragma unroll
                        for (int e = 0; e < 4; ++e) { const float a = fmaxf(v0[e], 0.f), b = fmaxf(v1[e], 0.f); v0[e] = a * a; v1[e] = b * b; }
                    }
                    if (!NOSTORE || never) *(u32x4*)(rowp + (TILEDOUT ? bj * 2 * (BM * 64) : bj * HALF)) = pack8v(v0, v1);
                }
            }
    }
};

__device__ __forceinline__ void unpack8(u32x4 w, f32x4& a, f32x4& b) {
    a = (f32x4){__builtin_bit_cast(float, w.x << 16), __builtin_bit_cast(float, w.x & 0xffff0000u), __builtin_bit_cast(float, w.y << 16), __builtin_bit_cast(float, w.y & 0xffff0000u)};
    b = (f32x4){__builtin_bit_cast(float, w.z << 16), __builtin_bit_cast(float, w.z & 0xffff0000u), __builtin_bit_cast(float, w.w << 16), __builtin_bit_cast(float, w.w & 0xffff0000u)};
}
template <bool LAST, bool HAS_BIAS = false> struct EpiResid {
    static constexpr bool PERM = true, AFTER_DRAIN = false;
    float* xout; bf16_t* xb; const float* bias; ssq_t* ssn; bf16_t* xbw;
    __device__ __forceinline__ void operator()(const f32x4 (&acc)[2][2][4][2], const Unit& u, int wr, int wc, int fr, int fq) const {
        { const int ln_ = mk_lane(); fr = ln_ & 15; fq = ln_ >> 4; }
        const int row0 = u.pm * BM + wr * 64 + fr, col0 = u.pn * BM + wc * 32 + 8 * fq;
        f32x4 (&accw)[2][2][4][2] = const_cast<f32x4 (&)[2][2][4][2]>(acc);
        if (HAS_BIAS) {
#pragma unroll
            for (int bj = 0; bj < 2; ++bj)
#pragma unroll
                for (int n = 0; n < 2; ++n) { const f32x4 bvv = *(const f32x4*)(bias + col0 + bj * HALF + 4 * n);
#pragma unroll
                    for (int ai = 0; ai < 2; ++ai)
#pragma unroll
                        for (int m = 0; m < 4; ++m) accw[ai][bj][m][n] += bvv; }
        }
        constexpr int NB_ = HAS_BIAS ? 2 : 1, AI_ = HAS_BIAS ? 1 : 2;
#pragma unroll
        for (int hb = 0; hb < NB_; ++hb) {
            u32x4 xr[AI_][4][2];
#pragma unroll
            for (int a2 = 0; a2 < AI_; ++a2)
#pragma unroll
                for (int m = 0; m < 4; ++m)
#pragma unroll
                    for (int bj = 0; bj < 2; ++bj) xr[a2][m][bj] = *(const u32x4*)(xb + (size_t)(row0 + (hb * AI_ + a2) * HALF + m * 16) * 1024 + col0 + bj * HALF);
#pragma unroll
            for (int a2 = 0; a2 < AI_; ++a2)
#pragma unroll
                for (int m = 0; m < 4; ++m) {
                    const int ai = hb * AI_ + a2;
                    const int row = row0 + ai * HALF + m * 16;
                    const size_t off = (size_t)row * 1024 + col0;
                    float sq = 0.f;
#pragma unroll
                    for (int bj = 0; bj < 2; ++bj) {
                        f32x4 x0, x1; unpack8(xr[a2][m][bj], x0, x1);
                        const f32x4 v0 = accw[ai][bj][m][0] + x0, v1 = accw[ai][bj][m][1] + x1;
                        if (LAST) { *(f32x4*)(xout + off + bj * HALF) = v0; *(f32x4*)(xout + off + bj * HALF + 4) = v1; }
                        else { const u32x4 w = pack8v(v0, v1); *(u32x4*)(xbw + off + bj * HALF) = w; f32x4 r0, r1; unpack8(w, r0, r1); sq += dot4(r0) + dot4(r1); }
                    }
                    if (!LAST) { sq = quad_sum(sq); if (fq == 0) ss_add(ssn + row, sq); }
                }
        }
    }
};

struct EpiDown {
    static constexpr bool PERM = true, AFTER_DRAIN = false;
    const ssq_t* ss; bf16_t* cq; bf16_t* ckv; bf16_t* kr; ssq_t* sscq; ssq_t* ssckv;
    __device__ __forceinline__ void operator()(const f32x4 (&acc)[2][2][4][2], const Unit& u, int wr, int wc, int fr, int fq) const {
        { const int ln_ = mk_lane(); fr = ln_ & 15; fq = ln_ >> 4; }
        const int row0 = u.pm * BM + wr * 64 + fr, cw = wc * 32 + 8 * fq;
        float rsv[2][4]; row_rstd8(rsv, ss, row0, 1.0f / 1024.0f);
#pragma unroll
        for (int ai = 0; ai < 2; ++ai)
#pragma unroll
            for (int m = 0; m < 4; ++m) {
                const int row = row0 + ai * HALF + m * 16;
                const float rs = rsv[ai][m];
                float sq_q = 0.f, sq_kv = 0.f;
#pragma unroll
                for (int bj = 0; bj < 2; ++bj) {
                    const int seg = u.pn * 2 + bj;
                    const f32x4 v0 = acc[ai][bj][m][0] * rs, v1 = acc[ai][bj][m][1] * rs;
                    const u32x4 w = pack8v(v0, v1);
                    if (seg < 3) { *(u32x4*)(cq + (size_t)row * 384 + seg * 128 + cw) = w; sq_q += dot4(v0) + dot4(v1); }
                    else if (seg < 5) { *(u32x4*)(ckv + (size_t)row * 256 + (seg - 3) * 128 + cw) = w; sq_kv += dot4(v0) + dot4(v1); }
                    else if (wc < 2) { *(u32x4*)(kr + (size_t)row * 64 + cw) = w; }
                }
                sq_q = quad_sum(sq_q); sq_kv = quad_sum(sq_kv);
                if (fq == 0) { if (u.pn <= 1) ss_add(sscq + row, sq_q); if (u.pn >= 1) ss_add(ssckv + row, sq_kv); }
            }
    }
};

struct EpiUQ {
    static constexpr bool PERM = true, AFTER_DRAIN = false;
    const ssq_t* ss; bf16_t* Q;
    __device__ __forceinline__ void operator()(const f32x4 (&acc)[2][2][4][2], const Unit& u, int wr, int wc, int fr, int fq) const {
        { const int ln_ = mk_lane(); fr = ln_ & 15; fq = ln_ >> 4; }
        const int row0 = u.pm * BM + wr * 64 + fr, col0 = u.pn * BM + wc * 32 + 8 * fq;
        float rsv[2][4]; row_rstd8(rsv, ss, row0, 1.0f / 384.0f);
        int hoff[2];
#pragma unroll
        for (int bj = 0; bj < 2; ++bj) { const int col = col0 + bj * HALF, h = col / 192; hoff[bj] = h * (2048 * 192) + (col - h * 192); }
        const int bq = row0 >> 11;
        bf16_t* base = Q + (size_t)bq * (8 * 2048 * 192) + (size_t)(row0 & 2047) * 192;
#pragma unroll
        for (int ai = 0; ai < 2; ++ai)
#pragma unroll
            for (int m = 0; m < 4; ++m) {
                const float rs = rsv[ai][m];
#pragma unroll
                for (int bj = 0; bj < 2; ++bj) {
                    const f32x4 v0 = acc[ai][bj][m][0] * rs, v1 = acc[ai][bj][m][1] * rs;
                    *(u32x4*)(base + (ai * HALF + m * 16) * 192 + hoff[bj]) = pack8v(v0, v1);
                }
            }
    }
};

struct EpiUKV {
    static constexpr bool PERM = true, AFTER_DRAIN = false;
    const ssq_t* ss; bf16_t* Kn; bf16_t* V; const float* gk; PG8_LAS float* X;
    __device__ __forceinline__ void operator()(const f32x4 (&acc)[2][2][4][2], const Unit& u, int wr, int wc, int fr, int fq) const {
        { const int ln_ = mk_lane(); fr = ln_ & 15; fq = ln_ >> 4; }
        const int row0 = u.pm * BM + wr * 64 + fr, cw = wc * 32 + 8 * fq, h = u.pn;
        float rsv[2][4]; row_rstd8(rsv, ss, row0, 1.0f / 256.0f);
        const f32x4 g0 = *(const f32x4*)(gk + cw), g1 = *(const f32x4*)(gk + cw + 4);
        const size_t off0 = ((size_t)(((row0 >> 11) * 8 + h) * 2048 + (row0 & 2047))) * 128 + cw;
#pragma unroll
        for (int ai = 0; ai < 2; ++ai)
#pragma unroll
            for (int m = 0; m < 4; ++m) {
                const float rs = rsv[ai][m];
                const f32x4 a0 = acc[ai][0][m][0] * rs, a1 = acc[ai][0][m][1] * rs;
                const float s = quad_sum(dot4(a0) + dot4(a1));
                if (fq == 0) X[(ai * HALF + wr * 64 + m * 16 + fr) * 4 + wc] = s;
                const size_t off = off0 + (size_t)(ai * HALF + m * 16) * 128;
                { const f32x4 v0 = acc[ai][1][m][0] * rs, v1 = acc[ai][1][m][1] * rs; *(u32x4*)(V + off) = pack8v(v0, v1); }
            }
        asm volatile("s_waitcnt lgkmcnt(0)" ::: "memory"); __builtin_amdgcn_s_barrier(); asm volatile("" ::: "memory");
#pragma unroll
        for (int ai = 0; ai < 2; ++ai)
#pragma unroll
            for (int m = 0; m < 4; ++m) {
                const f32x4 p = *(const PG8_LAS f32x4*)(X + (ai * HALF + wr * 64 + m * 16 + fr) * 4);
                const float rk = rsqrtf(((p[0] + p[1]) + (p[2] + p[3])) * (1.0f / 128.0f) + RMS_EPS) * rsv[ai][m];
                const size_t off = off0 + (size_t)(ai * HALF + m * 16) * 128;
                const f32x4 v0 = acc[ai][0][m][0] * rk * g0, v1 = acc[ai][0][m][1] * rk * g1;
                *(u32x4*)(Kn + off) = pack8v(v0, v1);
            }
    }
};

struct EpiHG {
    static constexpr bool PERM = true, AFTER_DRAIN = false;
    const ssq_t* ss; const float* lb; bf16_t* hq; float* hlf; size_t sec_stride;
    __device__ __forceinline__ void operator()(const f32x4 (&acc)[2][2][4][2], const Unit& u, int wr, int wc, int fr, int fq) const {
        { const int ln_ = mk_lane(); fr = ln_ & 15; fq = ln_ >> 4; }
        const int row0 = u.pm * BM + wr * 64 + fr, sec = u.pn >> 2, cc0 = (u.pn & 3) * BM + wc * 32 + 8 * fq;
        float rsv[2][4]; row_rstd8(rsv, ss, row0, 1.0f / 1024.0f);
        if (sec == 1) {
            f32x4 lbv[2][2];
#pragma unroll
            for (int bj = 0; bj < 2; ++bj)
#pragma unroll
                for (int n = 0; n < 2; ++n) lbv[bj][n] = *(const f32x4*)(lb + cc0 + bj * HALF + 4 * n);
#pragma unroll
            for (int ai = 0; ai < 2; ++ai)
#pragma unroll
                for (int m = 0; m < 4; ++m) {
                    const int row = row0 + ai * HALF + m * 16;
                    const float rs = rsv[ai][m];
#pragma unroll
                    for (int bj = 0; bj < 2; ++bj)
#pragma unroll
                        for (int n = 0; n < 2; ++n) {
                            const f32x4 v = acc[ai][bj][m][n] * rs; f32x4 o;
#pragma unroll
                            for (int e = 0; e < 4; ++e) { const float l = lbv[bj][n][e]; o[e] = __logf(l + (1.0f - l) * sigm(v[e])); }
                            *(f32x4*)(hlf + (size_t)row * 1024 + cc0 + bj * HALF + 4 * n) = o;
                        }
                }
        } else {
            bf16_t* dst = hq + (size_t)((sec + 1) >> 1) * sec_stride;
#pragma unroll
            for (int ai = 0; ai < 2; ++ai)
#pragma unroll
                for (int m = 0; m < 4; ++m) {
                    const int row = row0 + ai * HALF + m * 16;
                    const float rs = rsv[ai][m];
#pragma unroll
                    for (int bj = 0; bj < 2; ++bj) {
                        f32x4 v0 = acc[ai][bj][m][0] * rs, v1 = acc[ai][bj][m][1] * rs;
                        if (sec == 3) {
#pragma unroll
                            for (int e = 0; e < 4; ++e) { v0[e] = v0[e] * sigm(v0[e]); v1[e] = v1[e] * sigm(v1[e]); }
                        }
                        *(u32x4*)(dst + (size_t)row * 1024 + cc0 + bj * HALF) = pack8v(v0, v1);
                    }
                }
        }
    }
};

struct EpiGLU {
    static constexpr bool PERM = true, AFTER_DRAIN = false;
    const ssq_t* ss; const float* bias; bf16_t* cu;
    __device__ __forceinline__ void operator()(const f32x4 (&acc)[2][2][4][2], const Unit& u, int wr, int wc, int fr, int fq) const {
        { const int ln_ = mk_lane(); fr = ln_ & 15; fq = ln_ >> 4; }
        const int row0 = u.pm * BM + wr * 64 + fr, j0 = u.pn * HALF + wc * 32 + 8 * fq;
        const f32x4 ba0 = *(const f32x4*)(bias + j0), ba1 = *(const f32x4*)(bias + j0 + 4), bg0 = *(const f32x4*)(bias + 1024 + j0), bg1 = *(const f32x4*)(bias + 1024 + j0 + 4);
        float rsv[2][4]; row_rstd8(rsv, ss, row0, 1.0f / 1024.0f);
#pragma unroll
        for (int ai = 0; ai < 2; ++ai)
#pragma unroll
            for (int m = 0; m < 4; ++m) {
                const int row = row0 + ai * HALF + m * 16;
                const float rs = rsv[ai][m];
                f32x4 a0 = acc[ai][0][m][0] * rs + ba0, a1 = acc[ai][0][m][1] * rs + ba1;
                const f32x4 g0 = acc[ai][1][m][0] * rs + bg0, g1 = acc[ai][1][m][1] * rs + bg1;
#pragma unroll
                for (int e = 0; e < 4; ++e) { a0[e] *= sigm(g0[e]); a1[e] *= sigm(g1[e]); }
                *(u32x4*)(cu + (size_t)row * 1024 + j0) = pack8v(a0, a1);
            }
    }
};
template <class Epi, class Sched, bool ALIGN_EPI = false, bool SP2 = false, bool TILED = false, bool TILEDB = TILED>
__device__ __forceinline__ void gemm_phase(PG8_LAS unsigned char* lds, const Gemm g, const Sched& S, const Epi& E, int wave_s, int stagger_ticks = 0) {
    int tid_ = wave_s * 64 + mk_lane(); asm volatile("" : "+v"(tid_));
    const int tid = tid_, wid = __builtin_amdgcn_readfirstlane(tid >> 6), lane = tid & 63, wr = wid >> 2, wc = wid & 3, fr = lane & 15, fq = lane >> 4;
    const int K = g.K, nt = K / BK;
    unsigned voffA[2], voffB[2];
#pragma unroll
    for (int i = 0; i < 2; ++i) { int R, C; stage_rc(tid * 16 + i * 8192, R, C); const int Rb = Epi::PERM ? ((R & ~31) + perm32(R & 31)) : R;
        voffA[i] = (unsigned)(R * (TILED ? BK : K) + C) * 2u; voffB[i] = (unsigned)(Rb * (TILEDB ? BK : K) + C) * 2u; }
    const size_t kstep = TILED ? (size_t)(BM * BK * 2) : (size_t)(BK * 2), kstepB = TILEDB ? (size_t)(BM * BK * 2) : (size_t)(BK * 2);
    const size_t hstep = TILED ? (size_t)(HALF * BK * 2) : (size_t)HALF * K * 2, hstepB = TILEDB ? (size_t)(HALF * BK * 2) : (size_t)HALF * K * 2;
    const size_t tstep = (size_t)BM * K * 2;
    const unsigned ldsw = (unsigned)wid * 1024u;
    const int aoff = lds_byte(wr * 64 + fr, fq * 8), boff = lds_byte(wc * 32 + fr, fq * 8);
#define PG8_SA(b, h) (((b) * 2 + (h)) * HTB)
#define PG8_SB(b, h) ((4 + (b) * 2 + (h)) * HTB)
#define PG8_STAGE(bufoff, gbase, voff) do { _Pragma("unroll") for (int _i = 0; _i < 2; ++_i) \
        __builtin_amdgcn_global_load_lds((const unsigned*)((const char*)(gbase) + (voff)[_i]), (PG8_LAS unsigned*)(lds + (bufoff) + ldsw + _i * 8192), 16, 0, 0); } while (0)
#define PG8_LDA(dst, b, h) do { _Pragma("unroll") for (int m = 0; m < 4; ++m) _Pragma("unroll") for (int k = 0; k < 2; ++k) dst[m][k] = *(const PG8_LAS bf16x8*)(lds + PG8_SA(b, h) + aoff + m * 2048 + k * 1024); } while (0)
#define PG8_LDB(dst, b, h) do { _Pragma("unroll") for (int n = 0; n < 2; ++n) _Pragma("unroll") for (int k = 0; k < 2; ++k) dst[n][k] = *(const PG8_LAS bf16x8*)(lds + PG8_SB(b, h) + boff + n * 2048 + k * 1024); } while (0)
#define PG8_MMA(ai, bj, At, Bt) do { __builtin_amdgcn_s_setprio(1); _Pragma("unroll") for (int m = 0; m < 4; ++m) _Pragma("unroll") for (int n = 0; n < 2; ++n) _Pragma("unroll") for (int k = 0; k < 2; ++k) \
        acc[ai][bj][m][n] = __builtin_amdgcn_mfma_f32_16x16x32_bf16(Bt[n][k], At[m][k], acc[ai][bj][m][n], 0, 0, 0); __builtin_amdgcn_s_setprio(0); } while (0)
#define PG8_WAIT_V(n) asm volatile("s_waitcnt vmcnt(" #n ")" ::: "memory")
#define PG8_WAIT_L(n) asm volatile("s_waitcnt lgkmcnt(" #n ")" ::: "memory")
#define PG8_BAR __builtin_amdgcn_s_barrier()
#define PG8_SCHED __builtin_amdgcn_sched_barrier(0)
    Unit cur, nxt; int ui = 0;
    if (!S.next(0, cur)) return;
    if (stagger_ticks > 0) { const unsigned long long t0_ = __builtin_amdgcn_s_memrealtime(); while (__builtin_amdgcn_s_memrealtime() - t0_ < (unsigned long long)stagger_ticks) __builtin_amdgcn_s_sleep(8); }
    f32x4 acc[2][2][4][2];
#pragma unroll
    for (int a = 0; a < 2; ++a)
#pragma unroll
        for (int b = 0; b < 2; ++b)
#pragma unroll
            for (int m = 0; m < 4; ++m)
#pragma unroll
                for (int n = 0; n < 2; ++n) acc[a][b][m][n] = (f32x4){0.f, 0.f, 0.f, 0.f};
    bf16x8 At[4][2], B0[2][2], B1[2][2];
    const char* cA = (const char*)g.A + (size_t)cur.pm * tstep; const char* cB = (const char*)g.Bt + (size_t)cur.pn * tstep;
    S.a_ready(cur);
    if constexpr (SP2) {
        PG8_STAGE(PG8_SB(0, 0), cB, voffB); PG8_STAGE(PG8_SB(0, 1), cB + hstepB, voffB); PG8_STAGE(PG8_SA(0, 0), cA, voffA); PG8_STAGE(PG8_SA(0, 1), cA + hstep, voffA);
        if (wr == 1) PG8_BAR;
        PG8_WAIT_V(2); PG8_BAR;
        PG8_STAGE(PG8_SB(1, 0), cB + kstepB, voffB); PG8_STAGE(PG8_SA(1, 0), cA + kstep, voffA); PG8_STAGE(PG8_SB(1, 1), cB + hstepB + kstepB, voffB);
        PG8_WAIT_V(6); PG8_BAR;
    } else {
        PG8_STAGE(PG8_SB(0, 0), cB, voffB); PG8_STAGE(PG8_SA(0, 0), cA, voffA); PG8_STAGE(PG8_SB(0, 1), cB + hstepB, voffB); PG8_STAGE(PG8_SA(0, 1), cA + hstep, voffA);
        if (wr == 1) PG8_BAR;
        PG8_WAIT_V(4); PG8_BAR;
        PG8_STAGE(PG8_SB(1, 0), cB + kstepB, voffB); PG8_STAGE(PG8_SA(1, 0), cA + kstep, voffA); PG8_STAGE(PG8_SB(1, 1), cB + hstepB + kstepB, voffB);
        PG8_WAIT_V(6); PG8_BAR;
    }
    for (;;) {
        const bool has_next = S.next(ui + 1, nxt);
        const char* nA = has_next ? (const char*)g.A + (size_t)nxt.pm * tstep : cA; const char* nB = has_next ? (const char*)g.Bt + (size_t)nxt.pn * tstep : cB;
#pragma unroll 1
        for (int t = 0; t < nt; t += 2) {
            const bool last = (t == nt - 2);
            const char* a1 = cA + (size_t)(t + 1) * kstep;
            const char* a2 = last ? nA : cA + (size_t)(t + 2) * kstep; const char* b2 = last ? nB : cB + (size_t)(t + 2) * kstepB;
            const char* a3 = a2 + kstep; const char* b3 = b2 + kstepB;
            if (last && has_next) S.a_ready(nxt);
            if constexpr (SP2) {
            PG8_LDB(B0, 0, 0); PG8_LDB(B1, 0, 1); PG8_SCHED; PG8_LDA(At, 0, 0); PG8_STAGE(PG8_SA(1, 1), a1 + hstep, voffA);
            PG8_WAIT_V(8); PG8_WAIT_L(0); PG8_BAR; PG8_MMA(0, 0, At, B0); PG8_MMA(0, 1, At, B1); PG8_BAR; PG8_SCHED;
            PG8_LDA(At, 0, 1); PG8_STAGE(PG8_SB(0, 0), b2, voffB); PG8_STAGE(PG8_SB(0, 1), b2 + hstepB, voffB); PG8_STAGE(PG8_SA(0, 0), a2, voffA);
            PG8_WAIT_V(8); PG8_WAIT_L(0); PG8_BAR; PG8_MMA(1, 0, At, B0); PG8_MMA(1, 1, At, B1); PG8_BAR; PG8_SCHED;
            PG8_LDB(B0, 1, 0); PG8_LDB(B1, 1, 1); PG8_SCHED; PG8_LDA(At, 1, 0); PG8_STAGE(PG8_SA(0, 1), a2 + hstep, voffA);
            PG8_WAIT_V(8); PG8_WAIT_L(0); PG8_BAR; PG8_MMA(0, 0, At, B0); PG8_MMA(0, 1, At, B1); PG8_BAR; PG8_SCHED;
            PG8_LDA(At, 1, 1); PG8_STAGE(PG8_SB(1, 0), b3, voffB); PG8_STAGE(PG8_SB(1, 1), b3 + hstepB, voffB); PG8_STAGE(PG8_SA(1, 0), a3, voffA);
            PG8_WAIT_V(8); PG8_WAIT_L(0); PG8_BAR; PG8_MMA(1, 0, At, B0); PG8_MMA(1, 1, At, B1); PG8_BAR; PG8_SCHED;
            } else {
            PG8_LDB(B0, 0, 0); PG8_SCHED; PG8_LDA(At, 0, 0); PG8_STAGE(PG8_SA(1, 1), a1 + hstep, voffA);
            PG8_WAIT_L(8); PG8_BAR; PG8_WAIT_L(0); PG8_MMA(0, 0, At, B0); PG8_BAR; PG8_SCHED;
            PG8_LDB(B1, 0, 1); PG8_STAGE(PG8_SB(0, 0), b2, voffB);
            PG8_BAR; PG8_WAIT_L(0); PG8_MMA(0, 1, At, B1); PG8_BAR;
            PG8_LDA(At, 0, 1); PG8_STAGE(PG8_SA(0, 0), a2, voffA);
            PG8_BAR; PG8_WAIT_L(0); PG8_MMA(1, 0, At, B0); PG8_BAR; PG8_SCHED;
            PG8_STAGE(PG8_SB(0, 1), b2 + hstepB, voffB);
            PG8_WAIT_V(6); PG8_BAR; PG8_MMA(1, 1, At, B1); PG8_BAR;
            PG8_LDB(B0, 1, 0); PG8_SCHED; PG8_LDA(At, 1, 0); PG8_STAGE(PG8_SA(0, 1), a2 + hstep, voffA);
            PG8_WAIT_L(8); PG8_BAR; PG8_WAIT_L(0); PG8_MMA(0, 0, At, B0); PG8_BAR; PG8_SCHED;
            PG8_LDB(B1, 1, 1); PG8_STAGE(PG8_SB(1, 0), b3, voffB);
            PG8_BAR; PG8_WAIT_L(0); PG8_MMA(0, 1, At, B1); PG8_BAR;
            PG8_LDA(At, 1, 1); PG8_STAGE(PG8_SA(1, 0), a3, voffA);
            PG8_BAR; PG8_WAIT_L(0); PG8_MMA(1, 0, At, B0); PG8_BAR; PG8_SCHED;
            PG8_STAGE(PG8_SB(1, 1), b3 + hstepB, voffB);
            PG8_WAIT_V(6); PG8_BAR; PG8_MMA(1, 1, At, B1); PG8_BAR;
            }
        }
        if constexpr (ALIGN_EPI) { if (wr == 0) PG8_BAR; }
        if constexpr (!Epi::AFTER_DRAIN) { E(acc, cur, wr, wc, fr, fq); S.done(cur); }
        if (!has_next) break;
#pragma unroll
        for (int a = 0; a < 2; ++a)
#pragma unroll
            for (int b = 0; b < 2; ++b)
#pragma unroll
                for (int m = 0; m < 4; ++m)
#pragma unroll
                    for (int n = 0; n < 2; ++n) acc[a][b][m][n] = (f32x4){0.f, 0.f, 0.f, 0.f};
        cur = nxt; cA = nA; cB = nB; ++ui;
        if constexpr (ALIGN_EPI) { if (wr == 1) PG8_BAR; }
    }
    PG8_WAIT_V(0);
    if constexpr (!ALIGN_EPI) { if (wr == 0) PG8_BAR; }
    PG8_BAR;
    if constexpr (Epi::AFTER_DRAIN) { E.fused(acc, cur, wr, wc, fr, fq, lds, wid, lane); S.done(cur); }
#undef PG8_SA
#undef PG8_SB
#undef PG8_STAGE
#undef PG8_LDA
#undef PG8_LDB
#undef PG8_MMA
#undef PG8_WAIT_V
#undef PG8_WAIT_L
#undef PG8_BAR
#undef PG8_SCHED
}
}
namespace att {
typedef unsigned short bf16;
typedef short bf16x8 __attribute__((ext_vector_type(8)));
typedef short s16x4 __attribute__((ext_vector_type(4)));
typedef float f32x16 __attribute__((ext_vector_type(16)));
typedef float f32x4 __attribute__((ext_vector_type(4)));
typedef unsigned u32x4 __attribute__((ext_vector_type(4)));
constexpr int NW = 8, QBLK = 32, KVBLK = 64, QB = NW * QBLK;
constexpr int DN = 128, DR = 64, DQ = 192, DV = 128, SEQ = 2048, NH = 8, NB = 16, OSTR = 1024;
constexpr int SHM_V = KVBLK * DV * 2, SHM_K = KVBLK * DN * 2, RPAD = 144, SHM_R = KVBLK * RPAD;
constexpr int OFF_V = 0, OFF_K = 3 * SHM_V, OFF_R = OFF_K + 2 * SHM_K, OFF_WS = OFF_R + 2 * SHM_R, OFF_QS = OFF_WS + NW * 64 * 4, LDS_BYTES = OFF_QS + NW * 4096;
constexpr float SCALE = 0.07216878364870323f;
constexpr float THR = 8.f;
constexpr int WIN = 1 << 30;

#define KSWZ(row, colB) ((row) * 256 + ((colB) ^ (((row) & 7) << 4)))
#define SBAR() __builtin_amdgcn_sched_barrier(0)
__device__ __forceinline__ int v_st(int k, int c) { const int kk = (k & ~0xC) | ((k & 4) << 1) | ((k & 8) >> 1); return ((kk >> 3) * 4 + (c >> 5)) * 512 + ((kk & 7) * 32 + (c & 31)) * 2; }
__device__ __forceinline__ int v_rd_base(int lane) { return ((lane & 3) << 3) | (((lane >> 2) & 3) << 6) | (((lane >> 4) & 1) << 5) | (((lane >> 5) & 1) << 8); }
constexpr int v_rd_off(int d0, int ks, int half) { return d0 * 512 + ks * 4096 + half * 2048; }
__device__ __forceinline__ int crow(int r, int hi) { return (r & 3) + 8 * (r >> 2) + 4 * hi; }
__device__ __forceinline__ unsigned cvtpk(float lo, float hi) { unsigned r; asm volatile("v_cvt_pk_bf16_f32 %0, %1, %2" : "=v"(r) : "v"(lo), "v"(hi)); return r; }
__device__ __forceinline__ bf16x8 load8(const bf16* p) { return *reinterpret_cast<const bf16x8*>(p); }
__device__ __forceinline__ void mask_tile(f32x16& p0, f32x16& p1, int dq, unsigned W) {
    const float NEG = -__builtin_inff();
#pragma unroll
    for (int r = 0; r < 16; ++r) {
        const int c = (r & 3) + 8 * (r >> 2);
        if ((unsigned)(dq - c) >= W) p0[r] = NEG;
        if ((unsigned)(dq - c - 32) >= W) p1[r] = NEG;
    }
}
__device__ __forceinline__ void partialSM(f32x16& p0, f32x16& p1, float& m_reg, float& mn, float& alpha) {
    float pmax = p0[0]; for (int r = 1; r < 16; ++r) pmax = fmaxf(pmax, p0[r]); for (int r = 0; r < 16; ++r) pmax = fmaxf(pmax, p1[r]);
    { auto rr = __builtin_amdgcn_permlane32_swap(__float_as_uint(pmax), __float_as_uint(pmax), false, false);
      pmax = fmaxf(__uint_as_float(rr[0]), __uint_as_float(rr[1])); }
    constexpr float C2 = 1.4426950408889634f * SCALE;
    if (__builtin_expect(__all((pmax - m_reg) * SCALE <= THR), 1)) { mn = m_reg; alpha = 1.f; }
    else { mn = fmaxf(m_reg, pmax); alpha = __builtin_amdgcn_exp2f((m_reg - mn) * C2); m_reg = mn; }
    const float mnL = -mn * C2;
    for (int r = 0; r < 16; ++r) p0[r] = fmaf(p0[r], C2, mnL); for (int r = 0; r < 16; ++r) p1[r] = fmaf(p1[r], C2, mnL);
    for (int r = 0; r < 16; ++r) p0[r] = __builtin_amdgcn_exp2f(p0[r]);
}
__device__ __forceinline__ void finishSM(f32x16& p0, f32x16& p1, float alpha, float& l_reg, bf16x8& pa0, bf16x8& pa1, bf16x8& pa2, bf16x8& pa3) {
    for (int r = 0; r < 16; ++r) p1[r] = __builtin_amdgcn_exp2f(p1[r]);
    float ps = 0; for (int r = 0; r < 16; ++r) ps += p0[r]; for (int r = 0; r < 16; ++r) ps += p1[r];
    { auto rr = __builtin_amdgcn_permlane32_swap(__float_as_uint(ps), __float_as_uint(ps), false, false);
      ps = __uint_as_float(rr[0]) + __uint_as_float(rr[1]); }
    l_reg = l_reg * alpha + ps;
#define PK4(P, B_, OUT) do { unsigned a0 = cvtpk(P[B_+0], P[B_+1]), a1 = cvtpk(P[B_+2], P[B_+3]);                          \
        unsigned b0 = cvtpk(P[B_+4], P[B_+5]), b1 = cvtpk(P[B_+6], P[B_+7]);                                             \
        auto r0 = __builtin_amdgcn_permlane32_swap(a0, b0, false, false); auto r1 = __builtin_amdgcn_permlane32_swap(a1, b1, false, false); \
        u32x4 w = {r0[0], r1[0], r0[1], r1[1]}; OUT = *reinterpret_cast<bf16x8*>(&w); } while (0)
    PK4(p0, 0, pa0); PK4(p0, 8, pa1); PK4(p1, 0, pa2); PK4(p1, 8, pa3);
#undef PK4
}
template <int KB>
__device__ __forceinline__ void qkt(f32x16& p0, f32x16& p1, const char* K_lds, const char* R_lds, int r32, int hi, const bf16x8* qr, const char* qsp) {
    p0 = f32x16{}; p1 = f32x16{};
    const char* kb[4];
#pragma unroll
    for (int dd = 0; dd < 4; ++dd) kb[dd] = K_lds + KB * SHM_K + KSWZ(r32, (dd * 16 + hi * 8) * 2);
#pragma unroll
    for (int d0 = 0; d0 < 8; ++d0) { const char* a = kb[d0 & 3] + (d0 >> 2) * 128;
        bf16x8 b0 = *reinterpret_cast<const bf16x8*>(a);
        bf16x8 b1 = *reinterpret_cast<const bf16x8*>(a + 32 * 256);
        p0 = __builtin_amdgcn_mfma_f32_32x32x16_bf16(b0, qr[d0], p0, 0, 0, 0);
        p1 = __builtin_amdgcn_mfma_f32_32x32x16_bf16(b1, qr[d0], p1, 0, 0, 0); }
    const char* rb = R_lds + KB * SHM_R + r32 * RPAD + hi * 16;
#pragma unroll
    for (int d0 = 0; d0 < 4; ++d0) {
        bf16x8 b0 = *reinterpret_cast<const bf16x8*>(rb + d0 * 32);
        bf16x8 b1 = *reinterpret_cast<const bf16x8*>(rb + d0 * 32 + 32 * RPAD);
        const bf16x8 qf = *reinterpret_cast<const bf16x8*>(qsp + d0 * 1024);
        p0 = __builtin_amdgcn_mfma_f32_32x32x16_bf16(b0, qf, p0, 0, 0, 0);
        p1 = __builtin_amdgcn_mfma_f32_32x32x16_bf16(b1, qf, p1, 0, 0, 0); }
}
template <int VB>
__device__ __forceinline__ void pv_tile(f32x16* o, int vb0, bf16x8 pa0, bf16x8 pa1, bf16x8 pa2, bf16x8 pa3) {
#define TRRD(dst, off) asm volatile("ds_read_b64_tr_b16 %0, %1 offset:%2" : "=&v"(dst) : "v"(vb0), "i"(off) : "memory")
#define PV_KS(ks, PA) do { s16x4 l0, l1, l2, l3, h0, h1, h2, h3; constexpr int b_ = VB * SHM_V + v_rd_off(0, ks, 0);   \
        TRRD(l0, b_); TRRD(h0, b_ + 2048); TRRD(l1, b_ + 512); TRRD(h1, b_ + 512 + 2048); TRRD(l2, b_ + 1024); TRRD(h2, b_ + 1024 + 2048); TRRD(l3, b_ + 1536); TRRD(h3, b_ + 1536 + 2048); \
        asm volatile("s_waitcnt lgkmcnt(0)" ::: "memory"); SBAR();   \
        o[0] = __builtin_amdgcn_mfma_f32_32x32x16_bf16(PA, (bf16x8){l0[0], l0[1], l0[2], l0[3], h0[0], h0[1], h0[2], h0[3]}, o[0], 0, 0, 0);   \
        o[1] = __builtin_amdgcn_mfma_f32_32x32x16_bf16(PA, (bf16x8){l1[0], l1[1], l1[2], l1[3], h1[0], h1[1], h1[2], h1[3]}, o[1], 0, 0, 0);   \
        o[2] = __builtin_amdgcn_mfma_f32_32x32x16_bf16(PA, (bf16x8){l2[0], l2[1], l2[2], l2[3], h2[0], h2[1], h2[2], h2[3]}, o[2], 0, 0, 0);   \
        o[3] = __builtin_amdgcn_mfma_f32_32x32x16_bf16(PA, (bf16x8){l3[0], l3[1], l3[2], l3[3], h3[0], h3[1], h3[2], h3[3]}, o[3], 0, 0, 0); } while (0)
    PV_KS(0, pa0); PV_KS(1, pa1); PV_KS(2, pa2); PV_KS(3, pa3);
#undef PV_KS
#undef TRRD
}

struct BlockRef { const bf16* Q; const bf16* K; const bf16* R; const bf16* V; bf16* O; int P0; int row0; };
__device__ __forceinline__ BlockRef make_ref(int L, int pass, const bf16* Q, const bf16* K, const bf16* R, const bf16* V, bf16* O) {
    const int xcd = L & 7, k = L >> 3, bh = (k >> 2) * 8 + xcd, x = k & 3, qb = pass ? 7 - x : x, b = bh >> 3, h = bh & 7;
    BlockRef r;
    r.Q = Q + ((size_t)bh * SEQ + (size_t)qb * QB) * DQ; r.K = K + (size_t)bh * SEQ * DN; r.V = V + (size_t)bh * SEQ * DV; r.R = R + (size_t)b * SEQ * DR;
    r.O = O + ((size_t)b * SEQ + (size_t)qb * QB) * OSTR + h * DV; r.P0 = qb * QB; r.row0 = b * SEQ + qb * QB;
    return r;
}
#define ROW(p, k0, rr) ((p) + (size_t)((k0) + (rr)) * 128 + sc)
#define RROW(p, k0) ((p) + (size_t)((k0) + rsr) * 64 + rsc)
#define VMW() asm volatile("s_waitcnt vmcnt(0)" ::: "memory")
#define SLOAD_H(Kp, Rp, Vp, k0) do { st_v0 = load8(ROW(Vp, k0, sr)); st_v1 = load8(ROW(Vp, k0, 32 + sr));              \
                         st_k0 = load8(ROW(Kp, k0, sr)); st_k1 = load8(ROW(Kp, k0, 32 + sr)); st_r = load8(RROW(Rp, k0)); } while (0)
#define SWRITE_H(bf) do { *(bf16x8*)(V_lds + (bf) * SHM_V + vst0) = st_v0; *(bf16x8*)(V_lds + (bf) * SHM_V + vst1) = st_v1; \
                          *(bf16x8*)(K_lds + (bf) * SHM_K + kws) = st_k0; *(bf16x8*)(K_lds + (bf) * SHM_K + kws + 32 * 256) = st_k1; *(bf16x8*)(R_lds + (bf) * SHM_R + rws) = st_r; } while (0)
__device__ __forceinline__ void q_finalize(bf16x8 (&qr)[8], const BlockRef& cur, char* lds, int wid, const float* gq, const float* cs_tab) {
    {
            const int ln2_ = mk_lane(), r32 = ln2_ & 31, hi = ln2_ >> 5;
            const bf16* qp = cur.Q + (size_t)(wid * QBLK + r32) * DQ + hi * 8;
            char* qsp = lds + OFF_QS + wid * 4096 + ln2_ * 16;
            {
                bf16x8 raw[8];
#pragma unroll
                for (int d0 = 0; d0 < 8; ++d0) raw[d0] = load8(qp + d0 * 16);
                float sn = 0.f;
#pragma unroll
                for (int d0 = 0; d0 < 8; ++d0)
#pragma unroll
                    for (int j = 0; j < 8; ++j) { const float x = __builtin_bit_cast(float, (unsigned)(unsigned short)raw[d0][j] << 16); sn += x * x; }
                { auto rr = __builtin_amdgcn_permlane32_swap(__float_as_uint(sn), __float_as_uint(sn), false, false); sn = __uint_as_float(rr[0]) + __uint_as_float(rr[1]); }
                const float rn = rsqrtf(sn * (1.0f / 128.0f) + 1e-6f);
#pragma unroll
                for (int d0 = 0; d0 < 8; ++d0) { const f32x4 ga = *(const f32x4*)(gq + d0 * 16 + hi * 8), gb = *(const f32x4*)(gq + d0 * 16 + hi * 8 + 4); u32x4 w;
#define QX(j) (__builtin_bit_cast(float, (unsigned)(unsigned short)raw[d0][j] << 16) * rn)
                    w.x = cvtpk(QX(0) * ga[0], QX(1) * ga[1]); w.y = cvtpk(QX(2) * ga[2], QX(3) * ga[3]); w.z = cvtpk(QX(4) * gb[0], QX(5) * gb[1]); w.w = cvtpk(QX(6) * gb[2], QX(7) * gb[3]);
#undef QX
                    qr[d0] = *reinterpret_cast<bf16x8*>(&w); }
                asm volatile("" : "+v"(qr[0]), "+v"(qr[1]), "+v"(qr[2]), "+v"(qr[3]), "+v"(qr[4]), "+v"(qr[5]), "+v"(qr[6]), "+v"(qr[7]));
            }
            bf16x8 raw[12];
#pragma unroll
            for (int d0 = 8; d0 < 12; ++d0) raw[d0] = load8(qp + d0 * 16);
            float sr = 0.f;
#pragma unroll
            for (int d0 = 8; d0 < 12; ++d0)
#pragma unroll
                for (int j = 0; j < 8; ++j) { const float x = __builtin_bit_cast(float, (unsigned)(unsigned short)raw[d0][j] << 16); sr += x * x; }
            { auto rr = __builtin_amdgcn_permlane32_swap(__float_as_uint(sr), __float_as_uint(sr), false, false); sr = __uint_as_float(rr[0]) + __uint_as_float(rr[1]); }
            const float rrs = rsqrtf(sr * (1.0f / 64.0f) + 1e-6f);
            const float* csr = cs_tab + (size_t)(cur.row0 + wid * QBLK + r32) * 64;
#pragma unroll
            for (int dp = 0; dp < 2; ++dp) { u32x4 wlo, whi; unsigned lo[4], hi4[4];
#pragma unroll
                for (int jj = 0; jj < 4; ++jj) {
                    const f32x4 cs4 = *(const f32x4*)(csr + (16 * dp + 8 * hi + 2 * jj) * 2);
                    const int j = 2 * jj;
                    const float g1a = gq[128 + 16 * dp + 8 * hi + j], g1b = gq[128 + 16 * dp + 8 * hi + j + 1], g2a = gq[128 + 32 + 16 * dp + 8 * hi + j], g2b = gq[128 + 32 + 16 * dp + 8 * hi + j + 1];
                    const float t1a = __builtin_bit_cast(float, (unsigned)(unsigned short)raw[8 + dp][j] << 16) * rrs * g1a, t1b = __builtin_bit_cast(float, (unsigned)(unsigned short)raw[8 + dp][j + 1] << 16) * rrs * g1b;
                    const float t2a = __builtin_bit_cast(float, (unsigned)(unsigned short)raw[10 + dp][j] << 16) * rrs * g2a, t2b = __builtin_bit_cast(float, (unsigned)(unsigned short)raw[10 + dp][j + 1] << 16) * rrs * g2b;
                    lo[jj] = cvtpk(t1a * cs4[0] - t2a * cs4[1], t1b * cs4[2] - t2b * cs4[3]);
                    hi4[jj] = cvtpk(t2a * cs4[0] + t1a * cs4[1], t2b * cs4[2] + t1b * cs4[3]);
                }
                wlo = (u32x4){lo[0], lo[1], lo[2], lo[3]}; whi = (u32x4){hi4[0], hi4[1], hi4[2], hi4[3]};
                *reinterpret_cast<u32x4*>(qsp + dp * 1024) = wlo; *reinterpret_cast<u32x4*>(qsp + (dp + 2) * 1024) = whi; }
        }
}
__device__ __forceinline__ void o_epilogue(const f32x16 (&o)[4], float l_reg, bf16* Oblk, char* lds, float* li_l, int wid, int lane, int r32, int hi) {
        if (hi == 0) li_l[r32] = l_reg; asm volatile("s_waitcnt lgkmcnt(0)" ::: "memory");
        float rli[16];
#pragma unroll
        for (int r = 0; r < 16; ++r) rli[r] = __builtin_amdgcn_rcpf(li_l[crow(r, hi)]);
        bf16* Ow = Oblk + (size_t)(wid * QBLK) * OSTR;
        bf16* stg = (bf16*)(lds + OFF_QS + wid * 4096);
#pragma unroll
        for (int hf = 0; hf < 2; ++hf) {
#pragma unroll
            for (int r = 0; r < 16; ++r) { const int orow = crow(r, hi);
#pragma unroll
                for (int d = 0; d < 2; ++d) stg[orow * 64 + d * 32 + r32] = (bf16)(cvtpk(o[2 * hf + d][r] * rli[r], 0.f) & 0xffffu); }
            asm volatile("s_waitcnt lgkmcnt(0)" ::: "memory");
#pragma unroll
            for (int i = 0; i < 4; ++i) { const int row = i * 8 + (lane >> 3), ch = lane & 7; const u32x4 v = *(const u32x4*)(stg + row * 64 + ch * 8); *(u32x4*)(Ow + (size_t)row * OSTR + hf * 64 + ch * 8) = v; }
            asm volatile("s_waitcnt lgkmcnt(0)" ::: "memory");
        }
}
__device__ __forceinline__ void attn_phase(char* lds, const bf16* Q, const bf16* K, const bf16* R, const bf16* V, bf16* O, const float* gq, const float* cs_tab, int G, int c, int wave_s) {
    constexpr int total = 4 * NB * NH;
    int tid_ = wave_s * 64 + mk_lane(); asm volatile("" : "+v"(tid_));
    const int tid = tid_, wid = __builtin_amdgcn_readfirstlane(tid >> 6), lane = tid & 63, r32 = lane & 31, hi = lane >> 5;
    const int grp = wid >> 2;
    int L = c; if (L >= total) return;
    int pass = 0;
    BlockRef cur = make_ref(L, 0, Q, K, R, V, O);
    char* V_lds = lds + OFF_V; char* K_lds = lds + OFF_K; char* R_lds = lds + OFF_R;
    float* ws = (float*)(lds + OFF_WS) + wid * 64; float* li_l = ws, * al_l = ws + 32;
    char* qsp = lds + OFF_QS + wid * 4096 + lane * 16;
    const int sr = tid >> 4, sc = (tid & 15) * 8, vst0 = v_st(sr, sc), vst1 = v_st(32 + sr, sc), kws = KSWZ(sr, sc * 2);
    const int rsr = tid >> 3, rsc = (tid & 7) * 8, rws = rsr * RPAD + rsc * 2;
    const int vb0 = (int)(uintptr_t)V_lds + v_rd_base(lane);
    bf16x8 st_v0 = {}, st_v1 = {}, st_k0 = {}, st_k1 = {}, st_r = {};
#define SWRITE_KV(kb, vr) do { *(bf16x8*)(V_lds + (vr) * SHM_V + vst0) = st_v0; *(bf16x8*)(V_lds + (vr) * SHM_V + vst1) = st_v1; \
                               *(bf16x8*)(K_lds + (kb) * SHM_K + kws) = st_k0; *(bf16x8*)(K_lds + (kb) * SHM_K + kws + 32 * 256) = st_k1; *(bf16x8*)(R_lds + (kb) * SHM_R + rws) = st_r; } while (0)
    SLOAD_H(cur.K, cur.R, cur.V, 0); VMW(); SWRITE_KV(0, 0);
    __syncthreads();
    int vsel = 0;
    bool pend = false, have_old = false;
    bf16* oldO = cur.O;
    bf16x8 pa0 = {}, pa1 = {}, pa2 = {}, pa3 = {}; bf16x8 qr[8] = {};
    float m_reg = -1e30f, l_reg = 0; f32x16 o[4] = {};
#define RESC(a) do { if (__any((a) < 1.f)) { if (hi == 0) al_l[r32] = (a); asm volatile("s_waitcnt lgkmcnt(0)" ::: "memory");              \
                     for (int d_ = 0; d_ < 4; ++d_) for (int r = 0; r < 16; ++r) o[d_][r] *= al_l[crow(r, hi)]; } } while (0)
#define NEWBLOCK() do { q_finalize(qr, cur, lds, wid, gq, cs_tab); m_reg = -1e30f; l_reg = 0; _Pragma("unroll") for (int d_ = 0; d_ < 4; ++d_) o[d_] = f32x16{}; } while (0)
#define STEP(t, KB) do { const int kb_ = (t) * KVBLK; const int vprev = vsel == 0 ? 2 : vsel - 1, vnext = vsel == 2 ? 0 : vsel + 1;       \
        if (grp) {                                                              \
            if (pend) { pv_tile<0>(o, vb0 + vprev * SHM_V, pa0, pa1, pa2, pa3); pend = false; }                                          \
            if ((t) == 0) { if (have_old) o_epilogue(o, l_reg, oldO, lds, li_l, wid, lane, r32, hi); NEWBLOCK(); } }                     \
        if (kb_ <= qlo + QBLK - 1) {                                            \
            f32x16 p0 = {}, p1 = {}; float mn = 0.f, al = 1.f;                                                                                                 \
            SBAR(); qkt<KB>(p0, p1, K_lds, R_lds, r32, hi, qr, qsp);                                                                     \
            if (kb_ + KVBLK - 1 > qlo) mask_tile(p0, p1, qm - kb_, (unsigned)WIN);                                                        \
            partialSM(p0, p1, m_reg, mn, al); RESC(al);                                                                                  \
            finishSM(p0, p1, al, l_reg, pa0, pa1, pa2, pa3); SBAR();                                                                     \
            if (grp) pend = true; else pv_tile<0>(o, vb0 + vsel * SHM_V, pa0, pa1, pa2, pa3); }                                          \
        VMW(); SWRITE_KV((KB) ^ 1, vnext); __syncthreads(); vsel = vnext; } while (0)
    for (;;) {
        const bool more_pass = pass == 0, more_item = L + G < total, last = !more_pass && !more_item;
        int passn = pass + 1, Ln = L;
        if (!more_pass) { passn = 0; Ln = more_item ? L + G : L; }
        const BlockRef nxt = last ? cur : make_ref(Ln, passn, Q, K, R, V, O);
        const int NT = cur.P0 / KVBLK + 4;
        const int qlo = cur.P0 + wid * QBLK, qm = qlo + r32 - 4 * hi;
        const bf16* Kh = cur.K; const bf16* Vh = cur.V; const bf16* Rh = cur.R;
        if (!grp) NEWBLOCK();
        for (int t = 0; t < NT; t += 2) {
            SLOAD_H(Kh, Rh, Vh, (t + 1) * KVBLK); SBAR();
            STEP(t, 0);
            const bool lt = t + 2 >= NT;
            if (!lt) { SLOAD_H(Kh, Rh, Vh, (t + 2) * KVBLK); } else { SLOAD_H(nxt.K, nxt.R, nxt.V, 0); }
            SBAR();
            STEP(t + 1, 1);
        }
        if (grp) { oldO = cur.O; have_old = true; } else o_epilogue(o, l_reg, cur.O, lds, li_l, wid, lane, r32, hi);
        if (last) break;
        cur = nxt; pass = passn; L = Ln;
    }
    if (grp) { if (pend) pv_tile<0>(o, vb0 + (vsel == 0 ? 2 : vsel - 1) * SHM_V, pa0, pa1, pa2, pa3); o_epilogue(o, l_reg, oldO, lds, li_l, wid, lane, r32, hi); }
    __syncthreads();
#undef RESC
#undef NEWBLOCK
#undef STEP
#undef SWRITE_KV
}
#undef ROW
#undef RROW
#undef VMW
#undef SLOAD_H
#undef SWRITE_H
#undef KSWZ
#undef SBAR
}
#define GAS __attribute__((address_space(1)))
#define LAS __attribute__((address_space(3)))
typedef unsigned short bf16;
typedef unsigned v4u __attribute__((ext_vector_type(4)));
typedef float f32x4 __attribute__((ext_vector_type(4)));
typedef short bf16x8 __attribute__((ext_vector_type(8)));
typedef GAS unsigned gu32;
typedef GAS unsigned long long gu64;
#define RLX_AGENT __ATOMIC_RELAXED, __HIP_MEMORY_SCOPE_AGENT
#define LDS_WAIT() asm volatile("s_waitcnt lgkmcnt(0)" ::: "memory")
#define VM_WAIT() asm volatile("s_waitcnt vmcnt(0)" ::: "memory")
__device__ __forceinline__ unsigned long long rt() { return __builtin_amdgcn_s_memrealtime(); }
__device__ __forceinline__ unsigned f2bf(float f) { unsigned u = __builtin_bit_cast(unsigned, f); return (u + 0x7fffu + ((u >> 16) & 1u)) >> 16; }
__device__ __forceinline__ unsigned pk2(float lo, float hi) { return f2bf(lo) | (f2bf(hi) << 16); }
#define XB_TMO      128
#define XB_XCNT(j)  (256  + 64 * (j))
#define XB_XSUB(j)  (1280 + 64 * (j))
#define XB_XGEN(j)  (2304 + 64 * (j))
#define XB_TOP      3328
#define XB_TOPGEN   3392
#define XCD_BAR_WORDS 3456
#define XB_SPIN_CAP (1u << 18)

__device__ __forceinline__ unsigned xb_ld(unsigned* p)              { return __hip_atomic_load(p, __ATOMIC_RELAXED, __HIP_MEMORY_SCOPE_AGENT); }
__device__ __forceinline__ unsigned xb_add(unsigned* p, unsigned v) { return __hip_atomic_fetch_add(p, v, __ATOMIC_RELAXED, __HIP_MEMORY_SCOPE_AGENT); }
__device__ __forceinline__ unsigned xb_xcc_id() { return (unsigned)__builtin_amdgcn_s_getreg((3 << 11) | 20) & 0xFu; }
#define XB_SPIN(cond, bar) do { unsigned _sp = 0; while (cond) { __builtin_amdgcn_s_sleep(1); \
    if ((++_sp & 255u) == 0u) { if (xb_ld(&(bar)[XB_TMO])) break; if (_sp > XB_SPIN_CAP) { atomicAdd(&(bar)[XB_TMO], 1u); break; } } } } while (0)

struct XcdBarrier {
    unsigned* bar; unsigned x;
    volatile LAS unsigned* st;
};

__device__ __forceinline__ XcdBarrier xcd_barrier_post(unsigned* bar, volatile LAS unsigned* st, bool t0  ) {
    XcdBarrier b; b.bar = bar; b.x = xb_xcc_id(); b.st = st;
    if (t0) (void)xb_add(&bar[XB_XCNT(b.x)], 1u);
    return b;
}
__device__ __forceinline__ void xcd_barrier_complete(unsigned* bar, unsigned x, unsigned& nloc, unsigned& nx) {
    const unsigned G = gridDim.x * gridDim.y * gridDim.z;
    unsigned sum, cnt, mine, sp = 0u;
    for (;;) {
        sum = 0u; cnt = 0u; mine = 0u;
#pragma unroll
        for (unsigned j = 0; j < 16; ++j) { const unsigned c = xb_ld(&bar[XB_XCNT(j)]); sum += c; cnt += (c > 0u) ? 1u : 0u; mine = (j == x) ? c : mine; }
        if (sum == G) break;
        __builtin_amdgcn_s_sleep(1);
        if ((++sp & 255u) == 0u) { if (xb_ld(&bar[XB_TMO])) break; if (sp > XB_SPIN_CAP) { atomicAdd(&bar[XB_TMO], 1u); break; } }
    }
    nloc = mine > 0u ? mine : 1u; nx = cnt > 0u ? cnt : 1u;
}

__device__ __forceinline__ void xcd_barrier(const XcdBarrier& b, bool t0) {
    asm volatile("s_waitcnt vmcnt(0)" ::: "memory");
    __syncthreads();
    if (t0) {
        unsigned* bar = b.bar;
        __builtin_amdgcn_s_waitcnt(0);
        unsigned nloc = b.st[0], nx = b.st[1];
        if (nloc == 0u) { xcd_barrier_complete(bar, b.x, nloc, nx); b.st[0] = nloc; b.st[1] = nx; }
        const unsigned old = xb_add(&bar[XB_XSUB(b.x)], 1u);
        const unsigned gen = old / nloc;
        if (old + 1u == (gen + 1u) * nloc) {
            __builtin_amdgcn_fence(__ATOMIC_RELEASE, "agent");
            asm volatile("s_waitcnt vmcnt(0)" ::: "memory");
            const unsigned og = xb_add(&bar[XB_TOP], 1u);
            const unsigned tg = og / nx;
            if (og + 1u == (tg + 1u) * nx) xb_add(&bar[XB_TOPGEN], 1u);
            else XB_SPIN(xb_ld(&bar[XB_TOPGEN]) == tg, bar);
            __builtin_amdgcn_fence(__ATOMIC_ACQUIRE, "agent");
            xb_add(&bar[XB_XGEN(b.x)], 1u);
            asm volatile("s_waitcnt vmcnt(0)" ::: "memory");
        } else {
            XB_SPIN(xb_ld(&bar[XB_XGEN(b.x)]) == gen, bar);
            __builtin_amdgcn_fence(__ATOMIC_ACQUIRE, "agent");
            asm volatile("s_waitcnt vmcnt(0)" ::: "memory");
        }
    }
    __syncthreads();
}
constexpr int NWAVES = 8;
constexpr int BATCH = 16, SEQ = 2048, T = BATCH * SEQ, D = 1024, FF = 4096;
constexpr int NPHASE = 25;
#ifndef MK_PER_PHASE
#define MK_PER_PHASE 0
#endif

constexpr size_t MiB = 1u << 20;
constexpr size_t WS_CTL = 0, CTL_ZERO_BYTES = 4 * MiB;
constexpr size_t CTL_SS = 256 * 1024;
constexpr size_t CTL_SSCQ = CTL_SS + 8 * (size_t)T * 8;
constexpr size_t CTL_SSCKV = CTL_SSCQ + 2 * (size_t)T * 8;
constexpr size_t CTL_DUMMY = CTL_SSCKV + 2 * (size_t)T * 8;
static_assert(CTL_DUMMY + (size_t)T * 8 <= CTL_ZERO_BYTES, "ctl");
constexpr size_t WS_W = 4 * MiB;
constexpr size_t W_MI = 0, W_MO = W_MI + 4 * (size_t)FF * D, W_DN = W_MO + 4 * (size_t)FF * D, W_UQ = W_DN + 2 * (size_t)768 * 1024, W_UKV = W_UQ + 2 * (size_t)1536 * 384,
                 W_AO = W_UKV + 2 * (size_t)2048 * 256, W_HI = W_AO + 2 * (size_t)1024 * 1024, W_HO = W_HI + (size_t)4096 * 1024, W_P1 = W_HO + (size_t)1024 * 1024,
                 W_P2 = W_P1 + (size_t)2048 * 1024, W_END = W_P2 + (size_t)1024 * 1024;
constexpr size_t WS_LB = WS_W + W_END * 2;
constexpr size_t WS_PV = WS_LB + 4096;
constexpr int PV_GQ = 0, PV_GK = 384, PV_ON = 768, PV_BP1 = 896, PV_WDW = 2944, PV_BDW = 34688, PV_LNG = 35712, PV_LNB = 36736, PV_BP2 = 37760, PV_POS = 38784, PV_END = PV_POS + T;
static_assert(WS_PV + (size_t)PV_END * 4 <= 96 * MiB, "weights + params");
constexpr size_t WS_XB = 96 * MiB;
constexpr size_t WS_OV = 160 * MiB;
constexpr size_t WS_HH = WS_OV;
constexpr size_t WS_Q = WS_OV, WS_K = WS_OV + 96 * MiB, WS_V = WS_OV + 160 * MiB, WS_O = WS_OV + 224 * MiB, WS_CQ = WS_OV + 288 * MiB, WS_CKV = WS_OV + 312 * MiB, WS_KR = WS_OV + 328 * MiB;
constexpr size_t WS_HQ = WS_OV, WS_HV = WS_OV + 64 * MiB, WS_HG = WS_OV + 128 * MiB, WS_HLF = WS_OV + 192 * MiB;
constexpr size_t WS_CU = WS_OV, WS_CY = WS_OV + 64 * MiB;
constexpr size_t WS_CS = 496 * MiB;
constexpr size_t WS_END = 512 * MiB;
static_assert(WS_KR + (size_t)T * 64 * 2 <= WS_END && WS_HLF + (size_t)T * 1024 * 4 <= WS_END && WS_HH + (size_t)T * FF * 2 <= WS_O + 0 * MiB + 64 * MiB, "ws map");

constexpr int CW_BAR = 4096;

constexpr int RING_OFF = 0, RING_BYTES = 135168;
constexpr int LDSCTL_OFF = RING_BYTES, MISC_OFF = LDSCTL_OFF + 320, EXTRA_OFF = RING_BYTES + 1024;
constexpr int LDS_BYTES = 147456;

__device__ __forceinline__ float wave_sum(float v) {
#define WSDPP(c) v += __builtin_bit_cast(float, __builtin_amdgcn_mov_dpp(__builtin_bit_cast(int, v), c, 0xf, 0xf, true))
    WSDPP(0xB1); WSDPP(0x4E); WSDPP(0x141); WSDPP(0x140);
#undef WSDPP
    { auto r = __builtin_amdgcn_permlane32_swap(__float_as_uint(v), __float_as_uint(v), false, false); v = __uint_as_float(r[0]) + __uint_as_float(r[1]); }
    { auto r = __builtin_amdgcn_permlane16_swap(__float_as_uint(v), __float_as_uint(v), false, false); v = __uint_as_float(r[0]) + __uint_as_float(r[1]); }
    return v;
}
__device__ __forceinline__ float bf2f(unsigned h) { return __builtin_bit_cast(float, h << 16); }
template <bool TILED = false> __device__ __forceinline__ void p0_transpose_item(const float* W, int K, int N, const float* gain, bf16* WT, int dst_row0, LAS float* scr, int k0, int n0, int lane) {
    float wv_[32];
#pragma unroll
    for (int i = 0; i < 32; ++i) wv_[i] = W[(size_t)(k0 + 2 * i + (lane >> 5)) * N + n0 + (lane & 31)];
#pragma unroll
    for (int i = 0; i < 32; ++i) { const int kk = 2 * i + (lane >> 5); const float gk = gain ? gain[k0 + kk] : 1.0f; scr[kk * 33 + (lane & 31)] = wv_[i] * gk; }
    LDS_WAIT(); asm volatile("" ::: "memory");
    const int c = lane & 7;
#pragma unroll
    for (int j = 0; j < 4; ++j) { const int n = (lane >> 3) + 8 * j; const LAS float* s = scr + (8 * c) * 33 + n;
        v4u o; o.x = pk2(s[0 * 33], s[1 * 33]); o.y = pk2(s[2 * 33], s[3 * 33]); o.z = pk2(s[4 * 33], s[5 * 33]); o.w = pk2(s[6 * 33], s[7 * 33]);
        const int rr = dst_row0 + n;
        if (TILED) *(GAS v4u*)(WT + (((size_t)(rr >> 8) * (K / 64) + (k0 >> 6)) * 256 + (rr & 255)) * 64 + 8 * c) = o;
        else *(GAS v4u*)(WT + (size_t)rr * K + k0 + 8 * c) = o; }
    LDS_WAIT(); asm volatile("" ::: "memory");
}

struct Args {
    const float* in[26]; float* out; unsigned char* ws; int ph_lo, ph_hi, li, pad;
};

#define P0_MAT(cnt_per, nmats, Wbase, Wstride, Kd, Nd, gainexpr, WTbase, WTstride) P0_MATX(true, cnt_per, nmats, Wbase, Wstride, Kd, Nd, gainexpr, WTbase, WTstride)
#define P0_MATX(TL, cnt_per, nmats, Wbase, Wstride, Kd, Nd, gainexpr, WTbase, WTstride) \
    if (r < (cnt_per) * (nmats)) { const int mi = r / (cnt_per), it = r % (cnt_per); const int nnb = (Nd) / 32, kb = it / nnb, nb = it % nnb; \
        p0_transpose_item<TL>((Wbase) + (size_t)mi * (Wstride), (Kd), (Nd), (gainexpr), (WTbase) + (size_t)mi * (WTstride), 32 * nb, scr, 64 * kb, 32 * nb, lane); continue; } r -= (cnt_per) * (nmats);

template <int PART> __device__ __forceinline__ void p0_weights(const Args& a, LAS unsigned char* lds, int gw, int NGW, int lane, int wave) {
    bf16* Wb = (bf16*)(a.ws + WS_W);
    LAS float* scr = (LAS float*)(lds + RING_OFF + wave * 16384);
    const float* norm_mix = a.in[2]; const float* norm_mlp = a.in[3];
    constexpr int I_MI = 16 * 128, I_MO = 64 * 32, I_DN = 16 * 22, I_UQ = 6 * 48, I_UKV = 4 * 64, I_SQ = 16 * 32, I_HI = 16 * 128, I_P1 = 16 * 64;
    constexpr int NM = PART < 2 ? 2 : 1, L0 = PART == 0 ? 0 : PART == 1 ? 2 : PART == 2 ? 0 : 1, J0 = PART == 1 ? 1 : 0;
    constexpr bool HAS_MLA = PART != 3, TAIL_HG = PART == 0 || PART == 3, TAIL_CV = PART == 1;
    constexpr int NITEMS = NM * (I_MI + I_MO) + (HAS_MLA ? I_DN + I_UQ + I_UKV + I_SQ : 0) + (TAIL_HG ? I_HI + I_SQ : 0) + (TAIL_CV ? I_P1 + I_SQ : 0);
    for (int item = gw; item < NITEMS; item += NGW) {
        int r = item;
        P0_MAT(I_MI, NM, a.in[4] + (size_t)L0 * D * FF, (size_t)D * FF, D, FF, norm_mlp + (L0 + mi) * D, Wb + W_MI + (size_t)L0 * FF * D, (size_t)FF * D)
        P0_MATX(true, I_MO, NM, a.in[5] + (size_t)L0 * FF * D, (size_t)FF * D, FF, D, (const float*)nullptr, Wb + W_MO + (size_t)L0 * FF * D, (size_t)FF * D)
        if (HAS_MLA) {
            P0_MAT(I_DN, 1, a.in[6] + (size_t)J0 * D * 704, 0, D, 704, norm_mix + J0 * 3 * D, Wb + W_DN + (size_t)J0 * 768 * D, 0)
            P0_MAT(I_UQ, 1, a.in[9] + (size_t)J0 * 384 * 1536, 0, 384, 1536, a.in[7] + J0 * 384, Wb + W_UQ + (size_t)J0 * 1536 * 384, 0)
            P0_MAT(I_UKV, 1, a.in[10] + (size_t)J0 * 256 * 2048, 0, 256, 2048, a.in[8] + J0 * 256, Wb + W_UKV + (size_t)J0 * 2048 * 256, 0)
            P0_MAT(I_SQ, 1, a.in[13] + (size_t)J0 * D * D, 0, D, D, (const float*)nullptr, Wb + W_AO + (size_t)J0 * D * D, 0)
        }
        if (TAIL_HG) {
            P0_MAT(I_HI, 1, a.in[14], 0, D, FF, norm_mix + 1 * D, Wb + W_HI, 0)
            { const int nnb = D / 32, kb = r / nnb, nb = r % nnb; p0_transpose_item<true>(a.in[17], D, D, nullptr, Wb + W_HO, 32 * nb, scr, 64 * kb, 32 * nb, lane); }
        } else if (TAIL_CV) {
            if (r < I_P1) {
                const int nnb = 2048 / 32, kb = r / nnb, nb = r % nnb, n0 = 32 * nb, bj = n0 >> 10, j0 = n0 & 1023;
                p0_transpose_item<true>(a.in[18], D, 2048, norm_mix + 2 * D, Wb + W_P1, 256 * (j0 >> 7) + 128 * bj + (j0 & 127), scr, 64 * kb, n0, lane); continue; }
            r -= I_P1;
            { const int nnb = D / 32, kb = r / nnb, nb = r % nnb; p0_transpose_item<true>(a.in[24], D, D, nullptr, Wb + W_P2, 32 * nb, scr, 64 * kb, 32 * nb, lane); }
        }
    }
}
__device__ __forceinline__ void p0_prologue(const Args& a, LAS unsigned char* lds, int vcu, int G, int tid, int lane, int wave) {
    unsigned char* ws = a.ws;
    bf16* Wb = (bf16*)(ws + WS_W);
    const int gw = vcu * NWAVES + wave, NGW = G * NWAVES;
    p0_weights<2>(a, lds, gw, NGW, lane, wave);
    for (int i = vcu * 512 + tid; i < 2 * 8192; i += G * 512) { const int j = i >> 13, rem = i & 8191, kt = rem >> 9, ch = rem & 511;
        *(GAS v4u*)(Wb + W_DN + (size_t)j * 768 * D + ((size_t)(2 * 16 + kt) * 256 + 192) * 64 + ch * 8) = (v4u){0u, 0u, 0u, 0u}; }
    for (int c = vcu * 512 + tid; c < 1024; c += G * 512) {
        const float* lg = a.in[15]; const float l0 = lg[c], l1 = lg[1024 + c], l2 = lg[2048 + c], l3 = lg[3072 + c];
        const float mx = fmaxf(fmaxf(l0, l1), fmaxf(l2, l3)); const float e0 = expf(l0 - mx), e1 = expf(l1 - mx), e2 = expf(l2 - mx), e3 = expf(l3 - mx);
        ((float*)(ws + WS_LB))[c] = e1 / (e0 + e1 + e2 + e3);
    }
    { float* pv = (float*)(ws + WS_PV); const int gt = vcu * 512 + tid, NT_ = G * 512;
#define P0_COPY(dst, src, n) for (int i = gt; i < (n); i += NT_) pv[(dst) + i] = (src)[i];
      P0_COPY(PV_GQ, a.in[11], 384) P0_COPY(PV_GK, a.in[12], 384) P0_COPY(PV_ON, a.in[16], 128) P0_COPY(PV_BP1, a.in[19], 2048) P0_COPY(PV_WDW, a.in[20], 31 * 1024)
      P0_COPY(PV_BDW, a.in[21], 1024) P0_COPY(PV_LNG, a.in[22], 1024) P0_COPY(PV_LNB, a.in[23], 1024) P0_COPY(PV_BP2, a.in[25], 1024) P0_COPY(PV_POS, a.in[1], T)
#undef P0_COPY
    }
    const float* x = a.in[0]; bf16* xb = (bf16*)(ws + WS_XB); unsigned long long* ss0 = (unsigned long long*)(ws + CTL_SS);
    for (int m0 = gw; m0 < T; m0 += 2 * NGW) {
        f32x4 v[2][4];
#pragma unroll
        for (int u = 0; u < 2; ++u) { const int mr_ = (m0 + u * NGW < T) ? m0 + u * NGW : m0; const GAS f32x4* xr = (const GAS f32x4*)(x + (size_t)mr_ * D) + lane;
#pragma unroll
            for (int j = 0; j < 4; ++j) v[u][j] = xr[64 * j]; }
#pragma unroll
        for (int u = 0; u < 2; ++u) { const int m = (m0 + u * NGW < T) ? m0 + u * NGW : m0; float s = 0.f;
#pragma unroll
            for (int j = 0; j < 4; ++j) { const float r0 = bf2f(f2bf(v[u][j].x)), r1 = bf2f(f2bf(v[u][j].y)), r2 = bf2f(f2bf(v[u][j].z)), r3 = bf2f(f2bf(v[u][j].w)); s += (r0 * r0 + r1 * r1) + (r2 * r2 + r3 * r3); }
            s = wave_sum(s);
            GAS unsigned long long* o8 = (GAS unsigned long long*)(xb + (size_t)m * D) + lane;
#pragma unroll
            for (int j = 0; j < 4; ++j) o8[64 * j] = (unsigned long long)pk2(v[u][j].x, v[u][j].y) | ((unsigned long long)pk2(v[u][j].z, v[u][j].w) << 32);
            if (lane == 0) ss0[m] = (unsigned long long)(s * 1048576.0f + 0.5f); }
    }
}

__device__ __forceinline__ void mla_finalize(const int* pos, const float* gq, const float* gk, bf16* Q, bf16* Kn, bf16* Kr, int vcu, int G, int lane, int wave) {
    const int gw = vcu * NWAVES + wave, NGW = G * NWAVES;
    const float gq0 = gq[2 * lane], gq1 = gq[2 * lane + 1], gqr = gq[128 + lane], gk0 = gk[2 * lane], gk1 = gk[2 * lane + 1], gkr = gk[128 + lane];
    const float inv_freq = powf(10000.0f, -(float)(2 * (lane & 31)) / 64.0f);
    for (int row = gw; row < T; row += NGW) {
        const int b = row >> 11, s = row & 2047;
        const float ang = (float)pos[row] * inv_freq; float sn, cs; sincosf(ang, &sn, &cs);
        const float sgn = lane < 32 ? -sn : sn;
#pragma unroll 2
        for (int h = 0; h < 8; ++h) {
            bf16* qp = Q + ((size_t)((b * 8 + h) * 2048 + s)) * 192; bf16* kp = Kn + ((size_t)((b * 8 + h) * 2048 + s)) * 128;
            const unsigned wq = *(const unsigned*)(qp + 2 * lane), wk = *(const unsigned*)(kp + 2 * lane); const unsigned er = qp[128 + lane];
            float a0 = bf2f(wq & 0xffffu), a1 = bf2f(wq >> 16), k0 = bf2f(wk & 0xffffu), k1 = bf2f(wk >> 16), e = bf2f(er);
            const float sq = wave_sum(a0 * a0 + a1 * a1), sk = wave_sum(k0 * k0 + k1 * k1), se = wave_sum(e * e);
            const float rq = rsqrtf(sq * (1.0f / 128.0f) + 1e-6f), rk = rsqrtf(sk * (1.0f / 128.0f) + 1e-6f), re = rsqrtf(se * (1.0f / 64.0f) + 1e-6f);
            *(unsigned*)(qp + 2 * lane) = pk2(a0 * rq * gq0, a1 * rq * gq1);
            *(unsigned*)(kp + 2 * lane) = pk2(k0 * rk * gk0, k1 * rk * gk1);
            e = e * re * gqr; const float pe = __shfl_xor(e, 32);
            qp[128 + lane] = (bf16)f2bf(e * cs + pe * sgn);
        }
        { bf16* rp = Kr + (size_t)row * 64; float e = bf2f(rp[lane]); const float se = wave_sum(e * e); e = e * rsqrtf(se * (1.0f / 64.0f) + 1e-6f) * gkr;
          const float pe = __shfl_xor(e, 32); rp[lane] = (bf16)f2bf(e * cs + pe * sgn); }
    }
}

__device__ __forceinline__ void kr_finalize(const int* pos, const float* gk, bf16* Kr, float* cs_tab, int vcu, int G, int lane, int wave) {
    typedef float f32x2 __attribute__((ext_vector_type(2)));
    const int gw = vcu * NWAVES + wave, NGW = G * NWAVES;
    const float gkr = gk[128 + lane];
    const float inv_freq = powf(10000.0f, -(float)(2 * (lane & 31)) / 64.0f);
    for (int row = gw; row < T; row += NGW) {
        const float ang = (float)pos[row] * inv_freq; float sn, cs; sincosf(ang, &sn, &cs);
        const float sgn = lane < 32 ? -sn : sn;
        bf16* rp = Kr + (size_t)row * 64; float e = bf2f(rp[lane]); const float se = wave_sum(e * e); e = e * rsqrtf(se * (1.0f / 64.0f) + 1e-6f) * gkr;
        const float pe = __shfl_xor(e, 32); rp[lane] = (bf16)f2bf(e * cs + pe * sgn);
        if (lane < 32) *(f32x2*)(cs_tab + (size_t)row * 64 + 2 * lane) = (f32x2){cs, sn};
    }
}

__device__ __forceinline__ void hgrn_scan_simple(LAS unsigned char* lds, bf16* hq, const bf16* hv, const bf16* hg, const float* hlf, const float* onorm, int unit, int tid) {
    LAS float* Lf = (LAS float*)(lds); LAS float* Lk = Lf + 4096; LAS float* Lq = Lk + 4096; LAS float* Lv = Lq + 4096; LAS float* Lp = Lv + 4096;
    const int b = unit >> 3, h = unit & 7, dv = tid & 127, kg = tid >> 7;
    float S[32];
#pragma unroll
    for (int j = 0; j < 32; ++j) S[j] = 0.f;
    for (int c0 = 0; c0 < SEQ; c0 += 32) {
#pragma unroll
        for (int i = 0; i < 8; ++i) { const int idx = tid + 512 * i, t = idx >> 7, c = idx & 127; const size_t g = (size_t)(b * SEQ + c0 + t) * 1024 + h * 128 + c;
            const float f = __expf(hlf[g]); Lf[idx] = f; Lk[idx] = 1.0f - f; Lq[idx] = bf2f(hq[g]); Lv[idx] = bf2f(hv[g]); }
        __syncthreads();
        for (int t = 0; t < 32; ++t) {
            const float vv = Lv[t * 128 + dv]; float acc = 0.f;
            const LAS f32x4* pf = (const LAS f32x4*)(Lf + t * 128 + kg * 32); const LAS f32x4* pk = (const LAS f32x4*)(Lk + t * 128 + kg * 32); const LAS f32x4* pq = (const LAS f32x4*)(Lq + t * 128 + kg * 32);
#pragma unroll
            for (int j4 = 0; j4 < 8; ++j4) { const f32x4 f4 = pf[j4], k4 = pk[j4], q4 = pq[j4];
#pragma unroll
                for (int e = 0; e < 4; ++e) { const int j = j4 * 4 + e; S[j] = f4[e] * S[j] + k4[e] * vv; acc += q4[e] * S[j]; } }
            Lp[(kg * 32 + t) * 128 + dv] = acc;
        }
        __syncthreads();
        { const int t = tid >> 4, d0 = (tid & 15) * 8; float o[8]; float sq = 0.f;
#pragma unroll
            for (int e = 0; e < 8; ++e) { o[e] = (Lp[(0 * 32 + t) * 128 + d0 + e] + Lp[(1 * 32 + t) * 128 + d0 + e]) + (Lp[(2 * 32 + t) * 128 + d0 + e] + Lp[(3 * 32 + t) * 128 + d0 + e]); sq += o[e] * o[e]; }
            sq += __shfl_xor(sq, 1); sq += __shfl_xor(sq, 2); sq += __shfl_xor(sq, 4); sq += __shfl_xor(sq, 8);
            const float rn = rsqrtf(sq * (1.0f / 128.0f) + 1e-6f);
            const size_t g = (size_t)(b * SEQ + c0 + t) * 1024 + h * 128 + d0;
            const v4u gv = *(const v4u*)(hg + g); unsigned w[4];
#pragma unroll
            for (int e = 0; e < 4; ++e) { const unsigned gg = e == 0 ? gv.x : e == 1 ? gv.y : e == 2 ? gv.z : gv.w;
                w[e] = pk2(o[2 * e] * rn * onorm[d0 + 2 * e] * bf2f(gg & 0xffffu), o[2 * e + 1] * rn * onorm[d0 + 2 * e + 1] * bf2f(gg >> 16)); }
            *(v4u*)(hq + g) = (v4u){w[0], w[1], w[2], w[3]}; }
        __syncthreads();
    }
}

#ifndef EXP_NO_LN
#define EXP_NO_LN 0
#endif
__device__ __forceinline__ void conv_phase(LAS unsigned char* lds, const bf16* cu, bf16* cy, const float* wdw, const float* bdw, const float* lng, const float* lnb, int vcu, int G, int tid, int lane, int wave) {
    typedef float f32x2 __attribute__((ext_vector_type(2)));
    constexpr int TT = 16, NU = TT + 30;
    LAS f32x2* red = (LAS f32x2*)(lds + RING_OFF);
    const int c0 = 2 * tid;
    f32x2 wv[31];
#pragma unroll
    for (int k = 0; k < 31; ++k) wv[k] = *(const f32x2*)(wdw + k * 1024 + c0);
    const f32x2 bd = *(const f32x2*)(bdw + c0), g2 = *(const f32x2*)(lng + c0), b2 = *(const f32x2*)(lnb + c0);
    int par = 0;
    const int NT = T / TT, TPW = (NT + G - 1) / G, tb = vcu * TPW, te = (tb + TPW < NT) ? tb + TPW : NT;
    if (tb >= te) return;
    f32x2 uv[NU];
    unsigned nx[TT];
    {
        const int row0 = tb * TT, s0 = row0 & 2047;
#pragma unroll
        for (int i = 0; i < 30; ++i) {
            unsigned u = 0u;
            if (s0 - 30 + i >= 0) u = *(const unsigned*)(cu + (size_t)(row0 - 30 + i) * 1024 + c0);
            uv[i] = (f32x2){bf2f(u & 0xffffu), bf2f(u >> 16)};
        }
#pragma unroll
        for (int i = 0; i < TT; ++i) nx[i] = *(const unsigned*)(cu + (size_t)(row0 + i) * 1024 + c0);
    }
    for (int tile = tb; tile < te; ++tile) {
        const int row0 = tile * TT;
#pragma unroll
        for (int i = 0; i < TT; ++i) uv[30 + i] = (f32x2){bf2f(nx[i] & 0xffffu), bf2f(nx[i] >> 16)};
        if (tile + 1 < te) {
#pragma unroll
            for (int i = 0; i < TT; ++i) nx[i] = *(const unsigned*)(cu + (size_t)(row0 + TT + i) * 1024 + c0);
        }
        f32x2 yv[TT];
#pragma unroll
        for (int t = 0; t < TT; t += 2) { f32x2 a = bd, b = bd;
#pragma unroll
            for (int k = 0; k < 31; ++k) { a = __builtin_elementwise_fma(wv[k], uv[t + k], a); b = __builtin_elementwise_fma(wv[k], uv[t + 1 + k], b); }
            yv[t] = a; yv[t + 1] = b; }
        LAS f32x2* wp = red + (size_t)(par * TT * 8); par ^= 1;
        float zs[TT];
#define DPPA(v, c) v += __builtin_bit_cast(float, __builtin_amdgcn_mov_dpp(__builtin_bit_cast(int, v), c, 0xf, 0xf, true))
#pragma unroll
        for (int t = 0; t < TT; ++t) { float A = yv[t].x + yv[t].y, B = yv[t].x * yv[t].x + yv[t].y * yv[t].y;
            DPPA(A, 0xB1); DPPA(B, 0xB1); DPPA(A, 0x4E); DPPA(B, 0x4E); DPPA(A, 0x141); DPPA(B, 0x141); DPPA(A, 0x140); DPPA(B, 0x140);
            auto r1 = __builtin_amdgcn_permlane32_swap(__float_as_uint(A), __float_as_uint(B), false, false);
            const float X = __uint_as_float(r1[0]) + __uint_as_float(r1[1]);
            auto r2 = __builtin_amdgcn_permlane16_swap(__float_as_uint(X), __float_as_uint(X), false, false);
            zs[t] = __uint_as_float(r2[0]) + __uint_as_float(r2[1]); }
#undef DPPA
        if ((lane & 31) == 0) {
#pragma unroll
            for (int t = 0; t < TT; ++t) ((LAS float*)wp)[(t * 8 + wave) * 2 + (lane >> 5)] = zs[t];
        }
        __syncthreads();
#pragma unroll
        for (int t = 0; t < TT; ++t) { float s1 = 0.f, s2 = 0.f;
#pragma unroll
            for (int q = 0; q < 8; ++q) { const f32x2 v = wp[t * 8 + q]; s1 += v.x; s2 += v.y; }
            const float mean = s1 * (1.0f / 1024.0f), var = fmaxf(s2 * (1.0f / 1024.0f) - mean * mean, 0.f);
            const f32x2 st = (f32x2){mean, rsqrtf(var + 1e-6f)};
            float a = (yv[t].x - st.x) * st.y * g2.x + b2.x, b = (yv[t].y - st.x) * st.y * g2.y + b2.y;
            a = a * __builtin_amdgcn_rcpf(1.0f + __expf(-a)); b = b * __builtin_amdgcn_rcpf(1.0f + __expf(-b));
            *(unsigned*)(cy + (size_t)(row0 + t) * 1024 + c0) = pk2(a, b); }
        const bool newseq = ((row0 + TT) & 2047) == 0;
#pragma unroll
        for (int i = 0; i < 30; ++i) uv[i] = newseq ? (f32x2){0.f, 0.f} : uv[i + TT];
    }
}
namespace hgs {
typedef short bf16x8 __attribute__((ext_vector_type(8)));
typedef short s16x4 __attribute__((ext_vector_type(4)));
typedef float f32x4 __attribute__((ext_vector_type(4)));
typedef float f32x2 __attribute__((ext_vector_type(2)));
typedef unsigned u32x4 __attribute__((ext_vector_type(4)));
typedef unsigned u32x2 __attribute__((ext_vector_type(2)));
constexpr int RS = 272, RK = 144, RO = 528;
constexpr int OFF_KT = 0, OFF_LF = 0, OFF_QI = 43520, OFF_VV = OFF_QI + 17408, OFF_QT = OFF_VV + 17408, OFF_KO = OFF_QT + 17408, OFF_AT = OFF_KO + 18432, OFF_SEG = OFF_AT + 9216, OFF_AL = OFF_SEG + 4096,
              OFF_OUT = OFF_QT, LDS_END = OFF_AL + 512;
static_assert(LDS_END <= 131072 && 64 * RO <= 17408 + 18432 && 10 * 16 * RS <= OFF_QI && 64 * 512 <= OFF_QI, "scan LDS map");
__device__ __forceinline__ unsigned pkbf(float lo, float hi) { unsigned r; asm volatile("v_cvt_pk_bf16_f32 %0, %1, %2" : "=v"(r) : "v"(lo), "v"(hi)); return r; }
__device__ __forceinline__ float bflo(unsigned w) { return __builtin_bit_cast(float, w << 16); }
__device__ __forceinline__ float bfhi(unsigned w) { return __builtin_bit_cast(float, w & 0xffff0000u); }
__device__ __forceinline__ void trrd4(s16x4& a, s16x4& b, s16x4& c, s16x4& d, unsigned addr) {
    asm volatile("ds_read_b64_tr_b16 %0, %4\n\tds_read_b64_tr_b16 %1, %4 offset:%5\n\tds_read_b64_tr_b16 %2, %4 offset:%6\n\tds_read_b64_tr_b16 %3, %4 offset:%7\n\ts_waitcnt lgkmcnt(0)"
                 : "=&v"(a), "=&v"(b), "=&v"(c), "=&v"(d) : "v"(addr), "n"(4 * RS), "n"(32 * RS), "n"(32 * RS + 4 * RS) : "memory");
}

__device__ __forceinline__ void scan_unit(LAS unsigned char* lds, unsigned short* hq, const unsigned short* hv, const unsigned short* hg, const float* hlf, const float* onorm, unsigned short* ho, int unit, int wave_s) {
    int tid_ = wave_s * 64 + mk_lane(); asm volatile("" : "+v"(tid_));
    const int tid = tid_, lane = tid & 63, w = __builtin_amdgcn_readfirstlane(tid >> 6);
    const int b = unit >> 3, h = unit & 7;
    const size_t gbase = (size_t)b * SEQ * 1024 + h * 128;
    u32x4 pq[2], pv[2], pg[2]; f32x4 pl[4];
#define SCAN_LOAD(c0) do { _Pragma("unroll") for (int i = 0; i < 2; ++i) { const int p = tid + 512 * i, t = p >> 4, c = p & 15; const size_t g = gbase + (size_t)((c0) + t) * 1024 + c * 8; \
            pq[i] = *(const u32x4*)(hq + g); pv[i] = *(const u32x4*)(hv + g); } \
        _Pragma("unroll") for (int i = 0; i < 4; ++i) { const int p = tid + 512 * i, t = p >> 5, c = p & 31; pl[i] = *(const f32x4*)(hlf + gbase + (size_t)((c0) + t) * 1024 + c * 4); } } while (0)
#define SCAN_STORE() do { _Pragma("unroll") for (int i = 0; i < 2; ++i) { const int p = tid + 512 * i, t = p >> 4, c = p & 15; \
            *(LAS u32x4*)(lds + OFF_QI + t * RS + c * 16) = pq[i]; *(LAS u32x4*)(lds + OFF_VV + t * RS + c * 16) = pv[i]; } \
        _Pragma("unroll") for (int i = 0; i < 4; ++i) { const int p = tid + 512 * i, t = p >> 5, c = p & 31; *(LAS f32x4*)(lds + OFF_LF + t * 512 + c * 16) = pl[i]; } } while (0)
    const int to = tid >> 3, d0 = (tid & 7) * 16;
    float gn[16];
#pragma unroll
    for (int e = 0; e < 16; ++e) gn[e] = onorm[d0 + e];
    for (int i = tid; i < 64 * RK / 4; i += 512) *(LAS unsigned*)(lds + OFF_AT + i * 4) = 0u;
    f32x4 S[8];
#pragma unroll
    for (int k = 0; k < 8; ++k) S[k] = (f32x4){0.f, 0.f, 0.f, 0.f};
    SCAN_LOAD(0); SCAN_STORE();
    const int col = lane & 15, rq = lane >> 4;
    f32x2 fv[8], R[8], Sx[8];
#define SCAN_S2() do { f32x2 ls = (f32x2){0.f, 0.f};                                                                                                   \
        _Pragma("unroll") for (int i = 0; i < 8; ++i) { const f32x2 l = *(const LAS f32x2*)(lds + OFF_LF + (8 * w + i) * 512 + lane * 8); ls += l; fv[i] = (f32x2){__expf(l.x), __expf(l.y)}; } \
        R[0] = fv[0];                                                                                                                                  \
        _Pragma("unroll") for (int i = 1; i < 8; ++i) R[i] = R[i - 1] * fv[i];                                                                         \
        Sx[7] = (f32x2){1.f, 1.f};                                                                                                                     \
        _Pragma("unroll") for (int i = 6; i >= 0; --i) Sx[i] = Sx[i + 1] * fv[i + 1];                                                                  \
        *(LAS f32x2*)(lds + OFF_SEG + w * 512 + lane * 8) = ls; } while (0)
    __syncthreads();
    SCAN_S2();
    for (int c0 = 0; c0 < SEQ; c0 += 64) {
        __syncthreads();
        if (c0 + 64 < SEQ) SCAN_LOAD(c0 + 64);
        { const size_t g = gbase + (size_t)(c0 + to) * 1024 + d0; pg[0] = *(const u32x4*)(hg + g); pg[1] = *(const u32x4*)(hg + g + 8); }
        {
            f32x2 tt[8];
#pragma unroll
            for (int s = 0; s < 8; ++s) tt[s] = *(const LAS f32x2*)(lds + OFF_SEG + s * 512 + lane * 8);
            f32x2 base = (f32x2){0.f, 0.f}, after = (f32x2){0.f, 0.f}, all = (f32x2){0.f, 0.f};
#pragma unroll
            for (int s = 0; s < 8; ++s) { if (s < w) base += tt[s]; if (s > w) after += tt[s]; all += tt[s]; }
            const int J = w >> 1, odd = w & 1;
            f32x2 prevt = (f32x2){0.f, 0.f};
#pragma unroll
            for (int s = 0; s < 8; ++s) if (odd && s == w - 1) prevt = tt[s];
            const f32x2 eb = (f32x2){__expf(base.x), __expf(base.y)};
            const f32x2 ep = (f32x2){__expf(prevt.x), __expf(prevt.y)};
            const f32x2 epi = (f32x2){__expf(-prevt.x), __expf(-prevt.y)};
            const f32x2 el = (f32x2){__expf(after.x), __expf(after.y)};
            f32x2 eI[3];
#pragma unroll
            for (int I = 1; I < 4; ++I) { f32x2 a = (f32x2){0.f, 0.f};
#pragma unroll
                for (int s = 0; s < 8; ++s) if (s > w && s < 2 * I) a += tt[s];
                eI[I - 1] = (f32x2){__expf(a.x), __expf(a.y)}; }
            if (w == 0) *(LAS f32x2*)(lds + OFF_AL + lane * 8) = (f32x2){__expf(all.x), __expf(all.y)};
            unsigned kow[2][4];
            const int sl0 = 8 * odd;
            unsigned qws[8];
#pragma unroll
            for (int i = 0; i < 8; ++i) qws[i] = *(const LAS unsigned*)(lds + OFF_QI + (8 * w + i) * RS + lane * 4);
#pragma unroll
            for (int i = 0; i < 8; ++i) {
                const int t = 8 * w + i;
                const unsigned qw = qws[i];
                const f32x2 q = (f32x2){bflo(qw), bfhi(qw)};
                const f32x2 k = (f32x2){1.f, 1.f} - fv[i];
                const f32x2 qin = q * eb * R[i], qt = q * ep * R[i];
                *(LAS unsigned*)(lds + OFF_QI + t * RS + lane * 4) = pkbf(qin.x, qin.y);
                *(LAS unsigned*)(lds + OFF_QT + t * RS + lane * 4) = pkbf(qt.x, qt.y);
                const f32x2 ks = k * Sx[i];
                const f32x2 ko = ks * el;
                if (i & 1) { kow[0][i >> 1] |= pkbf(0.f, ko.x) & 0xffff0000u; kow[1][i >> 1] |= pkbf(0.f, ko.y) & 0xffff0000u; }
                else { kow[0][i >> 1] = pkbf(ko.x, 0.f) & 0xffffu; kow[1][i >> 1] = pkbf(ko.y, 0.f) & 0xffffu; }
                const f32x2 ri = (f32x2){__builtin_amdgcn_rcpf(R[i].x), __builtin_amdgcn_rcpf(R[i].y)};
                const f32x2 kd = k * epi * ri;
                *(LAS unsigned*)(lds + OFF_KT + ((J * (J + 1) / 2 + J) * 16 + sl0 + i) * RS + lane * 4) = pkbf(kd.x, kd.y);
#pragma unroll
                for (int I = 1; I < 4; ++I) if (I > J) { const f32x2 kk = ks * eI[I - 1];
                    *(LAS unsigned*)(lds + OFF_KT + ((I * (I + 1) / 2 + J) * 16 + sl0 + i) * RS + lane * 4) = pkbf(kk.x, kk.y); }
            }
            *(LAS u32x4*)(lds + OFF_KO + (2 * lane) * RK + 16 * w) = (u32x4){kow[0][0], kow[0][1], kow[0][2], kow[0][3]};
            *(LAS u32x4*)(lds + OFF_KO + (2 * lane + 1) * RK + 16 * w) = (u32x4){kow[1][0], kow[1][1], kow[1][2], kow[1][3]};
        }
        __syncthreads();
#pragma unroll
        for (int rep = 0; rep < 2; ++rep) {
            const int idx = w + 8 * rep;
            if (idx < 10) {
                const int I = idx >= 6 ? 3 : (idx >= 3 ? 2 : (idx >= 1 ? 1 : 0)), Jb = idx - I * (I + 1) / 2;
                f32x4 d = (f32x4){0.f, 0.f, 0.f, 0.f};
                bf16x8 ka[4], qb[4];
#pragma unroll
                for (int j = 0; j < 4; ++j) { ka[j] = *(const LAS bf16x8*)(lds + OFF_KT + (idx * 16 + col) * RS + (32 * j + 8 * rq) * 2);
                                              qb[j] = *(const LAS bf16x8*)(lds + OFF_QT + (16 * I + col) * RS + (32 * j + 8 * rq) * 2); }
                __builtin_amdgcn_sched_barrier(0);
#pragma unroll
                for (int j = 0; j < 4; ++j) d = __builtin_amdgcn_mfma_f32_16x16x32_bf16(ka[j], qb[j], d, 0, 0, 0);
                if (I == Jb) {
#pragma unroll
                    for (int i = 0; i < 4; ++i) if (4 * rq + i > col) d[i] = 0.f; }
                *(LAS u32x2*)(lds + OFF_AT + (16 * I + col) * RK + (16 * Jb + 4 * rq) * 2) = (u32x2){pkbf(d[0], d[1]), pkbf(d[2], d[3])};
            }
        }
        bf16x8 vf[2];
        {
            const unsigned va = (unsigned)(size_t)(lds + OFF_VV) + (unsigned)((8 * rq + ((lane & 15) >> 2)) * RS + w * 32 + (lane & 3) * 8);
            s16x4 l0, h0, l1, h1; trrd4(l0, h0, l1, h1, va);
            vf[0] = (bf16x8){l0[0], l0[1], l0[2], l0[3], h0[0], h0[1], h0[2], h0[3]}; vf[1] = (bf16x8){l1[0], l1[1], l1[2], l1[3], h1[0], h1[1], h1[2], h1[3]};
        }
        f32x4 oacc[4];
        {
            bf16x8 sb[4];
#pragma unroll
            for (int j = 0; j < 4; ++j) { const u32x4 wv = (u32x4){pkbf(S[2 * j][0], S[2 * j][1]), pkbf(S[2 * j][2], S[2 * j][3]), pkbf(S[2 * j + 1][0], S[2 * j + 1][1]), pkbf(S[2 * j + 1][2], S[2 * j + 1][3])};
                sb[j] = __builtin_bit_cast(bf16x8, wv); }
            u32x4 av[4][4];
#pragma unroll
            for (int mb = 0; mb < 4; ++mb)
#pragma unroll
                for (int j = 0; j < 4; ++j) {
                    const u32x2 lo = *(const LAS u32x2*)(lds + OFF_QI + (16 * mb + col) * RS + (32 * j + 4 * rq) * 2), hi = *(const LAS u32x2*)(lds + OFF_QI + (16 * mb + col) * RS + (32 * j + 16 + 4 * rq) * 2);
                    av[mb][j] = (u32x4){lo.x, lo.y, hi.x, hi.y}; }
            __builtin_amdgcn_sched_barrier(0);
#pragma unroll
            for (int mb = 0; mb < 4; ++mb) oacc[mb] = (f32x4){0.f, 0.f, 0.f, 0.f};
#pragma unroll
            for (int j = 0; j < 4; ++j)
#pragma unroll
                for (int mb = 0; mb < 4; ++mb) oacc[mb] = __builtin_amdgcn_mfma_f32_16x16x32_bf16(__builtin_bit_cast(bf16x8, av[mb][j]), sb[j], oacc[mb], 0, 0, 0);
            __builtin_amdgcn_sched_barrier(0);
        }
#pragma unroll
        for (int bh = 0; bh < 2; ++bh) {
            f32x4 al[4]; bf16x8 ka[4][2];
#pragma unroll
            for (int b4 = 0; b4 < 4; ++b4) { const int blk = 4 * bh + b4; al[b4] = *(const LAS f32x4*)(lds + OFF_AL + (16 * blk + 4 * rq) * 4);
#pragma unroll
                for (int ks = 0; ks < 2; ++ks) ka[b4][ks] = *(const LAS bf16x8*)(lds + OFF_KO + (16 * blk + col) * RK + (32 * ks + 8 * rq) * 2); }
            __builtin_amdgcn_sched_barrier(0);
#pragma unroll
            for (int b4 = 0; b4 < 4; ++b4) S[4 * bh + b4] = S[4 * bh + b4] * al[b4];
#pragma unroll
            for (int ks = 0; ks < 2; ++ks)
#pragma unroll
                for (int b4 = 0; b4 < 4; ++b4) S[4 * bh + b4] = __builtin_amdgcn_mfma_f32_16x16x32_bf16(ka[b4][ks], vf[ks], S[4 * bh + b4], 0, 0, 0);
            __builtin_amdgcn_sched_barrier(0);
        }
        __syncthreads();
        if (c0 + 64 < SEQ) SCAN_STORE();
        {
            bf16x8 aa[4][2];
#pragma unroll
            for (int mb = 0; mb < 4; ++mb)
#pragma unroll
                for (int ks = 0; ks < 2; ++ks) if (ks == 0 || mb >= 2) aa[mb][ks] = *(const LAS bf16x8*)(lds + OFF_AT + (16 * mb + col) * RK + (32 * ks + 8 * rq) * 2);
            __builtin_amdgcn_sched_barrier(0);
#pragma unroll
            for (int ks = 0; ks < 2; ++ks)
#pragma unroll
                for (int mb = 0; mb < 4; ++mb) if (ks == 0 || mb >= 2) oacc[mb] = __builtin_amdgcn_mfma_f32_16x16x32_bf16(aa[mb][ks], vf[ks], oacc[mb], 0, 0, 0);
#pragma unroll
            for (int mb = 0; mb < 4; ++mb)
#pragma unroll
                for (int i = 0; i < 4; ++i) *(LAS float*)(lds + OFF_OUT + (16 * mb + 4 * rq + i) * RO + (16 * w + col) * 4) = oacc[mb][i];
        }
        __syncthreads();
        {
            f32x4 ov[4]; float sq = 0.f;
#pragma unroll
            for (int e = 0; e < 4; ++e) { ov[e] = *(const LAS f32x4*)(lds + OFF_OUT + to * RO + (d0 + 4 * e) * 4); sq += (ov[e][0] * ov[e][0] + ov[e][1] * ov[e][1]) + (ov[e][2] * ov[e][2] + ov[e][3] * ov[e][3]); }
            sq += __shfl_xor(sq, 1); sq += __shfl_xor(sq, 2); sq += __shfl_xor(sq, 4);
            const float rn = rsqrtf(sq * (1.0f / 128.0f) + 1e-6f);
            unsigned ow[8];
#pragma unroll
            for (int e = 0; e < 8; ++e) { const unsigned gw = e < 4 ? pg[0][e] : pg[1][e - 4];
                ow[e] = pkbf(ov[e >> 1][(2 * e) & 3] * rn * gn[2 * e] * bflo(gw), ov[e >> 1][(2 * e + 1) & 3] * rn * gn[2 * e + 1] * bfhi(gw)); }
            const size_t g = gbase + (size_t)(c0 + to) * 1024 + d0;
            *(u32x4*)(ho + g) = (u32x4){ow[0], ow[1], ow[2], ow[3]}; *(u32x4*)(ho + g + 8) = (u32x4){ow[4], ow[5], ow[6], ow[7]};
        }
        if (c0 + 64 < SEQ) SCAN_S2();
    }
    __syncthreads();
#undef SCAN_S2
#undef SCAN_LOAD
#undef SCAN_STORE
}
}
static_assert(att::LDS_BYTES <= RING_BYTES && pg8::STAGE_BYTES <= RING_BYTES && hgs::LDS_END <= RING_BYTES && EXTRA_OFF + 4096 <= LDS_BYTES, "LDS map");
__global__ void __launch_bounds__(NWAVES * 64, 2) mk_fwd(Args args) {
    extern __shared__ __attribute__((aligned(16))) unsigned char lds_raw[];
    LAS unsigned char* lds = (LAS unsigned char*)lds_raw;
    volatile LAS unsigned* MISC = (volatile LAS unsigned*)(lds + MISC_OFF);
    const int wave = __builtin_amdgcn_readfirstlane(threadIdx.x >> 6);
    const int tid = wave * 64 + mk_lane();
    const int G = gridDim.x; const int bx = blockIdx.x; const int vcu = (G % 8 == 0) ? (bx % 8) * (G / 8) + bx / 8 : bx;
    gu32* ctl = (gu32*)(args.ws + WS_CTL);
    for (int u = tid; u < (LDS_BYTES - LDSCTL_OFF) / 4; u += NWAVES * 64) ((LAS unsigned*)(lds + LDSCTL_OFF))[u] = 0u;
    __syncthreads();
#if MK_PER_PHASE
#define GRID_BAR() do { } while (0)
#else
    XcdBarrier bar = xcd_barrier_post((unsigned*)(ctl + CW_BAR), MISC + 8, wave == 0 && mk_lane() == 0);
#define GRID_BAR() xcd_barrier(bar, wave == 0 && mk_lane() == 0)
#endif
    const int lo = args.ph_lo, hi = args.ph_hi;
#ifndef REP_PHASE
#define REP_PHASE -1
#define REP_COUNT 2
#endif
#define REPEAT(k) _Pragma("unroll") for (int r_ = 0; r_ < (((k) == REP_PHASE) ? REP_COUNT : 1); ++r_)
#ifndef STAG_TICKS
#define STAG_TICKS 0
#endif
#ifndef MLPOUT_REV
#define MLPOUT_REV 1
#endif
#ifndef GEMM_SP2
#define GEMM_SP2 true
#endif
#ifndef SCAN_SIMPLE
#define SCAN_SIMPLE 0
#endif
#ifndef EXP_SKIP_CONV
#define EXP_SKIP_CONV 0
#endif
#ifndef NO_UQ
#define NO_UQ 0
#endif
#ifndef NO_UKV
#define NO_UKV 0
#endif
#ifndef ONLY_LO
#define ONLY_LO 0
#define ONLY_HI 99
#endif
#define IN(k) ((ONLY_LO) <= (k) && (k) <= (ONLY_HI) && lo <= (k) && (k) < hi)
#define SEAM(k) do { if (IN(k) && IN((k) + 1)) GRID_BAR(); } while (0)
#define WSDEF unsigned long long z_ = 0; asm volatile("" : "+s"(z_)); unsigned char* ws_ = args.ws + z_
#define P_OUT (args.out)
#define P_PV ((const float*)(ws_ + WS_PV))
#define P_POS ((const int*)(P_PV + PV_POS))
#define P_SSB ((pg8::ssq_t*)(ws_ + CTL_SS))
#define P_SSCQ ((pg8::ssq_t*)(ws_ + CTL_SSCQ))
#define P_SSCKV ((pg8::ssq_t*)(ws_ + CTL_SSCKV))
#define P_WB ((pg8::bf16_t*)(ws_ + WS_W))
#define P_XB ((pg8::bf16_t*)(ws_ + WS_XB))
#define P_HH ((pg8::bf16_t*)(ws_ + WS_HH))
#define P_Q ((pg8::bf16_t*)(ws_ + WS_Q))
#define P_K ((pg8::bf16_t*)(ws_ + WS_K))
#define P_V ((pg8::bf16_t*)(ws_ + WS_V))
#define P_O ((pg8::bf16_t*)(ws_ + WS_O))
#define P_CQ ((pg8::bf16_t*)(ws_ + WS_CQ))
#define P_CKV ((pg8::bf16_t*)(ws_ + WS_CKV))
#define P_KR ((pg8::bf16_t*)(ws_ + WS_KR))
#define P_HQ ((pg8::bf16_t*)(ws_ + WS_HQ))
#define P_HV ((pg8::bf16_t*)(ws_ + WS_HV))
#define P_HG ((pg8::bf16_t*)(ws_ + WS_HG))
#define P_HLF ((float*)(ws_ + WS_HLF))
#define P_CU ((pg8::bf16_t*)(ws_ + WS_CU))
#define P_CY ((pg8::bf16_t*)(ws_ + WS_CY))
#define P_LB ((const float*)(ws_ + WS_LB))

#define RUN_GEMM(EpiT, Aptr, Btptr, Nn, Kk, ...) do { pg8::Gemm g_{(Aptr), (Btptr), T, (Nn), (Kk)}; pg8::StaticOrder S_; S_.init(T, (Nn), G, (int)blockIdx.x); \
        EpiT E_{__VA_ARGS__}; pg8::gemm_phase<EpiT, pg8::StaticOrder, true, GEMM_SP2, false, true>(lds + RING_OFF, g_, S_, E_, wave); } while (0)
#define RUN_GEMM_STAG(EpiT, Aptr, Btptr, Nn, Kk, ...) do { pg8::Gemm g_{(Aptr), (Btptr), T, (Nn), (Kk)}; pg8::StaticOrder S_; S_.init(T, (Nn), G, (int)blockIdx.x); \
        EpiT E_{__VA_ARGS__}; pg8::gemm_phase<EpiT, pg8::StaticOrder, true, GEMM_SP2, false, true>(lds + RING_OFF, g_, S_, E_, wave, (int)((blockIdx.x >> 3) & 3) * STAG_TICKS); } while (0)
#define RUN_GEMM_TILED_P(EpiT, Aptr, Btptr, Nn, Kk, ...) do { pg8::Gemm g_{(Aptr), (Btptr), T, (Nn), (Kk)}; pg8::StaticOrder S_; S_.init(T, (Nn), G, (int)blockIdx.x, 2); \
        EpiT E_{__VA_ARGS__}; pg8::gemm_phase<EpiT, pg8::StaticOrder, true, GEMM_SP2, true>(lds + RING_OFF, g_, S_, E_, wave); } while (0)
#define RUN_GEMM_TILED(EpiT, Aptr, Btptr, Nn, Kk, ...) do { pg8::Gemm g_{(Aptr), (Btptr), T, (Nn), (Kk)}; pg8::StaticOrder S_; S_.init(T, (Nn), G, (int)blockIdx.x, MLPOUT_REV); \
        EpiT E_{__VA_ARGS__}; pg8::gemm_phase<EpiT, pg8::StaticOrder, true, GEMM_SP2, true>(lds + RING_OFF, g_, S_, E_, wave); } while (0)

#define MLP_LAYER(l, P) do { \
    if (IN(P) && (P) == REP_PHASE) { WSDEF; RUN_GEMM(EPI_ROW_NOSTORE, P_XB, P_WB + W_MI + (size_t)(l) * FF * D, FF, D, P_HH, FF, P_SSB + (size_t)(2 * (l) + 1) * T, 1.0f / 1024.0f); } \
    if (IN(P)) { WSDEF; RUN_GEMM_STAG(EPI_ROW_TILED, P_XB, P_WB + W_MI + (size_t)(l) * FF * D, FF, D, P_HH, FF, P_SSB + (size_t)(2 * (l) + 1) * T, 1.0f / 1024.0f); } SEAM(P); \
    if (IN((P) + 1) && (P) + 1 == REP_PHASE) { WSDEF; RUN_GEMM_TILED_P(pg8::EpiResid<false>, P_HH, P_WB + W_MO + (size_t)(l) * FF * D, D, FF, P_OUT, P_XB, (const float*)nullptr, (pg8::ssq_t*)(ws_ + CTL_DUMMY), (pg8::bf16_t*)P_OUT); } \
    if (IN((P) + 1)) { WSDEF; if ((l) < 3) { RUN_GEMM_TILED(pg8::EpiResid<false>, P_HH, P_WB + W_MO + (size_t)(l) * FF * D, D, FF, P_OUT, P_XB, (const float*)nullptr, P_SSB + (size_t)(2 * (l) + 2) * T, P_XB); } \
                       else { RUN_GEMM_TILED(pg8::EpiResid<true>, P_HH, P_WB + W_MO + (size_t)(l) * FF * D, D, FF, P_OUT, P_XB, (const float*)nullptr, (pg8::ssq_t*)nullptr, P_XB); } } SEAM((P) + 1); } while (0)

#define MLA_LAYER(j, l, P) do { \
    if (IN(P)) { WSDEF; RUN_GEMM(pg8::EpiDown, P_XB, P_WB + W_DN + (size_t)(j) * 768 * D, 768, D, P_SSB + (size_t)(2 * (l)) * T, P_CQ, P_CKV, P_KR, P_SSCQ + (size_t)(j) * T, P_SSCKV + (size_t)(j) * T); } \
    if (IN(P) && (j) == 0 && bx >= 128) { OPQ; p0_weights<3>(args, lds, (bx - 128) * NWAVES + w_, 128 * NWAVES, l_, w_); }     \
    SEAM(P); \
    if (IN((P) + 1)) { { WSDEF; OPQ; kr_finalize(P_POS, P_PV + PV_GK + (j) * 192, P_KR, (float*)(ws_ + WS_CS), vcu, G, l_, w_); } \
                       { WSDEF; RUN_GEMM(pg8::EpiUQ, P_CQ, P_WB + W_UQ + (size_t)(j) * 1536 * 384, 1536, 384, P_SSCQ + (size_t)(j) * T, P_Q); } \
                       { WSDEF; RUN_GEMM(pg8::EpiUKV, P_CKV, P_WB + W_UKV + (size_t)(j) * 2048 * 256, 2048, 256, P_SSCKV + (size_t)(j) * T, P_K, P_V, P_PV + PV_GK + (j) * 192, (PG8_LAS float*)(lds + EXTRA_OFF)); } } SEAM((P) + 1); \
    if (IN((P) + 3)) REPEAT((P) + 3) { WSDEF; att::attn_phase((char*)lds_raw + RING_OFF, P_Q, P_K, P_KR, P_V, P_O, P_PV + PV_GQ + (j) * 192, (const float*)(ws_ + WS_CS), G, (int)blockIdx.x, wave); } SEAM((P) + 3); \
    if (IN((P) + 4) && (P) + 4 == REP_PHASE) { WSDEF; RUN_GEMM(pg8::EpiResid<false>, P_O, P_WB + W_AO + (size_t)(j) * D * D, D, D, P_OUT, P_XB, (const float*)nullptr, (pg8::ssq_t*)(ws_ + CTL_DUMMY), (pg8::bf16_t*)P_OUT); } \
    if (IN((P) + 4)) { WSDEF; RUN_GEMM(pg8::EpiResid<false>, P_O, P_WB + W_AO + (size_t)(j) * D * D, D, D, P_OUT, P_XB, (const float*)nullptr, P_SSB + (size_t)(2 * (l) + 1) * T, P_XB); } SEAM((P) + 4); } while (0)

#define EPI_RESID_BIAS pg8::EpiResid<false, true>
#define EPI_ROW_NOSTORE pg8::EpiRow<1, true>
#define EPI_ROW_TILED pg8::EpiRow<1, false, true>
#define OPQ int t_ = wave * 64 + mk_lane(); asm volatile("" : "+v"(t_)); const int l_ = t_ & 63, w_ = __builtin_amdgcn_readfirstlane(t_ >> 6)
    if (IN(0)) REPEAT(0) { OPQ; p0_prologue(args, lds, vcu, G, t_, l_, w_); } SEAM(0);
#if REP_PHASE == 99
    {
        typedef float f32x16 __attribute__((ext_vector_type(16))); typedef short bf16x8v __attribute__((ext_vector_type(8)));
        f32x16 c0 = {}, c1 = {}, c2 = {}, c3 = {}; bf16x8v a = {1, 2, 3, 4, 5, 6, 7, 8}, b = {8, 7, 6, 5, 4, 3, 2, 1};
        asm volatile("" : "+v"(a), "+v"(b));
        for (int it = 0; it < 8192; ++it) {
            c0 = __builtin_amdgcn_mfma_f32_32x32x16_bf16(a, b, c0, 0, 0, 0); c1 = __builtin_amdgcn_mfma_f32_32x32x16_bf16(a, b, c1, 0, 0, 0);
            c2 = __builtin_amdgcn_mfma_f32_32x32x16_bf16(a, b, c2, 0, 0, 0); c3 = __builtin_amdgcn_mfma_f32_32x32x16_bf16(a, b, c3, 0, 0, 0);
        }
        int never = 0; asm volatile("" : "+s"(never));
        if (never) { float s = 0.f; for (int e = 0; e < 16; ++e) s += c0[e] + c1[e] + c2[e] + c3[e]; args.out[tid] = s; }
    }
#endif
    MLA_LAYER(0, 0, 1);
    MLP_LAYER(0, 6);
    if (IN(8)) REPEAT(8) { WSDEF; RUN_GEMM(pg8::EpiHG, P_XB, P_WB + W_HI, FF, D, P_SSB + (size_t)2 * T, P_LB, P_HQ, P_HLF, (size_t)(WS_HV - WS_HQ) / 2); } SEAM(8);
    if (IN(9) && bx >= 128) { OPQ; p0_weights<1>(args, lds, (bx - 128) * NWAVES + w_, 128 * NWAVES, l_, w_); }
    if (IN(9)) { WSDEF; const int nrep9 = (REP_PHASE == 9) ? args.pad : 1; for (int r9 = 0; r9 < nrep9; ++r9) { if (bx < 128) hgs::scan_unit(lds, P_HQ, P_HV, P_HG, P_HLF, P_PV + PV_ON, (r9 + 1 < nrep9) ? (unsigned short*)P_OUT : P_HQ, bx, wave); } } SEAM(9);
    if (IN(10)) { WSDEF; RUN_GEMM(pg8::EpiResid<false>, P_HQ, P_WB + W_HO, D, D, P_OUT, P_XB, (const float*)nullptr, P_SSB + (size_t)3 * T, P_XB); } SEAM(10);
    MLP_LAYER(1, 11);
    if (IN(13)) REPEAT(13) { WSDEF; RUN_GEMM(pg8::EpiGLU, P_XB, P_WB + W_P1, 2048, D, P_SSB + (size_t)4 * T, P_PV + PV_BP1, P_CU); } SEAM(13);
    if (IN(14)) REPEAT(14) { WSDEF; OPQ; conv_phase(lds, P_CU, P_CY, P_PV + PV_WDW, P_PV + PV_BDW, P_PV + PV_LNG, P_PV + PV_LNB, vcu, G, t_, l_, w_); } SEAM(14);
    if (IN(15)) { WSDEF; RUN_GEMM(EPI_RESID_BIAS, P_CY, P_WB + W_P2, D, D, P_OUT, P_XB, P_PV + PV_BP2, P_SSB + (size_t)5 * T, P_XB); } SEAM(15);
    MLP_LAYER(2, 16);
    MLA_LAYER(1, 3, 18);
    MLP_LAYER(3, 23);
#undef IN
#undef SEAM
}

extern "C" void kernel_launch(void* const* d_in, const int* in_sizes, int n_in, void* d_out, int out_size, void* d_ws, size_t ws_size, hipStream_t stream) {
    static int grid = 0;
    if (grid == 0) {
        if (n_in != 26 || in_sizes[0] != T * D || out_size != T * D || ws_size < WS_END) { fprintf(stderr, "kernel_launch: unexpected shapes (n_in %d, in0 %d, out %d, ws %zu)\n", n_in, n_in > 0 ? in_sizes[0] : -1, out_size, ws_size); grid = -1; return; }
        int dev = 0, cus = 0, per_cu = 0;
        if (hipGetDevice(&dev) != hipSuccess || hipDeviceGetAttribute(&cus, hipDeviceAttributeMultiprocessorCount, dev) != hipSuccess) { grid = -1; return; }
        if (hipFuncSetAttribute((const void*)mk_fwd, hipFuncAttributeMaxDynamicSharedMemorySize, LDS_BYTES) != hipSuccess) { fprintf(stderr, "kernel_launch: hipFuncSetAttribute failed\n"); grid = -1; return; }
        if (hipOccupancyMaxActiveBlocksPerMultiprocessor(&per_cu, (const void*)mk_fwd, NWAVES * 64, LDS_BYTES) != hipSuccess || per_cu < 1) { fprintf(stderr, "kernel_launch: occupancy query says %d\n", per_cu); }
        (void)hipGetLastError();
        grid = cus;
    }
    if (grid < 0) return;
    if (hipMemsetAsync((char*)d_ws + WS_CTL, 0, CTL_ZERO_BYTES, stream) != hipSuccess) return;
    Args a{};
    for (int i = 0; i < 26; ++i) a.in[i] = (const float*)d_in[i];
    a.out = (float*)d_out; a.ws = (unsigned char*)d_ws; a.pad = (REP_PHASE == 9) ? 2 : 0;
#if MK_PER_PHASE
    for (int p = 0; p < NPHASE; ++p) { a.ph_lo = p; a.ph_hi = p + 1; a.li = p; hipLaunchKernelGGL(mk_fwd, dim3(grid), dim3(NWAVES * 64), LDS_BYTES, stream, a); }
#else
    a.ph_lo = 0; a.ph_hi = NPHASE; a.li = 0;
    hipLaunchKernelGGL(mk_fwd, dim3(grid), dim3(NWAVES * 64), LDS_BYTES, stream, a);
#endif
}
```

```cpp
#include <hip/hip_runtime.h>
#include <cstdio>
#include <cstdint>
#include <cmath>
__device__ __forceinline__ int mk_lane() { int l; asm volatile("v_mbcnt_lo_u32_b32 %0, -1, 0\n\tv_mbcnt_hi_u32_b32 %0, -1, %0" : "=v"(l)); return l; }
namespace pg8 {
#define PG8_LAS __attribute__((address_space(3)))
typedef unsigned short bf16_t;
typedef short bf16x8 __attribute__((ext_vector_type(8)));
typedef float f32x4 __attribute__((ext_vector_type(4)));
typedef unsigned u32x4 __attribute__((ext_vector_type(4)));
constexpr int BM = 256, BK = 64, HALF = 128, HTB = HALF * BK * 2  , STAGE_BYTES = 8 * HTB, NXCD = 8, WGM = 8;

__host__ __device__ __forceinline__ int lds_byte(int r, int c) { const int st = (r >> 4) * 2 + (c >> 5), rr = r & 15, cc = c & 31, ob = rr * 64 + cc * 2; return st * 1024 + (ob ^ (((ob >> 9) & 1) << 5)); }
__host__ __device__ __forceinline__ void stage_rc(int b, int& R, int& C) { const int st = b / 1024, sb = b % 1024, swz = sb ^ (((sb >> 9) & 1) << 5); R = (st >> 1) * 16 + swz / 64; C = (st & 1) * 32 + (swz % 64) / 2; }
__host__ __device__ __forceinline__ int perm32(int rho) { const int n = rho >> 4, i = rho & 15; return 8 * (i >> 2) + 4 * n + (i & 3); }

struct Unit { int pm, pn; };
struct Gemm { const bf16_t* A; const bf16_t* Bt; int M, N, K; };

struct StaticOrder {
    int nM, nN, nwg, G, c, rev;
    __host__ __device__ void init(int M, int N, int G_, int c_, int rev_ = 0) { nM = M / BM; nN = N / BM; nwg = nM * nN; G = G_; c = c_; rev = rev_; }
    __host__ __device__ bool next(int i, Unit& u) const {
        const long L = (long)i * G + c; if (L >= nwg) return false;
        int wgid = (int)L; { const int q = nwg / NXCD, r = nwg % NXCD, xcd = wgid % NXCD, off = wgid / NXCD; wgid = (xcd < r ? xcd * (q + 1) : r * (q + 1) + (xcd - r) * q) + off; }
        const int nig = WGM * nN, gid = wgid / nig, fm = gid * WGM, gsz = (nM - fm) < WGM ? (nM - fm) : WGM;
        u.pm = fm + ((wgid % nig) % gsz); u.pn = (wgid % nig) / gsz; if (rev == 1) u.pm = nM - 1 - u.pm; if (rev == 2) u.pm = u.pm & 7; return true;
    }
    __device__ __forceinline__ void a_ready(const Unit&) const {}
    __device__ __forceinline__ void done(const Unit&) const {}
};
__device__ __forceinline__ unsigned cvt_pk_bf16(float lo, float hi) { unsigned r; asm volatile("v_cvt_pk_bf16_f32 %0, %1, %2" : "=v"(r) : "v"(lo), "v"(hi)); return r; }
constexpr float RMS_EPS = 1e-6f;
typedef unsigned long long ssq_t;
constexpr float SS_SCALE = 1048576.0f, SS_INV = 1.0f / 1048576.0f;
__device__ __forceinline__ float row_rstd(const ssq_t* ss, int row, float inv_n) { return rsqrtf((float)ss[row] * (inv_n * SS_INV) + RMS_EPS); }
__device__ __forceinline__ void row_rstd8(float (&rs)[2][4], const ssq_t* ss, int row0, float inv_n) {
    ssq_t v[2][4];
#pragma unroll
    for (int ai = 0; ai < 2; ++ai)
#pragma unroll
        for (int m = 0; m < 4; ++m) v[ai][m] = ss[row0 + ai * HALF + m * 16];
#pragma unroll
    for (int ai = 0; ai < 2; ++ai)
#pragma unroll
        for (int m = 0; m < 4; ++m) rs[ai][m] = rsqrtf((float)v[ai][m] * (inv_n * SS_INV) + RMS_EPS);
}
__device__ __forceinline__ void ss_add(ssq_t* p, float v) { (void)__hip_atomic_fetch_add(p, (ssq_t)(v * SS_SCALE + 0.5f), __ATOMIC_RELAXED, __HIP_MEMORY_SCOPE_AGENT); }
__device__ __forceinline__ float sigm(float x) { return __builtin_amdgcn_rcpf(1.0f + __expf(-x)); }
__device__ __forceinline__ u32x4 pack8v(f32x4 a, f32x4 b) { u32x4 w; w.x = cvt_pk_bf16(a[0], a[1]); w.y = cvt_pk_bf16(a[2], a[3]); w.z = cvt_pk_bf16(b[0], b[1]); w.w = cvt_pk_bf16(b[2], b[3]); return w; }
__device__ __forceinline__ float dot4(f32x4 a) { return (a[0] * a[0] + a[1] * a[1]) + (a[2] * a[2] + a[3] * a[3]); }
__device__ __forceinline__ float quad_sum(float s) { s += __shfl_xor(s, 16); s += __shfl_xor(s, 32); return s; }

template <int ACT, bool NOSTORE = false, bool TILEDOUT = false> struct EpiRow {
    static constexpr bool PERM = true, AFTER_DRAIN = false;
    bf16_t* O; int ldc; const ssq_t* ss; float inv_n;
    __device__ __forceinline__ void operator()(const f32x4 (&acc)[2][2][4][2], const Unit& u, int wr, int wc, int fr, int fq) const {
        { const int ln_ = mk_lane(); fr = ln_ & 15; fq = ln_ >> 4; }
        const int row0 = u.pm * BM + wr * 64 + fr, col0 = u.pn * BM + wc * 32 + 8 * fq;
        float rsv[2][4]; row_rstd8(rsv, ss, row0, inv_n);
        int never = 0; asm volatile("" : "+s"(never));
#pragma unroll
        for (int ai = 0; ai < 2; ++ai)
#pragma unroll
            for (int m = 0; m < 4; ++m) {
                const int row = row0 + ai * HALF + m * 16;
                const float rs = rsv[ai][m];
                bf16_t* rowp = TILEDOUT ? O + ((size_t)u.pm * (ldc / 64) + (size_t)(u.pn * 4 + (wc >> 1))) * (BM * 64) + (size_t)(row & 255) * 64 + (wc & 1) * 32 + 8 * fq - (TILEDOUT ? 0 : 0)
                                        : O + (size_t)row * ldc + col0;
#pragma unroll
                for (int bj = 0; bj < 2; ++bj) {
                    f32x4 v0 = acc[ai][bj][m][0] * rs, v1 = acc[ai][bj][m][1] * rs;
                    if (ACT == 1) {
#pragma unroll
                        for (int e = 0; e < 4; ++e) { const float a = fmaxf(v0[e], 0.f), b = fmaxf(v1[e], 0.f); v0[e] = a * a; v1[e] = b * b; }
                    }
                    if (!NOSTORE || never) *(u32x4*)(rowp + (TILEDOUT ? bj * 2 * (BM * 64) : bj * HALF)) = pack8v(v0, v1);
                }
            }
    }
};

__device__ __forceinline__ void unpack8(u32x4 w, f32x4& a, f32x4& b) {
    a = (f32x4){__builtin_bit_cast(float, w.x << 16), __builtin_bit_cast(float, w.x & 0xffff0000u), __builtin_bit_cast(float, w.y << 16), __builtin_bit_cast(float, w.y & 0xffff0000u)};
    b = (f32x4){__builtin_bit_cast(float, w.z << 16), __builtin_bit_cast(float, w.z & 0xffff0000u), __builtin_bit_cast(float, w.w << 16), __builtin_bit_cast(float, w.w & 0xffff0000u)};
}
template <bool LAST, bool HAS_BIAS = false> struct EpiResid {
    static constexpr bool PERM = true, AFTER_DRAIN = false;
    float* xout; bf16_t* xb; const float* bias; ssq_t* ssn; bf16_t* xbw;
    __device__ __forceinline__ void operator()(const f32x4 (&acc)[2][2][4][2], const Unit& u, int wr, int wc, int fr, int fq) const {
        { const int ln_ = mk_lane(); fr = ln_ & 15; fq = ln_ >> 4; }
        const int row0 = u.pm * BM + wr * 64 + fr, col0 = u.pn * BM + wc * 32 + 8 * fq;
        f32x4 (&accw)[2][2][4][2] = const_cast<f32x4 (&)[2][2][4][2]>(acc);
        if (HAS_BIAS) {
#pragma unroll
            for (int bj = 0; bj < 2; ++bj)
#pragma unroll
                for (int n = 0; n < 2; ++n) { const f32x4 bvv = *(const f32x4*)(bias + col0 + bj * HALF + 4 * n);
#pragma unroll
                    for (int ai = 0; ai < 2; ++ai)
#pragma unroll
                        for (int m = 0; m < 4; ++m) accw[ai][bj][m][n] += bvv; }
        }
        constexpr int NB_ = HAS_BIAS ? 2 : 1, AI_ = HAS_BIAS ? 1 : 2;
#pragma unroll
        for (int hb = 0; hb < NB_; ++hb) {
            u32x4 xr[AI_][4][2];
#pragma unroll
            for (int a2 = 0; a2 < AI_; ++a2)
#pragma unroll
                for (int m = 0; m < 4; ++m)
#pragma unroll
                    for (int bj = 0; bj < 2; ++bj) xr[a2][m][bj] = *(const u32x4*)(xb + (size_t)(row0 + (hb * AI_ + a2) * HALF + m * 16) * 1024 + col0 + bj * HALF);
#pragma unroll
            for (int a2 = 0; a2 < AI_; ++a2)
#pragma unroll
                for (int m = 0; m < 4; ++m) {
                    const int ai = hb * AI_ + a2;
                    const int row = row0 + ai * HALF + m * 16;
                    const size_t off = (size_t)row * 1024 + col0;
                    float sq = 0.f;
#pragma unroll
                    for (int bj = 0; bj < 2; ++bj) {
                        f32x4 x0, x1; unpack8(xr[a2][m][bj], x0, x1);
                        const f32x4 v0 = accw[ai][bj][m][0] + x0, v1 = accw[ai][bj][m][1] + x1;
                        if (LAST) { *(f32x4*)(xout + off + bj * HALF) = v0; *(f32x4*)(xout + off + bj * HALF + 4) = v1; }
                        else { const u32x4 w = pack8v(v0, v1); *(u32x4*)(xbw + off + bj * HALF) = w; f32x4 r0, r1; unpack8(w, r0, r1); sq += dot4(r0) + dot4(r1); }
                    }
                    if (!LAST) { sq = quad_sum(sq); if (fq == 0) ss_add(ssn + row, sq); }
                }
        }
    }
};

struct EpiDown {
    static constexpr bool PERM = true, AFTER_DRAIN = false;
    const ssq_t* ss; bf16_t* cq; bf16_t* ckv; bf16_t* kr; ssq_t* sscq; ssq_t* ssckv;
    __device__ __forceinline__ void operator()(const f32x4 (&acc)[2][2][4][2], const Unit& u, int wr, int wc, int fr, int fq) const {
        { const int ln_ = mk_lane(); fr = ln_ & 15; fq = ln_ >> 4; }
        const int row0 = u.pm * BM + wr * 64 + fr, cw = wc * 32 + 8 * fq;
        float rsv[2][4]; row_rstd8(rsv, ss, row0, 1.0f / 1024.0f);
#pragma unroll
        for (int ai = 0; ai < 2; ++ai)
#pragma unroll
            for (int m = 0; m < 4; ++m) {
                const int row = row0 + ai * HALF + m * 16;
                const float rs = rsv[ai][m];
                float sq_q = 0.f, sq_kv = 0.f;
#pragma unroll
                for (int bj = 0; bj < 2; ++bj) {
                    const int seg = u.pn * 2 + bj;
                    const f32x4 v0 = acc[ai][bj][m][0] * rs, v1 = acc[ai][bj][m][1] * rs;
                    const u32x4 w = pack8v(v0, v1);
                    if (seg < 3) { *(u32x4*)(cq + (size_t)row * 384 + seg * 128 + cw) = w; sq_q += dot4(v0) + dot4(v1); }
                    else if (seg < 5) { *(u32x4*)(ckv + (size_t)row * 256 + (seg - 3) * 128 + cw) = w; sq_kv += dot4(v0) + dot4(v1); }
                    else if (wc < 2) { *(u32x4*)(kr + (size_t)row * 64 + cw) = w; }
                }
                sq_q = quad_sum(sq_q); sq_kv = quad_sum(sq_kv);
                if (fq == 0) { if (u.pn <= 1) ss_add(sscq + row, sq_q); if (u.pn >= 1) ss_add(ssckv + row, sq_kv); }
            }
    }
};

struct EpiUQ {
    static constexpr bool PERM = true, AFTER_DRAIN = false;
    const ssq_t* ss; bf16_t* Q;
    __device__ __forceinline__ void operator()(const f32x4 (&acc)[2][2][4][2], const Unit& u, int wr, int wc, int fr, int fq) const {
        { const int ln_ = mk_lane(); fr = ln_ & 15; fq = ln_ >> 4; }
        const int row0 = u.pm * BM + wr * 64 + fr, col0 = u.pn * BM + wc * 32 + 8 * fq;
        float rsv[2][4]; row_rstd8(rsv, ss, row0, 1.0f / 384.0f);
        int hoff[2];
#pragma unroll
        for (int bj = 0; bj < 2; ++bj) { const int col = col0 + bj * HALF, h = col / 192; hoff[bj] = h * (2048 * 192) + (col - h * 192); }
        const int bq = row0 >> 11;
        bf16_t* base = Q + (size_t)bq * (8 * 2048 * 192) + (size_t)(row0 & 2047) * 192;
#pragma unroll
        for (int ai = 0; ai < 2; ++ai)
#pragma unroll
            for (int m = 0; m < 4; ++m) {
                const float rs = rsv[ai][m];
#pragma unroll
                for (int bj = 0; bj < 2; ++bj) {
                    const f32x4 v0 = acc[ai][bj][m][0] * rs, v1 = acc[ai][bj][m][1] * rs;
                    *(u32x4*)(base + (ai * HALF + m * 16) * 192 + hoff[bj]) = pack8v(v0, v1);
                }
            }
    }
};

struct EpiUKV {
    static constexpr bool PERM = true, AFTER_DRAIN = false;
    const ssq_t* ss; bf16_t* Kn; bf16_t* V; const float* gk; PG8_LAS float* X;
    __device__ __forceinline__ void operator()(const f32x4 (&acc)[2][2][4][2], const Unit& u, int wr, int wc, int fr, int fq) const {
        { const int ln_ = mk_lane(); fr = ln_ & 15; fq = ln_ >> 4; }
        const int row0 = u.pm * BM + wr * 64 + fr, cw = wc * 32 + 8 * fq, h = u.pn;
        float rsv[2][4]; row_rstd8(rsv, ss, row0, 1.0f / 256.0f);
        const f32x4 g0 = *(const f32x4*)(gk + cw), g1 = *(const f32x4*)(gk + cw + 4);
        const size_t off0 = ((size_t)(((row0 >> 11) * 8 + h) * 2048 + (row0 & 2047))) * 128 + cw;
#pragma unroll
        for (int ai = 0; ai < 2; ++ai)
#pragma unroll
            for (int m = 0; m < 4; ++m) {
                const float rs = rsv[ai][m];
                const f32x4 a0 = acc[ai][0][m][0] * rs, a1 = acc[ai][0][m][1] * rs;
                const float s = quad_sum(dot4(a0) + dot4(a1));
                if (fq == 0) X[(ai * HALF + wr * 64 + m * 16 + fr) * 4 + wc] = s;
                const size_t off = off0 + (size_t)(ai * HALF + m * 16) * 128;
                { const f32x4 v0 = acc[ai][1][m][0] * rs, v1 = acc[ai][1][m][1] * rs; *(u32x4*)(V + off) = pack8v(v0, v1); }
            }
        asm volatile("s_waitcnt lgkmcnt(0)" ::: "memory"); __builtin_amdgcn_s_barrier(); asm volatile("" ::: "memory");
#pragma unroll
        for (int ai = 0; ai < 2; ++ai)
#pragma unroll
            for (int m = 0; m < 4; ++m) {
                const f32x4 p = *(const PG8_LAS f32x4*)(X + (ai * HALF + wr * 64 + m * 16 + fr) * 4);
                const float rk = rsqrtf(((p[0] + p[1]) + (p[2] + p[3])) * (1.0f / 128.0f) + RMS_EPS) * rsv[ai][m];
                const size_t off = off0 + (size_t)(ai * HALF + m * 16) * 128;
                const f32x4 v0 = acc[ai][0][m][0] * rk * g0, v1 = acc[ai][0][m][1] * rk * g1;
                *(u32x4*)(Kn + off) = pack8v(v0, v1);
            }
    }
};

struct EpiHG {
    static constexpr bool PERM = true, AFTER_DRAIN = false;
    const ssq_t* ss; const float* lb; bf16_t* hq; float* hlf; size_t sec_stride;
    __device__ __forceinline__ void operator()(const f32x4 (&acc)[2][2][4][2], const Unit& u, int wr, int wc, int fr, int fq) const {
        { const int ln_ = mk_lane(); fr = ln_ & 15; fq = ln_ >> 4; }
        const int row0 = u.pm * BM + wr * 64 + fr, sec = u.pn >> 2, cc0 = (u.pn & 3) * BM + wc * 32 + 8 * fq;
        float rsv[2][4]; row_rstd8(rsv, ss, row0, 1.0f / 1024.0f);
        if (sec == 1) {
            f32x4 lbv[2][2];
#pragma unroll
            for (int bj = 0; bj < 2; ++bj)
#pragma unroll
                for (int n = 0; n < 2; ++n) lbv[bj][n] = *(const f32x4*)(lb + cc0 + bj * HALF + 4 * n);
#pragma unroll
            for (int ai = 0; ai < 2; ++ai)
#pragma unroll
                for (int m = 0; m < 4; ++m) {
                    const int row = row0 + ai * HALF + m * 16;
                    const float rs = rsv[ai][m];
#pragma unroll
                    for (int bj = 0; bj < 2; ++bj)
#pragma unroll
                        for (int n = 0; n < 2; ++n) {
                            const f32x4 v = acc[ai][bj][m][n] * rs; f32x4 o;
#pragma unroll
                            for (int e = 0; e < 4; ++e) { const float l = lbv[bj][n][e]; o[e] = __logf(l + (1.0f - l) * sigm(v[e])); }
                            *(f32x4*)(hlf + (size_t)row * 1024 + cc0 + bj * HALF + 4 * n) = o;
                        }
                }
        } else {
            bf16_t* dst = hq + (size_t)((sec + 1) >> 1) * sec_stride;
#pragma unroll
            for (int ai = 0; ai < 2; ++ai)
#pragma unroll
                for (int m = 0; m < 4; ++m) {
                    const int row = row0 + ai * HALF + m * 16;
                    const float rs = rsv[ai][m];
#pragma unroll
                    for (int bj = 0; bj < 2; ++bj) {
                        f32x4 v0 = acc[ai][bj][m][0] * rs, v1 = acc[ai][bj][m][1] * rs;
                        if (sec == 3) {
#pragma unroll
                            for (int e = 0; e < 4; ++e) { v0[e] = v0[e] * sigm(v0[e]); v1[e] = v1[e] * sigm(v1[e]); }
                        }
                        *(u32x4*)(dst + (size_t)row * 1024 + cc0 + bj * HALF) = pack8v(v0, v1);
                    }
                }
        }
    }
};

struct EpiGLU {
    static constexpr bool PERM = true, AFTER_DRAIN = false;
    const ssq_t* ss; const float* bias; bf16_t* cu;
    __device__ __forceinline__ void operator()(const f32x4 (&acc)[2][2][4][2], const Unit& u, int wr, int wc, int fr, int fq) const {
        { const int ln_ = mk_lane(); fr = ln_ & 15; fq = ln_ >> 4; }
        const int row0 = u.pm * BM + wr * 64 + fr, j0 = u.pn * HALF + wc * 32 + 8 * fq;
        const f32x4 ba0 = *(const f32x4*)(bias + j0), ba1 = *(const f32x4*)(bias + j0 + 4), bg0 = *(const f32x4*)(bias + 1024 + j0), bg1 = *(const f32x4*)(bias + 1024 + j0 + 4);
        float rsv[2][4]; row_rstd8(rsv, ss, row0, 1.0f / 1024.0f);
#pragma unroll
        for (int ai = 0; ai < 2; ++ai)
#pragma unroll
            for (int m = 0; m < 4; ++m) {
                const int row = row0 + ai * HALF + m * 16;
                const float rs = rsv[ai][m];
                f32x4 a0 = acc[ai][0][m][0] * rs + ba0, a1 = acc[ai][0][m][1] * rs + ba1;
                const f32x4 g0 = acc[ai][1][m][0] * rs + bg0, g1 = acc[ai][1][m][1] * rs + bg1;
#pragma unroll
                for (int e = 0; e < 4; ++e) { a0[e] *= sigm(g0[e]); a1[e] *= sigm(g1[e]); }
                *(u32x4*)(cu + (size_t)row * 1024 + j0) = pack8v(a0, a1);
            }
    }
};
template <class Epi, class Sched, bool ALIGN_EPI = false, bool SP2 = false, bool TILED = false, bool TILEDB = TILED>
__device__ __forceinline__ void gemm_phase(PG8_LAS unsigned char* lds, const Gemm g, const Sched& S, const Epi& E, int wave_s, int stagger_ticks = 0) {
    int tid_ = wave_s * 64 + mk_lane(); asm volatile("" : "+v"(tid_));
    const int tid = tid_, wid = __builtin_amdgcn_readfirstlane(tid >> 6), lane = tid & 63, wr = wid >> 2, wc = wid & 3, fr = lane & 15, fq = lane >> 4;
    const int K = g.K, nt = K / BK;
    unsigned voffA[2], voffB[2];
#pragma unroll
    for (int i = 0; i < 2; ++i) { int R, C; stage_rc(tid * 16 + i * 8192, R, C); const int Rb = Epi::PERM ? ((R & ~31) + perm32(R & 31)) : R;
        voffA[i] = (unsigned)(R * (TILED ? BK : K) + C) * 2u; voffB[i] = (unsigned)(Rb * (TILEDB ? BK : K) + C) * 2u; }
    const size_t kstep = TILED ? (size_t)(BM * BK * 2) : (size_t)(BK * 2), kstepB = TILEDB ? (size_t)(BM * BK * 2) : (size_t)(BK * 2);
    const size_t hstep = TILED ? (size_t)(HALF * BK * 2) : (size_t)HALF * K * 2, hstepB = TILEDB ? (size_t)(HALF * BK * 2) : (size_t)HALF * K * 2;
    const size_t tstep = (size_t)BM * K * 2;
    const unsigned ldsw = (unsigned)wid * 1024u;
    const int aoff = lds_byte(wr * 64 + fr, fq * 8), boff = lds_byte(wc * 32 + fr, fq * 8);
#define PG8_SA(b, h) (((b) * 2 + (h)) * HTB)
#define PG8_SB(b, h) ((4 + (b) * 2 + (h)) * HTB)
#define PG8_STAGE(bufoff, gbase, voff) do { _Pragma("unroll") for (int _i = 0; _i < 2; ++_i) \
        __builtin_amdgcn_global_load_lds((const unsigned*)((const char*)(gbase) + (voff)[_i]), (PG8_LAS unsigned*)(lds + (bufoff) + ldsw + _i * 8192), 16, 0, 0); } while (0)
#define PG8_LDA(dst, b, h) do { _Pragma("unroll") for (int m = 0; m < 4; ++m) _Pragma("unroll") for (int k = 0; k < 2; ++k) dst[m][k] = *(const PG8_LAS bf16x8*)(lds + PG8_SA(b, h) + aoff + m * 2048 + k * 1024); } while (0)
#define PG8_LDB(dst, b, h) do { _Pragma("unroll") for (int n = 0; n < 2; ++n) _Pragma("unroll") for (int k = 0; k < 2; ++k) dst[n][k] = *(const PG8_LAS bf16x8*)(lds + PG8_SB(b, h) + boff + n * 2048 + k * 1024); } while (0)
#define PG8_MMA(ai, bj, At, Bt) do { __builtin_amdgcn_s_setprio(1); _Pragma("unroll") for (int m = 0; m < 4; ++m) _Pragma("unroll") for (int n = 0; n < 2; ++n) _Pragma("unroll") for (int k = 0; k < 2; ++k) \
        acc[ai][bj][m][n] = __builtin_amdgcn_mfma_f32_16x16x32_bf16(Bt[n][k], At[m][k], acc[ai][bj][m][n], 0, 0, 0); __builtin_amdgcn_s_setprio(0); } while (0)
#define PG8_WAIT_V(n) asm volatile("s_waitcnt vmcnt(" #n ")" ::: "memory")
#define PG8_WAIT_L(n) asm volatile("s_waitcnt lgkmcnt(" #n ")" ::: "memory")
#define PG8_BAR __builtin_amdgcn_s_barrier()
#define PG8_SCHED __builtin_amdgcn_sched_barrier(0)
    Unit cur, nxt; int ui = 0;
    if (!S.next(0, cur)) return;
    if (stagger_ticks > 0) { const unsigned long long t0_ = __builtin_amdgcn_s_memrealtime(); while (__builtin_amdgcn_s_memrealtime() - t0_ < (unsigned long long)stagger_ticks) __builtin_amdgcn_s_sleep(8); }
    f32x4 acc[2][2][4][2];
#pragma unroll
    for (int a = 0; a < 2; ++a)
#pragma unroll
        for (int b = 0; b < 2; ++b)
#pragma unroll
            for (int m = 0; m < 4; ++m)
#pragma unroll
                for (int n = 0; n < 2; ++n) acc[a][b][m][n] = (f32x4){0.f, 0.f, 0.f, 0.f};
    bf16x8 At[4][2], B0[2][2], B1[2][2];
    const char* cA = (const char*)g.A + (size_t)cur.pm * tstep; const char* cB = (const char*)g.Bt + (size_t)cur.pn * tstep;
    S.a_ready(cur);
    if constexpr (SP2) {
        PG8_STAGE(PG8_SB(0, 0), cB, voffB); PG8_STAGE(PG8_SB(0, 1), cB + hstepB, voffB); PG8_STAGE(PG8_SA(0, 0), cA, voffA); PG8_STAGE(PG8_SA(0, 1), cA + hstep, voffA);
        if (wr == 1) PG8_BAR;
        PG8_WAIT_V(2); PG8_BAR;
        PG8_STAGE(PG8_SB(1, 0), cB + kstepB, voffB); PG8_STAGE(PG8_SA(1, 0), cA + kstep, voffA); PG8_STAGE(PG8_SB(1, 1), cB + hstepB + kstepB, voffB);
        PG8_WAIT_V(6); PG8_BAR;
    } else {
        PG8_STAGE(PG8_SB(0, 0), cB, voffB); PG8_STAGE(PG8_SA(0, 0), cA, voffA); PG8_STAGE(PG8_SB(0, 1), cB + hstepB, voffB); PG8_STAGE(PG8_SA(0, 1), cA + hstep, voffA);
        if (wr == 1) PG8_BAR;
        PG8_WAIT_V(4); PG8_BAR;
        PG8_STAGE(PG8_SB(1, 0), cB + kstepB, voffB); PG8_STAGE(PG8_SA(1, 0), cA + kstep, voffA); PG8_STAGE(PG8_SB(1, 1), cB + hstepB + kstepB, voffB);
        PG8_WAIT_V(6); PG8_BAR;
    }
    for (;;) {
        const bool has_next = S.next(ui + 1, nxt);
        const char* nA = has_next ? (const char*)g.A + (size_t)nxt.pm * tstep : cA; const char* nB = has_next ? (const char*)g.Bt + (size_t)nxt.pn * tstep : cB;
#pragma unroll 1
        for (int t = 0; t < nt; t += 2) {
            const bool last = (t == nt - 2);
            const char* a1 = cA + (size_t)(t + 1) * kstep;
            const char* a2 = last ? nA : cA + (size_t)(t + 2) * kstep; const char* b2 = last ? nB : cB + (size_t)(t + 2) * kstepB;
            const char* a3 = a2 + kstep; const char* b3 = b2 + kstepB;
            if (last && has_next) S.a_ready(nxt);
            if constexpr (SP2) {
            PG8_LDB(B0, 0, 0); PG8_LDB(B1, 0, 1); PG8_SCHED; PG8_LDA(At, 0, 0); PG8_STAGE(PG8_SA(1, 1), a1 + hstep, voffA);
            PG8_WAIT_V(8); PG8_WAIT_L(0); PG8_BAR; PG8_MMA(0, 0, At, B0); PG8_MMA(0, 1, At, B1); PG8_BAR; PG8_SCHED;
            PG8_LDA(At, 0, 1); PG8_STAGE(PG8_SB(0, 0), b2, voffB); PG8_STAGE(PG8_SB(0, 1), b2 + hstepB, voffB); PG8_STAGE(PG8_SA(0, 0), a2, voffA);
            PG8_WAIT_V(8); PG8_WAIT_L(0); PG8_BAR; PG8_MMA(1, 0, At, B0); PG8_MMA(1, 1, At, B1); PG8_BAR; PG8_SCHED;
            PG8_LDB(B0, 1, 0); PG8_LDB(B1, 1, 1); PG8_SCHED; PG8_LDA(At, 1, 0); PG8_STAGE(PG8_SA(0, 1), a2 + hstep, voffA);
            PG8_WAIT_V(8); PG8_WAIT_L(0); PG8_BAR; PG8_MMA(0, 0, At, B0); PG8_MMA(0, 1, At, B1); PG8_BAR; PG8_SCHED;
            PG8_LDA(At, 1, 1); PG8_STAGE(PG8_SB(1, 0), b3, voffB); PG8_STAGE(PG8_SB(1, 1), b3 + hstepB, voffB); PG8_STAGE(PG8_SA(1, 0), a3, voffA);
            PG8_WAIT_V(8); PG8_WAIT_L(0); PG8_BAR; PG8_MMA(1, 0, At, B0); PG8_MMA(1, 1, At, B1); PG8_BAR; PG8_SCHED;
            } else {
            PG8_LDB(B0, 0, 0); PG8_SCHED; PG8_LDA(At, 0, 0); PG8_STAGE(PG8_SA(1, 1), a1 + hstep, voffA);
            PG8_WAIT_L(8); PG8_BAR; PG8_WAIT_L(0); PG8_MMA(0, 0, At, B0); PG8_BAR; PG8_SCHED;
            PG8_LDB(B1, 0, 1); PG8_STAGE(PG8_SB(0, 0), b2, voffB);
            PG8_BAR; PG8_WAIT_L(0); PG8_MMA(0, 1, At, B1); PG8_BAR;
            PG8_LDA(At, 0, 1); PG8_STAGE(PG8_SA(0, 0), a2, voffA);
            PG8_BAR; PG8_WAIT_L(0); PG8_MMA(1, 0, At, B0); PG8_BAR; PG8_SCHED;
            PG8_STAGE(PG8_SB(0, 1), b2 + hstepB, voffB);
            PG8_WAIT_V(6); PG8_BAR; PG8_MMA(1, 1, At, B1); PG8_BAR;
            PG8_LDB(B0, 1, 0); PG8_SCHED; PG8_LDA(At, 1, 0); PG8_STAGE(PG8_SA(0, 1), a2 + hstep, voffA);
            PG8_WAIT_L(8); PG8_BAR; PG8_WAIT_L(0); PG8_MMA(0, 0, At, B0); PG8_BAR; PG8_SCHED;
            PG8_LDB(B1, 1, 1); PG8_STAGE(PG8_SB(1, 0), b3, voffB);
            PG8_BAR; PG8_WAIT_L(0); PG8_MMA(0, 1, At, B1); PG8_BAR;
            PG8_LDA(At, 1, 1); PG8_STAGE(PG8_SA(1, 0), a3, voffA);
            PG8_BAR; PG8_WAIT_L(0); PG8_MMA(1, 0, At, B0); PG8_BAR; PG8_SCHED;
            PG8_STAGE(PG8_SB(1, 1), b3 + hstepB, voffB);
            PG8_WAIT_V(6); PG8_BAR; PG8_MMA(1, 1, At, B1); PG8_BAR;
            }
        }
        if constexpr (ALIGN_EPI) { if (wr == 0) PG8_BAR; }
        if constexpr (!Epi::AFTER_DRAIN) { E(acc, cur, wr, wc, fr, fq); S.done(cur); }
        if (!has_next) break;
#pragma unroll
        for (int a = 0; a < 2; ++a)
#pragma unroll
            for (int b = 0; b < 2; ++b)
#pragma unroll
                for (int m = 0; m < 4; ++m)
#pragma unroll
                    for (int n = 0; n < 2; ++n) acc[a][b][m][n] = (f32x4){0.f, 0.f, 0.f, 0.f};
        cur = nxt; cA = nA; cB = nB; ++ui;
        if constexpr (ALIGN_EPI) { if (wr == 1) PG8_BAR; }
    }
    PG8_WAIT_V(0);
    if constexpr (!ALIGN_EPI) { if (wr == 0) PG8_BAR; }
    PG8_BAR;
    if constexpr (Epi::AFTER_DRAIN) { E.fused(acc, cur, wr, wc, fr, fq, lds, wid, lane); S.done(cur); }
#undef PG8_SA
#undef PG8_SB
#undef PG8_STAGE
#undef PG8_LDA
#undef PG8_LDB
#undef PG8_MMA
#undef PG8_WAIT_V
#undef PG8_WAIT_L
#undef PG8_BAR
#undef PG8_SCHED
}
}
namespace att {
typedef unsigned short bf16;
typedef short bf16x8 __attribute__((ext_vector_type(8)));
typedef short s16x4 __attribute__((ext_vector_type(4)));
typedef float f32x16 __attribute__((ext_vector_type(16)));
typedef float f32x4 __attribute__((ext_vector_type(4)));
typedef unsigned u32x4 __attribute__((ext_vector_type(4)));
constexpr int NW = 8, QBLK = 32, KVBLK = 64, QB = NW * QBLK;
constexpr int DN = 128, DR = 64, DQ = 192, DV = 128, SEQ = 2048, NH = 8, NB = 16, OSTR = 1024;
constexpr int SHM_V = KVBLK * DV * 2, SHM_K = KVBLK * DN * 2, RPAD = 144, SHM_R = KVBLK * RPAD;
constexpr int OFF_V = 0, OFF_K = 3 * SHM_V, OFF_R = OFF_K + 2 * SHM_K, OFF_WS = OFF_R + 2 * SHM_R, OFF_QS = OFF_WS + NW * 64 * 4, LDS_BYTES = OFF_QS + NW * 4096;
constexpr float SCALE = 0.07216878364870323f;
constexpr float THR = 8.f;
constexpr int WIN = 1 << 30;

#define KSWZ(row, colB) ((row) * 256 + ((colB) ^ (((row) & 7) << 4)))
#define SBAR() __builtin_amdgcn_sched_barrier(0)
__device__ __forceinline__ int v_st(int k, int c) { const int kk = (k & ~0xC) | ((k & 4) << 1) | ((k & 8) >> 1); return ((kk >> 3) * 4 + (c >> 5)) * 512 + ((kk & 7) * 32 + (c & 31)) * 2; }
__device__ __forceinline__ int v_rd_base(int lane) { return ((lane & 3) << 3) | (((lane >> 2) & 3) << 6) | (((lane >> 4) & 1) << 5) | (((lane >> 5) & 1) << 8); }
constexpr int v_rd_off(int d0, int ks, int half) { return d0 * 512 + ks * 4096 + half * 2048; }
__device__ __forceinline__ int crow(int r, int hi) { return (r & 3) + 8 * (r >> 2) + 4 * hi; }
__device__ __forceinline__ unsigned cvtpk(float lo, float hi) { unsigned r; asm volatile("v_cvt_pk_bf16_f32 %0, %1, %2" : "=v"(r) : "v"(lo), "v"(hi)); return r; }
__device__ __forceinline__ bf16x8 load8(const bf16* p) { return *reinterpret_cast<const bf16x8*>(p); }
__device__ __forceinline__ void mask_tile(f32x16& p0, f32x16& p1, int dq, unsigned W) {
    const float NEG = -__builtin_inff();
#pragma unroll
    for (int r = 0; r < 16; ++r) {
        const int c = (r & 3) + 8 * (r >> 2);
        if ((unsigned)(dq - c) >= W) p0[r] = NEG;
        if ((unsigned)(dq - c - 32) >= W) p1[r] = NEG;
    }
}
__device__ __forceinline__ void partialSM(f32x16& p0, f32x16& p1, float& m_reg, float& mn, float& alpha) {
    float pmax = p0[0]; for (int r = 1; r < 16; ++r) pmax = fmaxf(pmax, p0[r]); for (int r = 0; r < 16; ++r) pmax = fmaxf(pmax, p1[r]);
    { auto rr = __builtin_amdgcn_permlane32_swap(__float_as_uint(pmax), __float_as_uint(pmax), false, false);
      pmax = fmaxf(__uint_as_float(rr[0]), __uint_as_float(rr[1])); }
    constexpr float C2 = 1.4426950408889634f * SCALE;
    if (__builtin_expect(__all((pmax - m_reg) * SCALE <= THR), 1)) { mn = m_reg; alpha = 1.f; }
    else { mn = fmaxf(m_reg, pmax); alpha = __builtin_amdgcn_exp2f((m_reg - mn) * C2); m_reg = mn; }
    const float mnL = -mn * C2;
    for (int r = 0; r < 16; ++r) p0[r] = fmaf(p0[r], C2, mnL); for (int r = 0; r < 16; ++r) p1[r] = fmaf(p1[r], C2, mnL);
    for (int r = 0; r < 16; ++r) p0[r] = __builtin_amdgcn_exp2f(p0[r]);
}
__device__ __forceinline__ void finishSM(f32x16& p0, f32x16& p1, float alpha, float& l_reg, bf16x8& pa0, bf16x8& pa1, bf16x8& pa2, bf16x8& pa3) {
    for (int r = 0; r < 16; ++r) p1[r] = __builtin_amdgcn_exp2f(p1[r]);
    float ps = 0; for (int r = 0; r < 16; ++r) ps += p0[r]; for (int r = 0; r < 16; ++r) ps += p1[r];
    { auto rr = __builtin_amdgcn_permlane32_swap(__float_as_uint(ps), __float_as_uint(ps), false, false);
      ps = __uint_as_float(rr[0]) + __uint_as_float(rr[1]); }
    l_reg = l_reg * alpha + ps;
#define PK4(P, B_, OUT) do { unsigned a0 = cvtpk(P[B_+0], P[B_+1]), a1 = cvtpk(P[B_+2], P[B_+3]);                          \
        unsigned b0 = cvtpk(P[B_+4], P[B_+5]), b1 = cvtpk(P[B_+6], P[B_+7]);                                             \
        auto r0 = __builtin_amdgcn_permlane32_swap(a0, b0, false, false); auto r1 = __builtin_amdgcn_permlane32_swap(a1, b1, false, false); \
        u32x4 w = {r0[0], r1[0], r0[1], r1[1]}; OUT = *reinterpret_cast<bf16x8*>(&w); } while (0)
    PK4(p0, 0, pa0); PK4(p0, 8, pa1); PK4(p1, 0, pa2); PK4(p1, 8, pa3);
#undef PK4
}
template <int KB>
__device__ __forceinline__ void qkt(f32x16& p0, f32x16& p1, const char* K_lds, const char* R_lds, int r32, int hi, const bf16x8* qr, const char* qsp) {
    p0 = f32x16{}; p1 = f32x16{};
    const char* kb[4];
#pragma unroll
    for (int dd = 0; dd < 4; ++dd) kb[dd] = K_lds + KB * SHM_K + KSWZ(r32, (dd * 16 + hi * 8) * 2);
#pragma unroll
    for (int d0 = 0; d0 < 8; ++d0) { const char* a = kb[d0 & 3] + (d0 >> 2) * 128;
        bf16x8 b0 = *reinterpret_cast<const bf16x8*>(a);
        bf16x8 b1 = *reinterpret_cast<const bf16x8*>(a + 32 * 256);
        p0 = __builtin_amdgcn_mfma_f32_32x32x16_bf16(b0, qr[d0], p0, 0, 0, 0);
        p1 = __builtin_amdgcn_mfma_f32_32x32x16_bf16(b1, qr[d0], p1, 0, 0, 0); }
    const char* rb = R_lds + KB * SHM_R + r32 * RPAD + hi * 16;
#pragma unroll
    for (int d0 = 0; d0 < 4; ++d0) {
        bf16x8 b0 = *reinterpret_cast<const bf16x8*>(rb + d0 * 32);
        bf16x8 b1 = *reinterpret_cast<const bf16x8*>(rb + d0 * 32 + 32 * RPAD);
        const bf16x8 qf = *reinterpret_cast<const bf16x8*>(qsp + d0 * 1024);
        p0 = __builtin_amdgcn_mfma_f32_32x32x16_bf16(b0, qf, p0, 0, 0, 0);
        p1 = __builtin_amdgcn_mfma_f32_32x32x16_bf16(b1, qf, p1, 0, 0, 0); }
}
template <int VB>
__device__ __forceinline__ void pv_tile(f32x16* o, int vb0, bf16x8 pa0, bf16x8 pa1, bf16x8 pa2, bf16x8 pa3) {
#define TRRD(dst, off) asm volatile("ds_read_b64_tr_b16 %0, %1 offset:%2" : "=&v"(dst) : "v"(vb0), "i"(off) : "memory")
#define PV_KS(ks, PA) do { s16x4 l0, l1, l2, l3, h0, h1, h2, h3; constexpr int b_ = VB * SHM_V + v_rd_off(0, ks, 0);   \
        TRRD(l0, b_); TRRD(h0, b_ + 2048); TRRD(l1, b_ + 512); TRRD(h1, b_ + 512 + 2048); TRRD(l2, b_ + 1024); TRRD(h2, b_ + 1024 + 2048); TRRD(l3, b_ + 1536); TRRD(h3, b_ + 1536 + 2048); \
        asm volatile("s_waitcnt lgkmcnt(0)" ::: "memory"); SBAR();   \
        o[0] = __builtin_amdgcn_mfma_f32_32x32x16_bf16(PA, (bf16x8){l0[0], l0[1], l0[2], l0[3], h0[0], h0[1], h0[2], h0[3]}, o[0], 0, 0, 0);   \
        o[1] = __builtin_amdgcn_mfma_f32_32x32x16_bf16(PA, (bf16x8){l1[0], l1[1], l1[2], l1[3], h1[0], h1[1], h1[2], h1[3]}, o[1], 0, 0, 0);   \
        o[2] = __builtin_amdgcn_mfma_f32_32x32x16_bf16(PA, (bf16x8){l2[0], l2[1], l2[2], l2[3], h2[0], h2[1], h2[2], h2[3]}, o[2], 0, 0, 0);   \
        o[3] = __builtin_amdgcn_mfma_f32_32x32x16_bf16(PA, (bf16x8){l3[0], l3[1], l3[2], l3[3], h3[0], h3[1], h3[2], h3[3]}, o[3], 0, 0, 0); } while (0)
    PV_KS(0, pa0); PV_KS(1, pa1); PV_KS(2, pa2); PV_KS(3, pa3);
#undef PV_KS
#undef TRRD
}

struct BlockRef { const bf16* Q; const bf16* K; const bf16* R; const bf16* V; bf16* O; int P0; int row0; };
__device__ __forceinline__ BlockRef make_ref(int L, int pass, const bf16* Q, const bf16* K, const bf16* R, const bf16* V, bf16* O) {
    const int xcd = L & 7, k = L >> 3, bh = (k >> 2) * 8 + xcd, x = k & 3, qb = pass ? 7 - x : x, b = bh >> 3, h = bh & 7;
    BlockRef r;
    r.Q = Q + ((size_t)bh * SEQ + (size_t)qb * QB) * DQ; r.K = K + (size_t)bh * SEQ * DN; r.V = V + (size_t)bh * SEQ * DV; r.R = R + (size_t)b * SEQ * DR;
    r.O = O + ((size_t)b * SEQ + (size_t)qb * QB) * OSTR + h * DV; r.P0 = qb * QB; r.row0 = b * SEQ + qb * QB;
    return r;
}
#define ROW(p, k0, rr) ((p) + (size_t)((k0) + (rr)) * 128 + sc)
#define RROW(p, k0) ((p) + (size_t)((k0) + rsr) * 64 + rsc)
#define VMW() asm volatile("s_waitcnt vmcnt(0)" ::: "memory")
#define SLOAD_H(Kp, Rp, Vp, k0) do { st_v0 = load8(ROW(Vp, k0, sr)); st_v1 = load8(ROW(Vp, k0, 32 + sr));              \
                         st_k0 = load8(ROW(Kp, k0, sr)); st_k1 = load8(ROW(Kp, k0, 32 + sr)); st_r = load8(RROW(Rp, k0)); } while (0)
#define SWRITE_H(bf) do { *(bf16x8*)(V_lds + (bf) * SHM_V + vst0) = st_v0; *(bf16x8*)(V_lds + (bf) * SHM_V + vst1) = st_v1; \
                          *(bf16x8*)(K_lds + (bf) * SHM_K + kws) = st_k0; *(bf16x8*)(K_lds + (bf) * SHM_K + kws + 32 * 256) = st_k1; *(bf16x8*)(R_lds + (bf) * SHM_R + rws) = st_r; } while (0)
__device__ __forceinline__ void q_finalize(bf16x8 (&qr)[8], const BlockRef& cur, char* lds, int wid, const float* gq, const float* cs_tab) {
    {
            const int ln2_ = mk_lane(), r32 = ln2_ & 31, hi = ln2_ >> 5;
            const bf16* qp = cur.Q + (size_t)(wid * QBLK + r32) * DQ + hi * 8;
            char* qsp = lds + OFF_QS + wid * 4096 + ln2_ * 16;
            {
                bf16x8 raw[8];
#pragma unroll
                for (int d0 = 0; d0 < 8; ++d0) raw[d0] = load8(qp + d0 * 16);
                float sn = 0.f;
#pragma unroll
                for (int d0 = 0; d0 < 8; ++d0)
#pragma unroll
                    for (int j = 0; j < 8; ++j) { const float x = __builtin_bit_cast(float, (unsigned)(unsigned short)raw[d0][j] << 16); sn += x * x; }
                { auto rr = __builtin_amdgcn_permlane32_swap(__float_as_uint(sn), __float_as_uint(sn), false, false); sn = __uint_as_float(rr[0]) + __uint_as_float(rr[1]); }
                const float rn = rsqrtf(sn * (1.0f / 128.0f) + 1e-6f);
#pragma unroll
                for (int d0 = 0; d0 < 8; ++d0) { const f32x4 ga = *(const f32x4*)(gq + d0 * 16 + hi * 8), gb = *(const f32x4*)(gq + d0 * 16 + hi * 8 + 4); u32x4 w;
#define QX(j) (__builtin_bit_cast(float, (unsigned)(unsigned short)raw[d0][j] << 16) * rn)
                    w.x = cvtpk(QX(0) * ga[0], QX(1) * ga[1]); w.y = cvtpk(QX(2) * ga[2], QX(3) * ga[3]); w.z = cvtpk(QX(4) * gb[0], QX(5) * gb[1]); w.w = cvtpk(QX(6) * gb[2], QX(7) * gb[3]);
#undef QX
                    qr[d0] = *reinterpret_cast<bf16x8*>(&w); }
                asm volatile("" : "+v"(qr[0]), "+v"(qr[1]), "+v"(qr[2]), "+v"(qr[3]), "+v"(qr[4]), "+v"(qr[5]), "+v"(qr[6]), "+v"(qr[7]));
            }
            bf16x8 raw[12];
#pragma unroll
            for (int d0 = 8; d0 < 12; ++d0) raw[d0] = load8(qp + d0 * 16);
            float sr = 0.f;
#pragma unroll
            for (int d0 = 8; d0 < 12; ++d0)
#pragma unroll
                for (int j = 0; j < 8; ++j) { const float x = __builtin_bit_cast(float, (unsigned)(unsigned short)raw[d0][j] << 16); sr += x * x; }
            { auto rr = __builtin_amdgcn_permlane32_swap(__float_as_uint(sr), __float_as_uint(sr), false, false); sr = __uint_as_float(rr[0]) + __uint_as_float(rr[1]); }
            const float rrs = rsqrtf(sr * (1.0f / 64.0f) + 1e-6f);
            const float* csr = cs_tab + (size_t)(cur.row0 + wid * QBLK + r32) * 64;
#pragma unroll
            for (int dp = 0; dp < 2; ++dp) { u32x4 wlo, whi; unsigned lo[4], hi4[4];
#pragma unroll
                for (int jj = 0; jj < 4; ++jj) {
                    const f32x4 cs4 = *(const f32x4*)(csr + (16 * dp + 8 * hi + 2 * jj) * 2);
                    const int j = 2 * jj;
                    const float g1a = gq[128 + 16 * dp + 8 * hi + j], g1b = gq[128 + 16 * dp + 8 * hi + j + 1], g2a = gq[128 + 32 + 16 * dp + 8 * hi + j], g2b = gq[128 + 32 + 16 * dp + 8 * hi + j + 1];
                    const float t1a = __builtin_bit_cast(float, (unsigned)(unsigned short)raw[8 + dp][j] << 16) * rrs * g1a, t1b = __builtin_bit_cast(float, (unsigned)(unsigned short)raw[8 + dp][j + 1] << 16) * rrs * g1b;
                    const float t2a = __builtin_bit_cast(float, (unsigned)(unsigned short)raw[10 + dp][j] << 16) * rrs * g2a, t2b = __builtin_bit_cast(float, (unsigned)(unsigned short)raw[10 + dp][j + 1] << 16) * rrs * g2b;
                    lo[jj] = cvtpk(t1a * cs4[0] - t2a * cs4[1], t1b * cs4[2] - t2b * cs4[3]);
                    hi4[jj] = cvtpk(t2a * cs4[0] + t1a * cs4[1], t2b * cs4[2] + t1b * cs4[3]);
                }
                wlo = (u32x4){lo[0], lo[1], lo[2], lo[3]}; whi = (u32x4){hi4[0], hi4[1], hi4[2], hi4[3]};
                *reinterpret_cast<u32x4*>(qsp + dp * 1024) = wlo; *reinterpret_cast<u32x4*>(qsp + (dp + 2) * 1024) = whi; }
        }
}
__device__ __forceinline__ void o_epilogue(const f32x16 (&o)[4], float l_reg, bf16* Oblk, char* lds, float* li_l, int wid, int lane, int r32, int hi) {
        if (hi == 0) li_l[r32] = l_reg; asm volatile("s_waitcnt lgkmcnt(0)" ::: "memory");
        float rli[16];
#pragma unroll
        for (int r = 0; r < 16; ++r) rli[r] = __builtin_amdgcn_rcpf(li_l[crow(r, hi)]);
        bf16* Ow = Oblk + (size_t)(wid * QBLK) * OSTR;
        bf16* stg = (bf16*)(lds + OFF_QS + wid * 4096);
#pragma unroll
        for (int hf = 0; hf < 2; ++hf) {
#pragma unroll
            for (int r = 0; r < 16; ++r) { const int orow = crow(r, hi);
#pragma unroll
                for (int d = 0; d < 2; ++d) stg[orow * 64 + d * 32 + r32] = (bf16)(cvtpk(o[2 * hf + d][r] * rli[r], 0.f) & 0xffffu); }
            asm volatile("s_waitcnt lgkmcnt(0)" ::: "memory");
#pragma unroll
            for (int i = 0; i < 4; ++i) { const int row = i * 8 + (lane >> 3), ch = lane & 7; const u32x4 v = *(const u32x4*)(stg + row * 64 + ch * 8); *(u32x4*)(Ow + (size_t)row * OSTR + hf * 64 + ch * 8) = v; }
            asm volatile("s_waitcnt lgkmcnt(0)" ::: "memory");
        }
}
__device__ __forceinline__ void attn_phase(char* lds, const bf16* Q, const bf16* K, const bf16* R, const bf16* V, bf16* O, const float* gq, const float* cs_tab, int G, int c, int wave_s) {
    constexpr int total = 4 * NB * NH;
    int tid_ = wave_s * 64 + mk_lane(); asm volatile("" : "+v"(tid_));
    const int tid = tid_, wid = __builtin_amdgcn_readfirstlane(tid >> 6), lane = tid & 63, r32 = lane & 31, hi = lane >> 5;
    const int grp = wid >> 2;
    int L = c; if (L >= total) return;
    int pass = 0;
    BlockRef cur = make_ref(L, 0, Q, K, R, V, O);
    char* V_lds = lds + OFF_V; char* K_lds = lds + OFF_K; char* R_lds = lds + OFF_R;
    float* ws = (float*)(lds + OFF_WS) + wid * 64; float* li_l = ws, * al_l = ws + 32;
    char* qsp = lds + OFF_QS + wid * 4096 + lane * 16;
    const int sr = tid >> 4, sc = (tid & 15) * 8, vst0 = v_st(sr, sc), vst1 = v_st(32 + sr, sc), kws = KSWZ(sr, sc * 2);
    const int rsr = tid >> 3, rsc = (tid & 7) * 8, rws = rsr * RPAD + rsc * 2;
    const int vb0 = (int)(uintptr_t)V_lds + v_rd_base(lane);
    bf16x8 st_v0 = {}, st_v1 = {}, st_k0 = {}, st_k1 = {}, st_r = {};
#define SWRITE_KV(kb, vr) do { *(bf16x8*)(V_lds + (vr) * SHM_V + vst0) = st_v0; *(bf16x8*)(V_lds + (vr) * SHM_V + vst1) = st_v1; \
                               *(bf16x8*)(K_lds + (kb) * SHM_K + kws) = st_k0; *(bf16x8*)(K_lds + (kb) * SHM_K + kws + 32 * 256) = st_k1; *(bf16x8*)(R_lds + (kb) * SHM_R + rws) = st_r; } while (0)
    SLOAD_H(cur.K, cur.R, cur.V, 0); VMW(); SWRITE_KV(0, 0);
    __syncthreads();
    int vsel = 0;
    bool pend = false, have_old = false;
    bf16* oldO = cur.O;
    bf16x8 pa0 = {}, pa1 = {}, pa2 = {}, pa3 = {}; bf16x8 qr[8] = {};
    float m_reg = -1e30f, l_reg = 0; f32x16 o[4] = {};
#define RESC(a) do { if (__any((a) < 1.f)) { if (hi == 0) al_l[r32] = (a); asm volatile("s_waitcnt lgkmcnt(0)" ::: "memory");              \
                     for (int d_ = 0; d_ < 4; ++d_) for (int r = 0; r < 16; ++r) o[d_][r] *= al_l[crow(r, hi)]; } } while (0)
#define NEWBLOCK() do { q_finalize(qr, cur, lds, wid, gq, cs_tab); m_reg = -1e30f; l_reg = 0; _Pragma("unroll") for (int d_ = 0; d_ < 4; ++d_) o[d_] = f32x16{}; } while (0)
#define STEP(t, KB) do { const int kb_ = (t) * KVBLK; const int vprev = vsel == 0 ? 2 : vsel - 1, vnext = vsel == 2 ? 0 : vsel + 1;       \
        if (grp) {                                                              \
            if (pend) { pv_tile<0>(o, vb0 + vprev * SHM_V, pa0, pa1, pa2, pa3); pend = false; }                                          \
            if ((t) == 0) { if (have_old) o_epilogue(o, l_reg, oldO, lds, li_l, wid, lane, r32, hi); NEWBLOCK(); } }                     \
        if (kb_ <= qlo + QBLK - 1) {                                            \
            f32x16 p0 = {}, p1 = {}; float mn = 0.f, al = 1.f;                                                                                                 \
            SBAR(); qkt<KB>(p0, p1, K_lds, R_lds, r32, hi, qr, qsp);                                                                     \
            if (kb_ + KVBLK - 1 > qlo) mask_tile(p0, p1, qm - kb_, (unsigned)WIN);                                                        \
            partialSM(p0, p1, m_reg, mn, al); RESC(al);                                                                                  \
            finishSM(p0, p1, al, l_reg, pa0, pa1, pa2, pa3); SBAR();                                                                     \
            if (grp) pend = true; else pv_tile<0>(o, vb0 + vsel * SHM_V, pa0, pa1, pa2, pa3); }                                          \
        VMW(); SWRITE_KV((KB) ^ 1, vnext); __syncthreads(); vsel = vnext; } while (0)
    for (;;) {
        const bool more_pass = pass == 0, more_item = L + G < total, last = !more_pass && !more_item;
        int passn = pass + 1, Ln = L;
        if (!more_pass) { passn = 0; Ln = more_item ? L + G : L; }
        const BlockRef nxt = last ? cur : make_ref(Ln, passn, Q, K, R, V, O);
        const int NT = cur.P0 / KVBLK + 4;
        const int qlo = cur.P0 + wid * QBLK, qm = qlo + r32 - 4 * hi;
        const bf16* Kh = cur.K; const bf16* Vh = cur.V; const bf16* Rh = cur.R;
        if (!grp) NEWBLOCK();
        for (int t = 0; t < NT; t += 2) {
            SLOAD_H(Kh, Rh, Vh, (t + 1) * KVBLK); SBAR();
            STEP(t, 0);
            const bool lt = t + 2 >= NT;
            if (!lt) { SLOAD_H(Kh, Rh, Vh, (t + 2) * KVBLK); } else { SLOAD_H(nxt.K, nxt.R, nxt.V, 0); }
            SBAR();
            STEP(t + 1, 1);
        }
        if (grp) { oldO = cur.O; have_old = true; } else o_epilogue(o, l_reg, cur.O, lds, li_l, wid, lane, r32, hi);
        if (last) break;
        cur = nxt; pass = passn; L = Ln;
    }
    if (grp) { if (pend) pv_tile<0>(o, vb0 + (vsel == 0 ? 2 : vsel - 1) * SHM_V, pa0, pa1, pa2, pa3); o_epilogue(o, l_reg, oldO, lds, li_l, wid, lane, r32, hi); }
    __syncthreads();
#undef RESC
#undef NEWBLOCK
#undef STEP
#undef SWRITE_KV
}
#undef ROW
#undef RROW
#undef VMW
#undef SLOAD_H
#undef SWRITE_H
#undef KSWZ
#undef SBAR
}
#define GAS __attribute__((address_space(1)))
#define LAS __attribute__((address_space(3)))
typedef unsigned short bf16;
typedef unsigned v4u __attribute__((ext_vector_type(4)));
typedef float f32x4 __attribute__((ext_vector_type(4)));
typedef short bf16x8 __attribute__((ext_vector_type(8)));
typedef GAS unsigned gu32;
typedef GAS unsigned long long gu64;
#define RLX_AGENT __ATOMIC_RELAXED, __HIP_MEMORY_SCOPE_AGENT
#define LDS_WAIT() asm volatile("s_waitcnt lgkmcnt(0)" ::: "memory")
#define VM_WAIT() asm volatile("s_waitcnt vmcnt(0)" ::: "memory")
__device__ __forceinline__ unsigned long long rt() { return __builtin_amdgcn_s_memrealtime(); }
__device__ __forceinline__ unsigned f2bf(float f) { unsigned u = __builtin_bit_cast(unsigned, f); return (u + 0x7fffu + ((u >> 16) & 1u)) >> 16; }
__device__ __forceinline__ unsigned pk2(float lo, float hi) { return f2bf(lo) | (f2bf(hi) << 16); }
#define XB_TMO      128
#define XB_XCNT(j)  (256  + 64 * (j))
#define XB_XSUB(j)  (1280 + 64 * (j))
#define XB_XGEN(j)  (2304 + 64 * (j))
#define XB_TOP      3328
#define XB_TOPGEN   3392
#define XCD_BAR_WORDS 3456
#define XB_SPIN_CAP (1u << 18)

__device__ __forceinline__ unsigned xb_ld(unsigned* p)              { return __hip_atomic_load(p, __ATOMIC_RELAXED, __HIP_MEMORY_SCOPE_AGENT); }
__device__ __forceinline__ unsigned xb_add(unsigned* p, unsigned v) { return __hip_atomic_fetch_add(p, v, __ATOMIC_RELAXED, __HIP_MEMORY_SCOPE_AGENT); }
__device__ __forceinline__ unsigned xb_xcc_id() { return (unsigned)__builtin_amdgcn_s_getreg((3 << 11) | 20) & 0xFu; }
#define XB_SPIN(cond, bar) do { unsigned _sp = 0; while (cond) { __builtin_amdgcn_s_sleep(1); \
    if ((++_sp & 255u) == 0u) { if (xb_ld(&(bar)[XB_TMO])) break; if (_sp > XB_SPIN_CAP) { atomicAdd(&(bar)[XB_TMO], 1u); break; } } } } while (0)

struct XcdBarrier {
    unsigned* bar; unsigned x;
    volatile LAS unsigned* st;
};

__device__ __forceinline__ XcdBarrier xcd_barrier_post(unsigned* bar, volatile LAS unsigned* st, bool t0  ) {
    XcdBarrier b; b.bar = bar; b.x = xb_xcc_id(); b.st = st;
    if (t0) (void)xb_add(&bar[XB_XCNT(b.x)], 1u);
    return b;
}
__device__ __forceinline__ void xcd_barrier_complete(unsigned* bar, unsigned x, unsigned& nloc, unsigned& nx) {
    const unsigned G = gridDim.x * gridDim.y * gridDim.z;
    unsigned sum, cnt, mine, sp = 0u;
    for (;;) {
        sum = 0u; cnt = 0u; mine = 0u;
#pragma unroll
        for (unsigned j = 0; j < 16; ++j) { const unsigned c = xb_ld(&bar[XB_XCNT(j)]); sum += c; cnt += (c > 0u) ? 1u : 0u; mine = (j == x) ? c : mine; }
        if (sum == G) break;
        __builtin_amdgcn_s_sleep(1);
        if ((++sp & 255u) == 0u) { if (xb_ld(&bar[XB_TMO])) break; if (sp > XB_SPIN_CAP) { atomicAdd(&bar[XB_TMO], 1u); break; } }
    }
    nloc = mine > 0u ? mine : 1u; nx = cnt > 0u ? cnt : 1u;
}

__device__ __forceinline__ void xcd_barrier(const XcdBarrier& b, bool t0) {
    asm volatile("s_waitcnt vmcnt(0)" ::: "memory");
    __syncthreads();
    if (t0) {
        unsigned* bar = b.bar;
        __builtin_amdgcn_s_waitcnt(0);
        unsigned nloc = b.st[0], nx = b.st[1];
        if (nloc == 0u) { xcd_barrier_complete(bar, b.x, nloc, nx); b.st[0] = nloc; b.st[1] = nx; }
        const unsigned old = xb_add(&bar[XB_XSUB(b.x)], 1u);
        const unsigned gen = old / nloc;
        if (old + 1u == (gen + 1u) * nloc) {
            __builtin_amdgcn_fence(__ATOMIC_RELEASE, "agent");
            asm volatile("s_waitcnt vmcnt(0)" ::: "memory");
            const unsigned og = xb_add(&bar[XB_TOP], 1u);
            const unsigned tg = og / nx;
            if (og + 1u == (tg + 1u) * nx) xb_add(&bar[XB_TOPGEN], 1u);
            else XB_SPIN(xb_ld(&bar[XB_TOPGEN]) == tg, bar);
            __builtin_amdgcn_fence(__ATOMIC_ACQUIRE, "agent");
            xb_add(&bar[XB_XGEN(b.x)], 1u);
            asm volatile("s_waitcnt vmcnt(0)" ::: "memory");
        } else {
            XB_SPIN(xb_ld(&bar[XB_XGEN(b.x)]) == gen, bar);
            __builtin_amdgcn_fence(__ATOMIC_ACQUIRE, "agent");
            asm volatile("s_waitcnt vmcnt(0)" ::: "memory");
        }
    }
    __syncthreads();
}
constexpr int NWAVES = 8;
constexpr int BATCH = 16, SEQ = 2048, T = BATCH * SEQ, D = 1024, FF = 4096;
constexpr int NPHASE = 25;
#ifndef MK_PER_PHASE
#define MK_PER_PHASE 0
#endif

constexpr size_t MiB = 1u << 20;
constexpr size_t WS_CTL = 0, CTL_ZERO_BYTES = 4 * MiB;
constexpr size_t CTL_SS = 256 * 1024;
constexpr size_t CTL_SSCQ = CTL_SS + 8 * (size_t)T * 8;
constexpr size_t CTL_SSCKV = CTL_SSCQ + 2 * (size_t)T * 8;
constexpr size_t CTL_DUMMY = CTL_SSCKV + 2 * (size_t)T * 8;
static_assert(CTL_DUMMY + (size_t)T * 8 <= CTL_ZERO_BYTES, "ctl");
constexpr size_t WS_W = 4 * MiB;
constexpr size_t W_MI = 0, W_MO = W_MI + 4 * (size_t)FF * D, W_DN = W_MO + 4 * (size_t)FF * D, W_UQ = W_DN + 2 * (size_t)768 * 1024, W_UKV = W_UQ + 2 * (size_t)1536 * 384,
                 W_AO = W_UKV + 2 * (size_t)2048 * 256, W_HI = W_AO + 2 * (size_t)1024 * 1024, W_HO = W_HI + (size_t)4096 * 1024, W_P1 = W_HO + (size_t)1024 * 1024,
                 W_P2 = W_P1 + (size_t)2048 * 1024, W_END = W_P2 + (size_t)1024 * 1024;
constexpr size_t WS_LB = WS_W + W_END * 2;
constexpr size_t WS_PV = WS_LB + 4096;
constexpr int PV_GQ = 0, PV_GK = 384, PV_ON = 768, PV_BP1 = 896, PV_WDW = 2944, PV_BDW = 34688, PV_LNG = 35712, PV_LNB = 36736, PV_BP2 = 37760, PV_POS = 38784, PV_END = PV_POS + T;
static_assert(WS_PV + (size_t)PV_END * 4 <= 96 * MiB, "weights + params");
constexpr size_t WS_XB = 96 * MiB;
constexpr size_t WS_OV = 160 * MiB;
constexpr size_t WS_HH = WS_OV;
constexpr size_t WS_Q = WS_OV, WS_K = WS_OV + 96 * MiB, WS_V = WS_OV + 160 * MiB, WS_O = WS_OV + 224 * MiB, WS_CQ = WS_OV + 288 * MiB, WS_CKV = WS_OV + 312 * MiB, WS_KR = WS_OV + 328 * MiB;
constexpr size_t WS_HQ = WS_OV, WS_HV = WS_OV + 64 * MiB, WS_HG = WS_OV + 128 * MiB, WS_HLF = WS_OV + 192 * MiB;
constexpr size_t WS_CU = WS_OV, WS_CY = WS_OV + 64 * MiB;
constexpr size_t WS_CS = 496 * MiB;
constexpr size_t WS_END = 512 * MiB;
static_assert(WS_KR + (size_t)T * 64 * 2 <= WS_END && WS_HLF + (size_t)T * 1024 * 4 <= WS_END && WS_HH + (size_t)T * FF * 2 <= WS_O + 0 * MiB + 64 * MiB, "ws map");

constexpr int CW_BAR = 4096;

constexpr int RING_OFF = 0, RING_BYTES = 135168;
constexpr int LDSCTL_OFF = RING_BYTES, MISC_OFF = LDSCTL_OFF + 320, EXTRA_OFF = RING_BYTES + 1024;
constexpr int LDS_BYTES = 147456;

__device__ __forceinline__ float wave_sum(float v) {
#define WSDPP(c) v += __builtin_bit_cast(float, __builtin_amdgcn_mov_dpp(__builtin_bit_cast(int, v), c, 0xf, 0xf, true))
    WSDPP(0xB1); WSDPP(0x4E); WSDPP(0x141); WSDPP(0x140);
#undef WSDPP
    { auto r = __builtin_amdgcn_permlane32_swap(__float_as_uint(v), __float_as_uint(v), false, false); v = __uint_as_float(r[0]) + __uint_as_float(r[1]); }
    { auto r = __builtin_amdgcn_permlane16_swap(__float_as_uint(v), __float_as_uint(v), false, false); v = __uint_as_float(r[0]) + __uint_as_float(r[1]); }
    return v;
}
__device__ __forceinline__ float bf2f(unsigned h) { return __builtin_bit_cast(float, h << 16); }
template <bool TILED = false> __device__ __forceinline__ void p0_transpose_item(const float* W, int K, int N, const float* gain, bf16* WT, int dst_row0, LAS float* scr, int k0, int n0, int lane) {
    float wv_[32];
#pragma unroll
    for (int i = 0; i < 32; ++i) wv_[i] = W[(size_t)(k0 + 2 * i + (lane >> 5)) * N + n0 + (lane & 31)];
#pragma unroll
    for (int i = 0; i < 32; ++i) { const int kk = 2 * i + (lane >> 5); const float gk = gain ? gain[k0 + kk] : 1.0f; scr[kk * 33 + (lane & 31)] = wv_[i] * gk; }
    LDS_WAIT(); asm volatile("" ::: "memory");
    const int c = lane & 7;
#pragma unroll
    for (int j = 0; j < 4; ++j) { const int n = (lane >> 3) + 8 * j; const LAS float* s = scr + (8 * c) * 33 + n;
        v4u o; o.x = pk2(s[0 * 33], s[1 * 33]); o.y = pk2(s[2 * 33], s[3 * 33]); o.z = pk2(s[4 * 33], s[5 * 33]); o.w = pk2(s[6 * 33], s[7 * 33]);
        const int rr = dst_row0 + n;
        if (TILED) *(GAS v4u*)(WT + (((size_t)(rr >> 8) * (K / 64) + (k0 >> 6)) * 256 + (rr & 255)) * 64 + 8 * c) = o;
        else *(GAS v4u*)(WT + (size_t)rr * K + k0 + 8 * c) = o; }
    LDS_WAIT(); asm volatile("" ::: "memory");
}

struct Args {
    const float* in[26]; float* out; unsigned char* ws; int ph_lo, ph_hi, li, pad;
};

#define P0_MAT(cnt_per, nmats, Wbase, Wstride, Kd, Nd, gainexpr, WTbase, WTstride) P0_MATX(true, cnt_per, nmats, Wbase, Wstride, Kd, Nd, gainexpr, WTbase, WTstride)
#define P0_MATX(TL, cnt_per, nmats, Wbase, Wstride, Kd, Nd, gainexpr, WTbase, WTstride) \
    if (r < (cnt_per) * (nmats)) { const int mi = r / (cnt_per), it = r % (cnt_per); const int nnb = (Nd) / 32, kb = it / nnb, nb = it % nnb; \
        p0_transpose_item<TL>((Wbase) + (size_t)mi * (Wstride), (Kd), (Nd), (gainexpr), (WTbase) + (size_t)mi * (WTstride), 32 * nb, scr, 64 * kb, 32 * nb, lane); continue; } r -= (cnt_per) * (nmats);

template <int PART> __device__ __forceinline__ void p0_weights(const Args& a, LAS unsigned char* lds, int gw, int NGW, int lane, int wave) {
    bf16* Wb = (bf16*)(a.ws + WS_W);
    LAS float* scr = (LAS float*)(lds + RING_OFF + wave * 16384);
    const float* norm_mix = a.in[2]; const float* norm_mlp = a.in[3];
    constexpr int I_MI = 16 * 128, I_MO = 64 * 32, I_DN = 16 * 22, I_UQ = 6 * 48, I_UKV = 4 * 64, I_SQ = 16 * 32, I_HI = 16 * 128, I_P1 = 16 * 64;
    constexpr int NM = PART < 2 ? 2 : 1, L0 = PART == 0 ? 0 : PART == 1 ? 2 : PART == 2 ? 0 : 1, J0 = PART == 1 ? 1 : 0;
    constexpr bool HAS_MLA = PART != 3, TAIL_HG = PART == 0 || PART == 3, TAIL_CV = PART == 1;
    constexpr int NITEMS = NM * (I_MI + I_MO) + (HAS_MLA ? I_DN + I_UQ + I_UKV + I_SQ : 0) + (TAIL_HG ? I_HI + I_SQ : 0) + (TAIL_CV ? I_P1 + I_SQ : 0);
    for (int item = gw; item < NITEMS; item += NGW) {
        int r = item;
        P0_MAT(I_MI, NM, a.in[4] + (size_t)L0 * D * FF, (size_t)D * FF, D, FF, norm_mlp + (L0 + mi) * D, Wb + W_MI + (size_t)L0 * FF * D, (size_t)FF * D)
        P0_MATX(true, I_MO, NM, a.in[5] + (size_t)L0 * FF * D, (size_t)FF * D, FF, D, (const float*)nullptr, Wb + W_MO + (size_t)L0 * FF * D, (size_t)FF * D)
        if (HAS_MLA) {
            P0_MAT(I_DN, 1, a.in[6] + (size_t)J0 * D * 704, 0, D, 704, norm_mix + J0 * 3 * D, Wb + W_DN + (size_t)J0 * 768 * D, 0)
            P0_MAT(I_UQ, 1, a.in[9] + (size_t)J0 * 384 * 1536, 0, 384, 1536, a.in[7] + J0 * 384, Wb + W_UQ + (size_t)J0 * 1536 * 384, 0)
            P0_MAT(I_UKV, 1, a.in[10] + (size_t)J0 * 256 * 2048, 0, 256, 2048, a.in[8] + J0 * 256, Wb + W_UKV + (size_t)J0 * 2048 * 256, 0)
            P0_MAT(I_SQ, 1, a.in[13] + (size_t)J0 * D * D, 0, D, D, (const float*)nullptr, Wb + W_AO + (size_t)J0 * D * D, 0)
        }
        if (TAIL_HG) {
            P0_MAT(I_HI, 1, a.in[14], 0, D, FF, norm_mix + 1 * D, Wb + W_HI, 0)
            { const int nnb = D / 32, kb = r / nnb, nb = r % nnb; p0_transpose_item<true>(a.in[17], D, D, nullptr, Wb + W_HO, 32 * nb, scr, 64 * kb, 32 * nb, lane); }
        } else if (TAIL_CV) {
            if (r < I_P1) {
                const int nnb = 2048 / 32, kb = r / nnb, nb = r % nnb, n0 = 32 * nb, bj = n0 >> 10, j0 = n0 & 1023;
                p0_transpose_item<true>(a.in[18], D, 2048, norm_mix + 2 * D, Wb + W_P1, 256 * (j0 >> 7) + 128 * bj + (j0 & 127), scr, 64 * kb, n0, lane); continue; }
            r -= I_P1;
            { const int nnb = D / 32, kb = r / nnb, nb = r % nnb; p0_transpose_item<true>(a.in[24], D, D, nullptr, Wb + W_P2, 32 * nb, scr, 64 * kb, 32 * nb, lane); }
        }
    }
}
__device__ __forceinline__ void p0_prologue(const Args& a, LAS unsigned char* lds, int vcu, int G, int tid, int lane, int wave) {
    unsigned char* ws = a.ws;
    bf16* Wb = (bf16*)(ws + WS_W);
    const int gw = vcu * NWAVES + wave, NGW = G * NWAVES;
    p0_weights<2>(a, lds, gw, NGW, lane, wave);
    for (int i = vcu * 512 + tid; i < 2 * 8192; i += G * 512) { const int j = i >> 13, rem = i & 8191, kt = rem >> 9, ch = rem & 511;
        *(GAS v4u*)(Wb + W_DN + (size_t)j * 768 * D + ((size_t)(2 * 16 + kt) * 256 + 192) * 64 + ch * 8) = (v4u){0u, 0u, 0u, 0u}; }
    for (int c = vcu * 512 + tid; c < 1024; c += G * 512) {
        const float* lg = a.in[15]; const float l0 = lg[c], l1 = lg[1024 + c], l2 = lg[2048 + c], l3 = lg[3072 + c];
        const float mx = fmaxf(fmaxf(l0, l1), fmaxf(l2, l3)); const float e0 = expf(l0 - mx), e1 = expf(l1 - mx), e2 = expf(l2 - mx), e3 = expf(l3 - mx);
        ((float*)(ws + WS_LB))[c] = e1 / (e0 + e1 + e2 + e3);
    }
    { float* pv = (float*)(ws + WS_PV); const int gt = vcu * 512 + tid, NT_ = G * 512;
#define P0_COPY(dst, src, n) for (int i = gt; i < (n); i += NT_) pv[(dst) + i] = (src)[i];
      P0_COPY(PV_GQ, a.in[11], 384) P0_COPY(PV_GK, a.in[12], 384) P0_COPY(PV_ON, a.in[16], 128) P0_COPY(PV_BP1, a.in[19], 2048) P0_COPY(PV_WDW, a.in[20], 31 * 1024)
      P0_COPY(PV_BDW, a.in[21], 1024) P0_COPY(PV_LNG, a.in[22], 1024) P0_COPY(PV_LNB, a.in[23], 1024) P0_COPY(PV_BP2, a.in[25], 1024) P0_COPY(PV_POS, a.in[1], T)
#undef P0_COPY
    }
    const float* x = a.in[0]; bf16* xb = (bf16*)(ws + WS_XB); unsigned long long* ss0 = (unsigned long long*)(ws + CTL_SS);
    for (int m0 = gw; m0 < T; m0 += 2 * NGW) {
        f32x4 v[2][4];
#pragma unroll
        for (int u = 0; u < 2; ++u) { const int mr_ = (m0 + u * NGW < T) ? m0 + u * NGW : m0; const GAS f32x4* xr = (const GAS f32x4*)(x + (size_t)mr_ * D) + lane;
#pragma unroll
            for (int j = 0; j < 4; ++j) v[u][j] = xr[64 * j]; }
#pragma unroll
        for (int u = 0; u < 2; ++u) { const int m = (m0 + u * NGW < T) ? m0 + u * NGW : m0; float s = 0.f;
#pragma unroll
            for (int j = 0; j < 4; ++j) { const float r0 = bf2f(f2bf(v[u][j].x)), r1 = bf2f(f2bf(v[u][j].y)), r2 = bf2f(f2bf(v[u][j].z)), r3 = bf2f(f2bf(v[u][j].w)); s += (r0 * r0 + r1 * r1) + (r2 * r2 + r3 * r3); }
            s = wave_sum(s);
            GAS unsigned long long* o8 = (GAS unsigned long long*)(xb + (size_t)m * D) + lane;
#pragma unroll
            for (int j = 0; j < 4; ++j) o8[64 * j] = (unsigned long long)pk2(v[u][j].x, v[u][j].y) | ((unsigned long long)pk2(v[u][j].z, v[u][j].w) << 32);
            if (lane == 0) ss0[m] = (unsigned long long)(s * 1048576.0f + 0.5f); }
    }
}

__device__ __forceinline__ void mla_finalize(const int* pos, const float* gq, const float* gk, bf16* Q, bf16* Kn, bf16* Kr, int vcu, int G, int lane, int wave) {
    const int gw = vcu * NWAVES + wave, NGW = G * NWAVES;
    const float gq0 = gq[2 * lane], gq1 = gq[2 * lane + 1], gqr = gq[128 + lane], gk0 = gk[2 * lane], gk1 = gk[2 * lane + 1], gkr = gk[128 + lane];
    const float inv_freq = powf(10000.0f, -(float)(2 * (lane & 31)) / 64.0f);
    for (int row = gw; row < T; row += NGW) {
        const int b = row >> 11, s = row & 2047;
        const float ang = (float)pos[row] * inv_freq; float sn, cs; sincosf(ang, &sn, &cs);
        const float sgn = lane < 32 ? -sn : sn;
#pragma unroll 2
        for (int h = 0; h < 8; ++h) {
            bf16* qp = Q + ((size_t)((b * 8 + h) * 2048 + s)) * 192; bf16* kp = Kn + ((size_t)((b * 8 + h) * 2048 + s)) * 128;
            const unsigned wq = *(const unsigned*)(qp + 2 * lane), wk = *(const unsigned*)(kp + 2 * lane); const unsigned er = qp[128 + lane];
            float a0 = bf2f(wq & 0xffffu), a1 = bf2f(wq >> 16), k0 = bf2f(wk & 0xffffu), k1 = bf2f(wk >> 16), e = bf2f(er);
            const float sq = wave_sum(a0 * a0 + a1 * a1), sk = wave_sum(k0 * k0 + k1 * k1), se = wave_sum(e * e);
            const float rq = rsqrtf(sq * (1.0f / 128.0f) + 1e-6f), rk = rsqrtf(sk * (1.0f / 128.0f) + 1e-6f), re = rsqrtf(se * (1.0f / 64.0f) + 1e-6f);
            *(unsigned*)(qp + 2 * lane) = pk2(a0 * rq * gq0, a1 * rq * gq1);
            *(unsigned*)(kp + 2 * lane) = pk2(k0 * rk * gk0, k1 * rk * gk1);
            e = e * re * gqr; const float pe = __shfl_xor(e, 32);
            qp[128 + lane] = (bf16)f2bf(e * cs + pe * sgn);
        }
        { bf16* rp = Kr + (size_t)row * 64; float e = bf2f(rp[lane]); const float se = wave_sum(e * e); e = e * rsqrtf(se * (1.0f / 64.0f) + 1e-6f) * gkr;
          const float pe = __shfl_xor(e, 32); rp[lane] = (bf16)f2bf(e * cs + pe * sgn); }
    }
}

__device__ __forceinline__ void kr_finalize(const int* pos, const float* gk, bf16* Kr, float* cs_tab, int vcu, int G, int lane, int wave) {
    typedef float f32x2 __attribute__((ext_vector_type(2)));
    const int gw = vcu * NWAVES + wave, NGW = G * NWAVES;
    const float gkr = gk[128 + lane];
    const float inv_freq = powf(10000.0f, -(float)(2 * (lane & 31)) / 64.0f);
    for (int row0 = gw; row0 < T; row0 += 8 * NGW) {
        int ps[8]; unsigned er[8];
#pragma unroll
        for (int i = 0; i < 8; ++i) { const int r = row0 + i * NGW, rc = r < T ? r : T - 1; ps[i] = pos[rc]; er[i] = Kr[(size_t)rc * 64 + lane]; }
#pragma unroll
        for (int i = 0; i < 8; ++i) { const int row = row0 + i * NGW;
            if (row < T) {
                const float ang = (float)ps[i] * inv_freq; float sn, cs; sincosf(ang, &sn, &cs);
                const float sgn = lane < 32 ? -sn : sn;
                bf16* rp = Kr + (size_t)row * 64; float e = bf2f(er[i]); const float se = wave_sum(e * e); e = e * rsqrtf(se * (1.0f / 64.0f) + 1e-6f) * gkr;
                const float pe = __shfl_xor(e, 32); rp[lane] = (bf16)f2bf(e * cs + pe * sgn);
                if (lane < 32) *(f32x2*)(cs_tab + (size_t)row * 64 + 2 * lane) = (f32x2){cs, sn};
            } }
    }
}

__device__ __forceinline__ void hgrn_scan_simple(LAS unsigned char* lds, bf16* hq, const bf16* hv, const bf16* hg, const float* hlf, const float* onorm, int unit, int tid) {
    LAS float* Lf = (LAS float*)(lds); LAS float* Lk = Lf + 4096; LAS float* Lq = Lk + 4096; LAS float* Lv = Lq + 4096; LAS float* Lp = Lv + 4096;
    const int b = unit >> 3, h = unit & 7, dv = tid & 127, kg = tid >> 7;
    float S[32];
#pragma unroll
    for (int j = 0; j < 32; ++j) S[j] = 0.f;
    for (int c0 = 0; c0 < SEQ; c0 += 32) {
#pragma unroll
        for (int i = 0; i < 8; ++i) { const int idx = tid + 512 * i, t = idx >> 7, c = idx & 127; const size_t g = (size_t)(b * SEQ + c0 + t) * 1024 + h * 128 + c;
            const float f = __expf(hlf[g]); Lf[idx] = f; Lk[idx] = 1.0f - f; Lq[idx] = bf2f(hq[g]); Lv[idx] = bf2f(hv[g]); }
        __syncthreads();
        for (int t = 0; t < 32; ++t) {
            const float vv = Lv[t * 128 + dv]; float acc = 0.f;
            const LAS f32x4* pf = (const LAS f32x4*)(Lf + t * 128 + kg * 32); const LAS f32x4* pk = (const LAS f32x4*)(Lk + t * 128 + kg * 32); const LAS f32x4* pq = (const LAS f32x4*)(Lq + t * 128 + kg * 32);
#pragma unroll
            for (int j4 = 0; j4 < 8; ++j4) { const f32x4 f4 = pf[j4], k4 = pk[j4], q4 = pq[j4];
#pragma unroll
                for (int e = 0; e < 4; ++e) { const int j = j4 * 4 + e; S[j] = f4[e] * S[j] + k4[e] * vv; acc += q4[e] * S[j]; } }
            Lp[(kg * 32 + t) * 128 + dv] = acc;
        }
        __syncthreads();
        { const int t = tid >> 4, d0 = (tid & 15) * 8; float o[8]; float sq = 0.f;
#pragma unroll
            for (int e = 0; e < 8; ++e) { o[e] = (Lp[(0 * 32 + t) * 128 + d0 + e] + Lp[(1 * 32 + t) * 128 + d0 + e]) + (Lp[(2 * 32 + t) * 128 + d0 + e] + Lp[(3 * 32 + t) * 128 + d0 + e]); sq += o[e] * o[e]; }
            sq += __shfl_xor(sq, 1); sq += __shfl_xor(sq, 2); sq += __shfl_xor(sq, 4); sq += __shfl_xor(sq, 8);
            const float rn = rsqrtf(sq * (1.0f / 128.0f) + 1e-6f);
            const size_t g = (size_t)(b * SEQ + c0 + t) * 1024 + h * 128 + d0;
            const v4u gv = *(const v4u*)(hg + g); unsigned w[4];
#pragma unroll
            for (int e = 0; e < 4; ++e) { const unsigned gg = e == 0 ? gv.x : e == 1 ? gv.y : e == 2 ? gv.z : gv.w;
                w[e] = pk2(o[2 * e] * rn * onorm[d0 + 2 * e] * bf2f(gg & 0xffffu), o[2 * e + 1] * rn * onorm[d0 + 2 * e + 1] * bf2f(gg >> 16)); }
            *(v4u*)(hq + g) = (v4u){w[0], w[1], w[2], w[3]}; }
        __syncthreads();
    }
}

#ifndef EXP_NO_LN
#define EXP_NO_LN 0
#endif
__device__ __forceinline__ void conv_phase(LAS unsigned char* lds, const bf16* cu, bf16* cy, const float* wdw, const float* bdw, const float* lng, const float* lnb, int vcu, int G, int tid, int lane, int wave) {
    typedef float f32x2 __attribute__((ext_vector_type(2)));
    constexpr int TT = 16, NU = TT + 30;
    LAS f32x2* red = (LAS f32x2*)(lds + RING_OFF);
    const int c0 = 2 * tid;
    f32x2 wv[31];
#pragma unroll
    for (int k = 0; k < 31; ++k) wv[k] = *(const f32x2*)(wdw + k * 1024 + c0);
    const f32x2 bd = *(const f32x2*)(bdw + c0), g2 = *(const f32x2*)(lng + c0), b2 = *(const f32x2*)(lnb + c0);
    int par = 0;
    const int NT = T / TT, TPW = (NT + G - 1) / G, tb = vcu * TPW, te = (tb + TPW < NT) ? tb + TPW : NT;
    if (tb >= te) return;
    f32x2 uv[NU];
    unsigned nx[TT];
    {
        const int row0 = tb * TT, s0 = row0 & 2047;
#pragma unroll
        for (int i = 0; i < 30; ++i) {
            unsigned u = 0u;
            if (s0 - 30 + i >= 0) u = *(const unsigned*)(cu + (size_t)(row0 - 30 + i) * 1024 + c0);
            uv[i] = (f32x2){bf2f(u & 0xffffu), bf2f(u >> 16)};
        }
#pragma unroll
        for (int i = 0; i < TT; ++i) nx[i] = *(const unsigned*)(cu + (size_t)(row0 + i) * 1024 + c0);
    }
    for (int tile = tb; tile < te; ++tile) {
        const int row0 = tile * TT;
#pragma unroll
        for (int i = 0; i < TT; ++i) uv[30 + i] = (f32x2){bf2f(nx[i] & 0xffffu), bf2f(nx[i] >> 16)};
        if (tile + 1 < te) {
#pragma unroll
            for (int i = 0; i < TT; ++i) nx[i] = *(const unsigned*)(cu + (size_t)(row0 + TT + i) * 1024 + c0);
        }
        f32x2 yv[TT];
#pragma unroll
        for (int t = 0; t < TT; t += 2) { f32x2 a = bd, b = bd;
#pragma unroll
            for (int k = 0; k < 31; ++k) { a = __builtin_elementwise_fma(wv[k], uv[t + k], a); b = __builtin_elementwise_fma(wv[k], uv[t + 1 + k], b); }
            yv[t] = a; yv[t + 1] = b; }
        LAS f32x2* wp = red + (size_t)(par * TT * 8); par ^= 1;
        float zs[TT];
#define DPPA(v, c) v += __builtin_bit_cast(float, __builtin_amdgcn_mov_dpp(__builtin_bit_cast(int, v), c, 0xf, 0xf, true))
#pragma unroll
        for (int t = 0; t < TT; ++t) { float A = yv[t].x + yv[t].y, B = yv[t].x * yv[t].x + yv[t].y * yv[t].y;
            DPPA(A, 0xB1); DPPA(B, 0xB1); DPPA(A, 0x4E); DPPA(B, 0x4E); DPPA(A, 0x141); DPPA(B, 0x141); DPPA(A, 0x140); DPPA(B, 0x140);
            auto r1 = __builtin_amdgcn_permlane32_swap(__float_as_uint(A), __float_as_uint(B), false, false);
            const float X = __uint_as_float(r1[0]) + __uint_as_float(r1[1]);
            auto r2 = __builtin_amdgcn_permlane16_swap(__float_as_uint(X), __float_as_uint(X), false, false);
            zs[t] = __uint_as_float(r2[0]) + __uint_as_float(r2[1]); }
#undef DPPA
        if ((lane & 31) == 0) {
#pragma unroll
            for (int t = 0; t < TT; ++t) ((LAS float*)wp)[(t * 8 + wave) * 2 + (lane >> 5)] = zs[t];
        }
        __syncthreads();
#pragma unroll
        for (int t = 0; t < TT; ++t) { float s1 = 0.f, s2 = 0.f;
#pragma unroll
            for (int q = 0; q < 8; ++q) { const f32x2 v = wp[t * 8 + q]; s1 += v.x; s2 += v.y; }
            const float mean = s1 * (1.0f / 1024.0f), var = fmaxf(s2 * (1.0f / 1024.0f) - mean * mean, 0.f);
            const f32x2 st = (f32x2){mean, rsqrtf(var + 1e-6f)};
            float a = (yv[t].x - st.x) * st.y * g2.x + b2.x, b = (yv[t].y - st.x) * st.y * g2.y + b2.y;
            a = a * __builtin_amdgcn_rcpf(1.0f + __expf(-a)); b = b * __builtin_amdgcn_rcpf(1.0f + __expf(-b));
            *(unsigned*)(cy + (size_t)(row0 + t) * 1024 + c0) = pk2(a, b); }
        const bool newseq = ((row0 + TT) & 2047) == 0;
#pragma unroll
        for (int i = 0; i < 30; ++i) uv[i] = newseq ? (f32x2){0.f, 0.f} : uv[i + TT];
    }
}
namespace hgs {
typedef short bf16x8 __attribute__((ext_vector_type(8)));
typedef short s16x4 __attribute__((ext_vector_type(4)));
typedef float f32x4 __attribute__((ext_vector_type(4)));
typedef float f32x2 __attribute__((ext_vector_type(2)));
typedef unsigned u32x4 __attribute__((ext_vector_type(4)));
typedef unsigned u32x2 __attribute__((ext_vector_type(2)));
constexpr int RS = 272, RK = 144, RO = 528;
constexpr int OFF_KT = 0, OFF_LF = 0, OFF_QI = 43520, OFF_VV = OFF_QI + 17408, OFF_QT = OFF_VV + 17408, OFF_KO = OFF_QT + 17408, OFF_AT = OFF_KO + 18432, OFF_SEG = OFF_AT + 9216, OFF_AL = OFF_SEG + 4096,
              OFF_OUT = OFF_QT, LDS_END = OFF_AL + 512;
static_assert(LDS_END <= 131072 && 64 * RO <= 17408 + 18432 && 10 * 16 * RS <= OFF_QI && 64 * 512 <= OFF_QI, "scan LDS map");
__device__ __forceinline__ unsigned pkbf(float lo, float hi) { unsigned r; asm volatile("v_cvt_pk_bf16_f32 %0, %1, %2" : "=v"(r) : "v"(lo), "v"(hi)); return r; }
__device__ __forceinline__ float bflo(unsigned w) { return __builtin_bit_cast(float, w << 16); }
__device__ __forceinline__ float bfhi(unsigned w) { return __builtin_bit_cast(float, w & 0xffff0000u); }
__device__ __forceinline__ void trrd4(s16x4& a, s16x4& b, s16x4& c, s16x4& d, unsigned addr) {
    asm volatile("ds_read_b64_tr_b16 %0, %4\n\tds_read_b64_tr_b16 %1, %4 offset:%5\n\tds_read_b64_tr_b16 %2, %4 offset:%6\n\tds_read_b64_tr_b16 %3, %4 offset:%7\n\ts_waitcnt lgkmcnt(0)"
                 : "=&v"(a), "=&v"(b), "=&v"(c), "=&v"(d) : "v"(addr), "n"(4 * RS), "n"(32 * RS), "n"(32 * RS + 4 * RS) : "memory");
}

__device__ __forceinline__ void scan_unit(LAS unsigned char* lds, unsigned short* hq, const unsigned short* hv, const unsigned short* hg, const float* hlf, const float* onorm, unsigned short* ho, int unit, int wave_s) {
    int tid_ = wave_s * 64 + mk_lane(); asm volatile("" : "+v"(tid_));
    const int tid = tid_, lane = tid & 63, w = __builtin_amdgcn_readfirstlane(tid >> 6);
    const int b = unit >> 3, h = unit & 7;
    const size_t gbase = (size_t)b * SEQ * 1024 + h * 128;
    u32x4 pq[2], pv[2], pg[2]; f32x4 pl[4];
#define SCAN_LOAD(c0) do { _Pragma("unroll") for (int i = 0; i < 2; ++i) { const int p = tid + 512 * i, t = p >> 4, c = p & 15; const size_t g = gbase + (size_t)((c0) + t) * 1024 + c * 8; \
            pq[i] = *(const u32x4*)(hq + g); pv[i] = *(const u32x4*)(hv + g); } \
        _Pragma("unroll") for (int i = 0; i < 4; ++i) { const int p = tid + 512 * i, t = p >> 5, c = p & 31; pl[i] = *(const f32x4*)(hlf + gbase + (size_t)((c0) + t) * 1024 + c * 4); } } while (0)
#define SCAN_STORE() do { _Pragma("unroll") for (int i = 0; i < 2; ++i) { const int p = tid + 512 * i, t = p >> 4, c = p & 15; \
            *(LAS u32x4*)(lds + OFF_QI + t * RS + c * 16) = pq[i]; *(LAS u32x4*)(lds + OFF_VV + t * RS + c * 16) = pv[i]; } \
        _Pragma("unroll") for (int i = 0; i < 4; ++i) { const int p = tid + 512 * i, t = p >> 5, c = p & 31; *(LAS f32x4*)(lds + OFF_LF + t * 512 + c * 16) = pl[i]; } } while (0)
    const int to = tid >> 3, d0 = (tid & 7) * 16;
    float gn[16];
#pragma unroll
    for (int e = 0; e < 16; ++e) gn[e] = onorm[d0 + e];
    for (int i = tid; i < 64 * RK / 4; i += 512) *(LAS unsigned*)(lds + OFF_AT + i * 4) = 0u;
    f32x4 S[8];
#pragma unroll
    for (int k = 0; k < 8; ++k) S[k] = (f32x4){0.f, 0.f, 0.f, 0.f};
    SCAN_LOAD(0); SCAN_STORE();
    const int col = lane & 15, rq = lane >> 4;
    f32x2 fv[8], R[8], Sx[8];
#define SCAN_S2() do { f32x2 ls = (f32x2){0.f, 0.f};                                                                                                   \
        _Pragma("unroll") for (int i = 0; i < 8; ++i) { const f32x2 l = *(const LAS f32x2*)(lds + OFF_LF + (8 * w + i) * 512 + lane * 8); ls += l; fv[i] = (f32x2){__expf(l.x), __expf(l.y)}; } \
        R[0] = fv[0];                                                                                                                                  \
        _Pragma("unroll") for (int i = 1; i < 8; ++i) R[i] = R[i - 1] * fv[i];                                                                         \
        Sx[7] = (f32x2){1.f, 1.f};                                                                                                                     \
        _Pragma("unroll") for (int i = 6; i >= 0; --i) Sx[i] = Sx[i + 1] * fv[i + 1];                                                                  \
        *(LAS f32x2*)(lds + OFF_SEG + w * 512 + lane * 8) = ls; } while (0)
    __syncthreads();
    SCAN_S2();
    for (int c0 = 0; c0 < SEQ; c0 += 64) {
        __syncthreads();
        if (c0 + 64 < SEQ) SCAN_LOAD(c0 + 64);
        { const size_t g = gbase + (size_t)(c0 + to) * 1024 + d0; pg[0] = *(const u32x4*)(hg + g); pg[1] = *(const u32x4*)(hg + g + 8); }
        {
            f32x2 tt[8];
#pragma unroll
            for (int s = 0; s < 8; ++s) tt[s] = *(const LAS f32x2*)(lds + OFF_SEG + s * 512 + lane * 8);
            f32x2 base = (f32x2){0.f, 0.f}, after = (f32x2){0.f, 0.f}, all = (f32x2){0.f, 0.f};
#pragma unroll
            for (int s = 0; s < 8; ++s) { if (s < w) base += tt[s]; if (s > w) after += tt[s]; all += tt[s]; }
            const int J = w >> 1, odd = w & 1;
            f32x2 prevt = (f32x2){0.f, 0.f};
#pragma unroll
            for (int s = 0; s < 8; ++s) if (odd && s == w - 1) prevt = tt[s];
            const f32x2 eb = (f32x2){__expf(base.x), __expf(base.y)};
            const f32x2 ep = (f32x2){__expf(prevt.x), __expf(prevt.y)};
            const f32x2 epi = (f32x2){__expf(-prevt.x), __expf(-prevt.y)};
            const f32x2 el = (f32x2){__expf(after.x), __expf(after.y)};
            f32x2 eI[3];
#pragma unroll
            for (int I = 1; I < 4; ++I) { f32x2 a = (f32x2){0.f, 0.f};
#pragma unroll
                for (int s = 0; s < 8; ++s) if (s > w && s < 2 * I) a += tt[s];
                eI[I - 1] = (f32x2){__expf(a.x), __expf(a.y)}; }
            if (w == 0) *(LAS f32x2*)(lds + OFF_AL + lane * 8) = (f32x2){__expf(all.x), __expf(all.y)};
            unsigned kow[2][4];
            const int sl0 = 8 * odd;
            unsigned qws[8];
#pragma unroll
            for (int i = 0; i < 8; ++i) qws[i] = *(const LAS unsigned*)(lds + OFF_QI + (8 * w + i) * RS + lane * 4);
#pragma unroll
            for (int i = 0; i < 8; ++i) {
                const int t = 8 * w + i;
                const unsigned qw = qws[i];
                const f32x2 q = (f32x2){bflo(qw), bfhi(qw)};
                const f32x2 k = (f32x2){1.f, 1.f} - fv[i];
                const f32x2 qin = q * eb * R[i], qt = q * ep * R[i];
                *(LAS unsigned*)(lds + OFF_QI + t * RS + lane * 4) = pkbf(qin.x, qin.y);
                *(LAS unsigned*)(lds + OFF_QT + t * RS + lane * 4) = pkbf(qt.x, qt.y);
                const f32x2 ks = k * Sx[i];
                const f32x2 ko = ks * el;
                if (i & 1) { kow[0][i >> 1] |= pkbf(0.f, ko.x) & 0xffff0000u; kow[1][i >> 1] |= pkbf(0.f, ko.y) & 0xffff0000u; }
                else { kow[0][i >> 1] = pkbf(ko.x, 0.f) & 0xffffu; kow[1][i >> 1] = pkbf(ko.y, 0.f) & 0xffffu; }
                const f32x2 ri = (f32x2){__builtin_amdgcn_rcpf(R[i].x), __builtin_amdgcn_rcpf(R[i].y)};
                const f32x2 kd = k * epi * ri;
                *(LAS unsigned*)(lds + OFF_KT + ((J * (J + 1) / 2 + J) * 16 + sl0 + i) * RS + lane * 4) = pkbf(kd.x, kd.y);
#pragma unroll
                for (int I = 1; I < 4; ++I) if (I > J) { const f32x2 kk = ks * eI[I - 1];
                    *(LAS unsigned*)(lds + OFF_KT + ((I * (I + 1) / 2 + J) * 16 + sl0 + i) * RS + lane * 4) = pkbf(kk.x, kk.y); }
            }
            *(LAS u32x4*)(lds + OFF_KO + (2 * lane) * RK + 16 * w) = (u32x4){kow[0][0], kow[0][1], kow[0][2], kow[0][3]};
            *(LAS u32x4*)(lds + OFF_KO + (2 * lane + 1) * RK + 16 * w) = (u32x4){kow[1][0], kow[1][1], kow[1][2], kow[1][3]};
        }
        __syncthreads();
#pragma unroll
        for (int rep = 0; rep < 2; ++rep) {
            const int idx = w + 8 * rep;
            if (idx < 10) {
                const int I = idx >= 6 ? 3 : (idx >= 3 ? 2 : (idx >= 1 ? 1 : 0)), Jb = idx - I * (I + 1) / 2;
                f32x4 d = (f32x4){0.f, 0.f, 0.f, 0.f};
                bf16x8 ka[4], qb[4];
#pragma unroll
                for (int j = 0; j < 4; ++j) { ka[j] = *(const LAS bf16x8*)(lds + OFF_KT + (idx * 16 + col) * RS + (32 * j + 8 * rq) * 2);
                                              qb[j] = *(const LAS bf16x8*)(lds + OFF_QT + (16 * I + col) * RS + (32 * j + 8 * rq) * 2); }
                __builtin_amdgcn_sched_barrier(0);
#pragma unroll
                for (int j = 0; j < 4; ++j) d = __builtin_amdgcn_mfma_f32_16x16x32_bf16(ka[j], qb[j], d, 0, 0, 0);
                if (I == Jb) {
#pragma unroll
                    for (int i = 0; i < 4; ++i) if (4 * rq + i > col) d[i] = 0.f; }
                *(LAS u32x2*)(lds + OFF_AT + (16 * I + col) * RK + (16 * Jb + 4 * rq) * 2) = (u32x2){pkbf(d[0], d[1]), pkbf(d[2], d[3])};
            }
        }
        bf16x8 vf[2];
        {
            const unsigned va = (unsigned)(size_t)(lds + OFF_VV) + (unsigned)((8 * rq + ((lane & 15) >> 2)) * RS + w * 32 + (lane & 3) * 8);
            s16x4 l0, h0, l1, h1; trrd4(l0, h0, l1, h1, va);
            vf[0] = (bf16x8){l0[0], l0[1], l0[2], l0[3], h0[0], h0[1], h0[2], h0[3]}; vf[1] = (bf16x8){l1[0], l1[1], l1[2], l1[3], h1[0], h1[1], h1[2], h1[3]};
        }
        f32x4 oacc[4];
        {
            bf16x8 sb[4];
#pragma unroll
            for (int j = 0; j < 4; ++j) { const u32x4 wv = (u32x4){pkbf(S[2 * j][0], S[2 * j][1]), pkbf(S[2 * j][2], S[2 * j][3]), pkbf(S[2 * j + 1][0], S[2 * j + 1][1]), pkbf(S[2 * j + 1][2], S[2 * j + 1][3])};
                sb[j] = __builtin_bit_cast(bf16x8, wv); }
            u32x4 av[4][4];
#pragma unroll
            for (int mb = 0; mb < 4; ++mb)
#pragma unroll
                for (int j = 0; j < 4; ++j) {
                    const u32x2 lo = *(const LAS u32x2*)(lds + OFF_QI + (16 * mb + col) * RS + (32 * j + 4 * rq) * 2), hi = *(const LAS u32x2*)(lds + OFF_QI + (16 * mb + col) * RS + (32 * j + 16 + 4 * rq) * 2);
                    av[mb][j] = (u32x4){lo.x, lo.y, hi.x, hi.y}; }
            __builtin_amdgcn_sched_barrier(0);
#pragma unroll
            for (int mb = 0; mb < 4; ++mb) oacc[mb] = (f32x4){0.f, 0.f, 0.f, 0.f};
#pragma unroll
            for (int j = 0; j < 4; ++j)
#pragma unroll
                for (int mb = 0; mb < 4; ++mb) oacc[mb] = __builtin_amdgcn_mfma_f32_16x16x32_bf16(__builtin_bit_cast(bf16x8, av[mb][j]), sb[j], oacc[mb], 0, 0, 0);
            __builtin_amdgcn_sched_barrier(0);
        }
#pragma unroll
        for (int bh = 0; bh < 2; ++bh) {
            f32x4 al[4]; bf16x8 ka[4][2];
#pragma unroll
            for (int b4 = 0; b4 < 4; ++b4) { const int blk = 4 * bh + b4; al[b4] = *(const LAS f32x4*)(lds + OFF_AL + (16 * blk + 4 * rq) * 4);
#pragma unroll
                for (int ks = 0; ks < 2; ++ks) ka[b4][ks] = *(const LAS bf16x8*)(lds + OFF_KO + (16 * blk + col) * RK + (32 * ks + 8 * rq) * 2); }
            __builtin_amdgcn_sched_barrier(0);
#pragma unroll
            for (int b4 = 0; b4 < 4; ++b4) S[4 * bh + b4] = S[4 * bh + b4] * al[b4];
#pragma unroll
            for (int ks = 0; ks < 2; ++ks)
#pragma unroll
                for (int b4 = 0; b4 < 4; ++b4) S[4 * bh + b4] = __builtin_amdgcn_mfma_f32_16x16x32_bf16(ka[b4][ks], vf[ks], S[4 * bh + b4], 0, 0, 0);
            __builtin_amdgcn_sched_barrier(0);
        }
        __syncthreads();
        if (c0 + 64 < SEQ) SCAN_STORE();
        {
            bf16x8 aa[4][2];
#pragma unroll
            for (int mb = 0; mb < 4; ++mb)
#pragma unroll
                for (int ks = 0; ks < 2; ++ks) if (ks == 0 || mb >= 2) aa[mb][ks] = *(const LAS bf16x8*)(lds + OFF_AT + (16 * mb + col) * RK + (32 * ks + 8 * rq) * 2);
            __builtin_amdgcn_sched_barrier(0);
#pragma unroll
            for (int ks = 0; ks < 2; ++ks)
#pragma unroll
                for (int mb = 0; mb < 4; ++mb) if (ks == 0 || mb >= 2) oacc[mb] = __builtin_amdgcn_mfma_f32_16x16x32_bf16(aa[mb][ks], vf[ks], oacc[mb], 0, 0, 0);
#pragma unroll
            for (int mb = 0; mb < 4; ++mb)
#pragma unroll
                for (int i = 0; i < 4; ++i) *(LAS float*)(lds + OFF_OUT + (16 * mb + 4 * rq + i) * RO + (16 * w + col) * 4) = oacc[mb][i];
        }
        __syncthreads();
        {
            f32x4 ov[4]; float sq = 0.f;
#pragma unroll
            for (int e = 0; e < 4; ++e) { ov[e] = *(const LAS f32x4*)(lds + OFF_OUT + to * RO + (d0 + 4 * e) * 4); sq += (ov[e][0] * ov[e][0] + ov[e][1] * ov[e][1]) + (ov[e][2] * ov[e][2] + ov[e][3] * ov[e][3]); }
            sq += __shfl_xor(sq, 1); sq += __shfl_xor(sq, 2); sq += __shfl_xor(sq, 4);
            const float rn = rsqrtf(sq * (1.0f / 128.0f) + 1e-6f);
            unsigned ow[8];
#pragma unroll
            for (int e = 0; e < 8; ++e) { const unsigned gw = e < 4 ? pg[0][e] : pg[1][e - 4];
                ow[e] = pkbf(ov[e >> 1][(2 * e) & 3] * rn * gn[2 * e] * bflo(gw), ov[e >> 1][(2 * e + 1) & 3] * rn * gn[2 * e + 1] * bfhi(gw)); }
            const size_t g = gbase + (size_t)(c0 + to) * 1024 + d0;
            *(u32x4*)(ho + g) = (u32x4){ow[0], ow[1], ow[2], ow[3]}; *(u32x4*)(ho + g + 8) = (u32x4){ow[4], ow[5], ow[6], ow[7]};
        }
        if (c0 + 64 < SEQ) SCAN_S2();
    }
    __syncthreads();
#undef SCAN_S2
#undef SCAN_LOAD
#undef SCAN_STORE
}
}
static_assert(att::LDS_BYTES <= RING_BYTES && pg8::STAGE_BYTES <= RING_BYTES && hgs::LDS_END <= RING_BYTES && EXTRA_OFF + 4096 <= LDS_BYTES, "LDS map");
__global__ void __launch_bounds__(NWAVES * 64, 2) mk_fwd(Args args) {
    extern __shared__ __attribute__((aligned(16))) unsigned char lds_raw[];
    LAS unsigned char* lds = (LAS unsigned char*)lds_raw;
    volatile LAS unsigned* MISC = (volatile LAS unsigned*)(lds + MISC_OFF);
    const int wave = __builtin_amdgcn_readfirstlane(threadIdx.x >> 6);
    const int tid = wave * 64 + mk_lane();
    const int G = gridDim.x; const int bx = blockIdx.x; const int vcu = (G % 8 == 0) ? (bx % 8) * (G / 8) + bx / 8 : bx;
    gu32* ctl = (gu32*)(args.ws + WS_CTL);
    for (int u = tid; u < (LDS_BYTES - LDSCTL_OFF) / 4; u += NWAVES * 64) ((LAS unsigned*)(lds + LDSCTL_OFF))[u] = 0u;
    __syncthreads();
#if MK_PER_PHASE
#define GRID_BAR() do { } while (0)
#else
    XcdBarrier bar = xcd_barrier_post((unsigned*)(ctl + CW_BAR), MISC + 8, wave == 0 && mk_lane() == 0);
#define GRID_BAR() xcd_barrier(bar, wave == 0 && mk_lane() == 0)
#endif
    const int lo = args.ph_lo, hi = args.ph_hi;
#ifndef REP_PHASE
#define REP_PHASE -1
#define REP_COUNT 2
#endif
#define REPEAT(k) _Pragma("unroll") for (int r_ = 0; r_ < (((k) == REP_PHASE) ? REP_COUNT : 1); ++r_)
#ifndef STAG_TICKS
#define STAG_TICKS 0
#endif
#ifndef MLPOUT_REV
#define MLPOUT_REV 1
#endif
#ifndef GEMM_SP2
#define GEMM_SP2 true
#endif
#ifndef SCAN_SIMPLE
#define SCAN_SIMPLE 0
#endif
#ifndef EXP_SKIP_CONV
#define EXP_SKIP_CONV 0
#endif
#ifndef NO_UQ
#define NO_UQ 0
#endif
#ifndef NO_UKV
#define NO_UKV 0
#endif
#ifndef ONLY_LO
#define ONLY_LO 0
#define ONLY_HI 99
#endif
#define IN(k) ((ONLY_LO) <= (k) && (k) <= (ONLY_HI) && lo <= (k) && (k) < hi)
#define SEAM(k) do { if (IN(k) && IN((k) + 1)) GRID_BAR(); } while (0)
#define WSDEF unsigned long long z_ = 0; asm volatile("" : "+s"(z_)); unsigned char* ws_ = args.ws + z_
#define P_OUT (args.out)
#define P_PV ((const float*)(ws_ + WS_PV))
#define P_POS ((const int*)(P_PV + PV_POS))
#define P_SSB ((pg8::ssq_t*)(ws_ + CTL_SS))
#define P_SSCQ ((pg8::ssq_t*)(ws_ + CTL_SSCQ))
#define P_SSCKV ((pg8::ssq_t*)(ws_ + CTL_SSCKV))
#define P_WB ((pg8::bf16_t*)(ws_ + WS_W))
#define P_XB ((pg8::bf16_t*)(ws_ + WS_XB))
#define P_HH ((pg8::bf16_t*)(ws_ + WS_HH))
#define P_Q ((pg8::bf16_t*)(ws_ + WS_Q))
#define P_K ((pg8::bf16_t*)(ws_ + WS_K))
#define P_V ((pg8::bf16_t*)(ws_ + WS_V))
#define P_O ((pg8::bf16_t*)(ws_ + WS_O))
#define P_CQ ((pg8::bf16_t*)(ws_ + WS_CQ))
#define P_CKV ((pg8::bf16_t*)(ws_ + WS_CKV))
#define P_KR ((pg8::bf16_t*)(ws_ + WS_KR))
#define P_HQ ((pg8::bf16_t*)(ws_ + WS_HQ))
#define P_HV ((pg8::bf16_t*)(ws_ + WS_HV))
#define P_HG ((pg8::bf16_t*)(ws_ + WS_HG))
#define P_HLF ((float*)(ws_ + WS_HLF))
#define P_CU ((pg8::bf16_t*)(ws_ + WS_CU))
#define P_CY ((pg8::bf16_t*)(ws_ + WS_CY))
#define P_LB ((const float*)(ws_ + WS_LB))

#define RUN_GEMM(EpiT, Aptr, Btptr, Nn, Kk, ...) do { pg8::Gemm g_{(Aptr), (Btptr), T, (Nn), (Kk)}; pg8::StaticOrder S_; S_.init(T, (Nn), G, (int)blockIdx.x); \
        EpiT E_{__VA_ARGS__}; pg8::gemm_phase<EpiT, pg8::StaticOrder, true, GEMM_SP2, false, true>(lds + RING_OFF, g_, S_, E_, wave); } while (0)
#define RUN_GEMM_STAG(EpiT, Aptr, Btptr, Nn, Kk, ...) do { pg8::Gemm g_{(Aptr), (Btptr), T, (Nn), (Kk)}; pg8::StaticOrder S_; S_.init(T, (Nn), G, (int)blockIdx.x); \
        EpiT E_{__VA_ARGS__}; pg8::gemm_phase<EpiT, pg8::StaticOrder, true, GEMM_SP2, false, true>(lds + RING_OFF, g_, S_, E_, wave, (int)((blockIdx.x >> 3) & 3) * STAG_TICKS); } while (0)
#define RUN_GEMM_TILED_P(EpiT, Aptr, Btptr, Nn, Kk, ...) do { pg8::Gemm g_{(Aptr), (Btptr), T, (Nn), (Kk)}; pg8::StaticOrder S_; S_.init(T, (Nn), G, (int)blockIdx.x, 2); \
        EpiT E_{__VA_ARGS__}; pg8::gemm_phase<EpiT, pg8::StaticOrder, true, GEMM_SP2, true>(lds + RING_OFF, g_, S_, E_, wave); } while (0)
#define RUN_GEMM_TILED(EpiT, Aptr, Btptr, Nn, Kk, ...) do { pg8::Gemm g_{(Aptr), (Btptr), T, (Nn), (Kk)}; pg8::StaticOrder S_; S_.init(T, (Nn), G, (int)blockIdx.x, MLPOUT_REV); \
        EpiT E_{__VA_ARGS__}; pg8::gemm_phase<EpiT, pg8::StaticOrder, true, GEMM_SP2, true>(lds + RING_OFF, g_, S_, E_, wave); } while (0)

#define MLP_LAYER(l, P) do { \
    if (IN(P) && (P) == REP_PHASE) { WSDEF; RUN_GEMM(EPI_ROW_NOSTORE, P_XB, P_WB + W_MI + (size_t)(l) * FF * D, FF, D, P_HH, FF, P_SSB + (size_t)(2 * (l) + 1) * T, 1.0f / 1024.0f); } \
    if (IN(P)) { WSDEF; RUN_GEMM_STAG(EPI_ROW_TILED, P_XB, P_WB + W_MI + (size_t)(l) * FF * D, FF, D, P_HH, FF, P_SSB + (size_t)(2 * (l) + 1) * T, 1.0f / 1024.0f); } SEAM(P); \
    if (IN((P) + 1) && (P) + 1 == REP_PHASE) { WSDEF; RUN_GEMM_TILED_P(pg8::EpiResid<false>, P_HH, P_WB + W_MO + (size_t)(l) * FF * D, D, FF, P_OUT, P_XB, (const float*)nullptr, (pg8::ssq_t*)(ws_ + CTL_DUMMY), (pg8::bf16_t*)P_OUT); } \
    if (IN((P) + 1)) { WSDEF; if ((l) < 3) { RUN_GEMM_TILED(pg8::EpiResid<false>, P_HH, P_WB + W_MO + (size_t)(l) * FF * D, D, FF, P_OUT, P_XB, (const float*)nullptr, P_SSB + (size_t)(2 * (l) + 2) * T, P_XB); } \
                       else { RUN_GEMM_TILED(pg8::EpiResid<true>, P_HH, P_WB + W_MO + (size_t)(l) * FF * D, D, FF, P_OUT, P_XB, (const float*)nullptr, (pg8::ssq_t*)nullptr, P_XB); } } SEAM((P) + 1); } while (0)

#define MLA_LAYER(j, l, P) do { \
    if (IN(P)) { WSDEF; RUN_GEMM(pg8::EpiDown, P_XB, P_WB + W_DN + (size_t)(j) * 768 * D, 768, D, P_SSB + (size_t)(2 * (l)) * T, P_CQ, P_CKV, P_KR, P_SSCQ + (size_t)(j) * T, P_SSCKV + (size_t)(j) * T); } \
    if (IN(P) && (j) == 0 && bx >= 128) { OPQ; p0_weights<3>(args, lds, (bx - 128) * NWAVES + w_, 128 * NWAVES, l_, w_); }     \
    SEAM(P); \
    if (IN((P) + 1)) { { WSDEF; OPQ; kr_finalize(P_POS, P_PV + PV_GK + (j) * 192, P_KR, (float*)(ws_ + WS_CS), vcu, G, l_, w_); } \
                       { WSDEF; RUN_GEMM(pg8::EpiUQ, P_CQ, P_WB + W_UQ + (size_t)(j) * 1536 * 384, 1536, 384, P_SSCQ + (size_t)(j) * T, P_Q); } \
                       { WSDEF; RUN_GEMM(pg8::EpiUKV, P_CKV, P_WB + W_UKV + (size_t)(j) * 2048 * 256, 2048, 256, P_SSCKV + (size_t)(j) * T, P_K, P_V, P_PV + PV_GK + (j) * 192, (PG8_LAS float*)(lds + EXTRA_OFF)); } } SEAM((P) + 1); \
    if (IN((P) + 3)) REPEAT((P) + 3) { WSDEF; att::attn_phase((char*)lds_raw + RING_OFF, P_Q, P_K, P_KR, P_V, P_O, P_PV + PV_GQ + (j) * 192, (const float*)(ws_ + WS_CS), G, (int)blockIdx.x, wave); } SEAM((P) + 3); \
    if (IN((P) + 4) && (P) + 4 == REP_PHASE) { WSDEF; RUN_GEMM(pg8::EpiResid<false>, P_O, P_WB + W_AO + (size_t)(j) * D * D, D, D, P_OUT, P_XB, (const float*)nullptr, (pg8::ssq_t*)(ws_ + CTL_DUMMY), (pg8::bf16_t*)P_OUT); } \
    if (IN((P) + 4)) { WSDEF; RUN_GEMM(pg8::EpiResid<false>, P_O, P_WB + W_AO + (size_t)(j) * D * D, D, D, P_OUT, P_XB, (const float*)nullptr, P_SSB + (size_t)(2 * (l) + 1) * T, P_XB); } SEAM((P) + 4); } while (0)

#define EPI_RESID_BIAS pg8::EpiResid<false, true>
#define EPI_ROW_NOSTORE pg8::EpiRow<1, true>
#define EPI_ROW_TILED pg8::EpiRow<1, false, true>
#define OPQ int t_ = wave * 64 + mk_lane(); asm volatile("" : "+v"(t_)); const int l_ = t_ & 63, w_ = __builtin_amdgcn_readfirstlane(t_ >> 6)
    if (IN(0)) REPEAT(0) { OPQ; p0_prologue(args, lds, vcu, G, t_, l_, w_); } SEAM(0);
#if REP_PHASE == 99
    {
        typedef float f32x16 __attribute__((ext_vector_type(16))); typedef short bf16x8v __attribute__((ext_vector_type(8)));
        f32x16 c0 = {}, c1 = {}, c2 = {}, c3 = {}; bf16x8v a = {1, 2, 3, 4, 5, 6, 7, 8}, b = {8, 7, 6, 5, 4, 3, 2, 1};
        asm volatile("" : "+v"(a), "+v"(b));
        for (int it = 0; it < 8192; ++it) {
            c0 = __builtin_amdgcn_mfma_f32_32x32x16_bf16(a, b, c0, 0, 0, 0); c1 = __builtin_amdgcn_mfma_f32_32x32x16_bf16(a, b, c1, 0, 0, 0);
            c2 = __builtin_amdgcn_mfma_f32_32x32x16_bf16(a, b, c2, 0, 0, 0); c3 = __builtin_amdgcn_mfma_f32_32x32x16_bf16(a, b, c3, 0, 0, 0);
        }
        int never = 0; asm volatile("" : "+s"(never));
        if (never) { float s = 0.f; for (int e = 0; e < 16; ++e) s += c0[e] + c1[e] + c2[e] + c3[e]; args.out[tid] = s; }
    }
#endif
    MLA_LAYER(0, 0, 1);
    MLP_LAYER(0, 6);
    if (IN(8)) REPEAT(8) { WSDEF; RUN_GEMM(pg8::EpiHG, P_XB, P_WB + W_HI, FF, D, P_SSB + (size_t)2 * T, P_LB, P_HQ, P_HLF, (size_t)(WS_HV - WS_HQ) / 2); } SEAM(8);
    if (IN(9) && bx >= 128) { OPQ; p0_weights<1>(args, lds, (bx - 128) * NWAVES + w_, 128 * NWAVES, l_, w_); }
    if (IN(9)) { WSDEF; const int nrep9 = (REP_PHASE == 9) ? args.pad : 1; for (int r9 = 0; r9 < nrep9; ++r9) { if (bx < 128) hgs::scan_unit(lds, P_HQ, P_HV, P_HG, P_HLF, P_PV + PV_ON, (r9 + 1 < nrep9) ? (unsigned short*)P_OUT : P_HQ, bx, wave); } } SEAM(9);
    if (IN(10)) { WSDEF; RUN_GEMM(pg8::EpiResid<false>, P_HQ, P_WB + W_HO, D, D, P_OUT, P_XB, (const float*)nullptr, P_SSB + (size_t)3 * T, P_XB); } SEAM(10);
    MLP_LAYER(1, 11);
    if (IN(13)) REPEAT(13) { WSDEF; RUN_GEMM(pg8::EpiGLU, P_XB, P_WB + W_P1, 2048, D, P_SSB + (size_t)4 * T, P_PV + PV_BP1, P_CU); } SEAM(13);
    if (IN(14)) REPEAT(14) { WSDEF; OPQ; conv_phase(lds, P_CU, P_CY, P_PV + PV_WDW, P_PV + PV_BDW, P_PV + PV_LNG, P_PV + PV_LNB, vcu, G, t_, l_, w_); } SEAM(14);
    if (IN(15)) { WSDEF; RUN_GEMM(EPI_RESID_BIAS, P_CY, P_WB + W_P2, D, D, P_OUT, P_XB, P_PV + PV_BP2, P_SSB + (size_t)5 * T, P_XB); } SEAM(15);
    MLP_LAYER(2, 16);
    MLA_LAYER(1, 3, 18);
    MLP_LAYER(3, 23);
#undef IN
#undef SEAM
}

extern "C" void kernel_launch(void* const* d_in, const int* in_sizes, int n_in, void* d_out, int out_size, void* d_ws, size_t ws_size, hipStream_t stream) {
    static int grid = 0;
    if (grid == 0) {
        if (n_in != 26 || in_sizes[0] != T * D || out_size != T * D || ws_size < WS_END) { fprintf(stderr, "kernel_launch: unexpected shapes (n_in %d, in0 %d, out %d, ws %zu)\n", n_in, n_in > 0 ? in_sizes[0] : -1, out_size, ws_size); grid = -1; return; }
        int dev = 0, cus = 0, per_cu = 0;
        if (hipGetDevice(&dev) != hipSuccess || hipDeviceGetAttribute(&cus, hipDeviceAttributeMultiprocessorCount, dev) != hipSuccess) { grid = -1; return; }
        if (hipFuncSetAttribute((const void*)mk_fwd, hipFuncAttributeMaxDynamicSharedMemorySize, LDS_BYTES) != hipSuccess) { fprintf(stderr, "kernel_launch: hipFuncSetAttribute failed\n"); grid = -1; return; }
        if (hipOccupancyMaxActiveBlocksPerMultiprocessor(&per_cu, (const void*)mk_fwd, NWAVES * 64, LDS_BYTES) != hipSuccess || per_cu < 1) { fprintf(stderr, "kernel_launch: occupancy query says %d\n", per_cu); }
        (void)hipGetLastError();
        grid = cus;
    }
    if (grid < 0) return;
    if (hipMemsetAsync((char*)d_ws + WS_CTL, 0, CTL_ZERO_BYTES, stream) != hipSuccess) return;
    Args a{};
    for (int i = 0; i < 26; ++i) a.in[i] = (const float*)d_in[i];
    a.out = (float*)d_out; a.ws = (unsigned char*)d_ws; a.pad = (REP_PHASE == 9) ? 2 : 0;
#if MK_PER_PHASE
    for (int p = 0; p < NPHASE; ++p) { a.ph_lo = p; a.ph_hi = p + 1; a.li = p; hipLaunchKernelGGL(mk_fwd, dim3(grid), dim3(NWAVES * 64), LDS_BYTES, stream, a); }
#else
    a.ph_lo = 0; a.ph_hi = NPHASE; a.li = 0;
    hipLaunchKernelGGL(mk_fwd, dim3(grid), dim3(NWAVES * 64), LDS_BYTES, stream, a);
#endif
}
```
